# Optimizing an MI355X kernel written in HIP

```python
import math
import jax, jax.numpy as jnp
from jax import lax
import numpy as np

D_MODEL = 1024
BATCH = 16
SEQ = 2048
DEPTH = 4

GRID_W = 64
HEAD_DIM = 64
POOL_WIDTH = D_MODEL // 4
POOL_WINDOWS = (2, 4, 8, 16)
POOL_GROUP = POOL_WIDTH // len(POOL_WINDOWS)
RWKV_WIDTH = D_MODEL // 4
RWKV_HEADS = RWKV_WIDTH // HEAD_DIM
DECAY_LORA = 32
AAA_LORA = 32
GATE_LORA = 64
GN_EPS = 64e-5
RWKV_IN = 3 * RWKV_WIDTH + 2 * DECAY_LORA + 2 * AAA_LORA + GATE_LORA
ATTN_WIDTH = D_MODEL // 2
ATTN_HEADS = ATTN_WIDTH // HEAD_DIM
ATTN_KV_HEADS = ATTN_HEADS // 4
ATTN_KV_WIDTH = ATTN_KV_HEADS * HEAD_DIM
Q_BLOCK = 128
ROPE_THETA = 10000.0
QK_EPS = 1e-6
IN_WIDTH = POOL_WIDTH + RWKV_IN + ATTN_WIDTH + 2 * ATTN_KV_WIDTH
N_GROUPS = 4
EXPERTS_PER_GROUP = 8
N_EXPERTS = N_GROUPS * EXPERTS_PER_GROUP
TOP_K = 2
EXPERT_HIDDEN = D_MODEL // 2
MOE_BLOCK = 256
DEEPNORM_ALPHA = float((2 * DEPTH) ** 0.25)
DEEPNORM_BETA = float((8 * DEPTH) ** -0.25)
LN_EPS = 1e-5

kernel_name = "hybrid_pool_rwkv7_axialgqa_hiermoe_encoder"


def layer_norm(x, g, b):
    xf = x.astype(jnp.float32)
    mu = jnp.mean(xf, -1, keepdims=True)
    var = jnp.mean(jnp.square(xf - mu), -1, keepdims=True)
    return ((xf - mu) * lax.rsqrt(var + LN_EPS) * g + b).astype(x.dtype)


def rms_norm(x, g):
    xf = x.astype(jnp.float32)
    return (xf * lax.rsqrt(jnp.mean(xf * xf, -1, keepdims=True) + QK_EPS) * g).astype(x.dtype)


def axial_rope_tables(seq_len):
    rows = seq_len // GRID_W
    row_id = jnp.repeat(jnp.arange(rows), GRID_W).astype(jnp.float32)
    col_id = jnp.tile(jnp.arange(GRID_W), rows).astype(jnp.float32)
    half = HEAD_DIM // 2
    inv_freq = ROPE_THETA ** (-jnp.arange(0, half, 2, dtype=jnp.float32) / half)
    ang_r = row_id[:, None] * inv_freq
    ang_c = col_id[:, None] * inv_freq
    ang = jnp.concatenate([ang_r, ang_r, ang_c, ang_c], -1)
    return jnp.cos(ang), jnp.sin(ang)


def apply_axial_rope(x, cos, sin):
    half = HEAD_DIM // 2
    quarter = half // 2
    def rot(u):
        return jnp.concatenate([-u[..., quarter:], u[..., :quarter]], -1)
    xr = jnp.concatenate([rot(x[..., :half]), rot(x[..., half:])], -1)
    c = cos[None, :, None, :].astype(x.dtype)
    s = sin[None, :, None, :].astype(x.dtype)
    return x * c + xr * s


def multiscale_pool(u, pool_w, pool_scale):
    S = u.shape[1]
    uf = u.astype(jnp.float32)
    cs = jnp.pad(jnp.cumsum(uf, axis=1), ((0, 0), (1, 0), (0, 0)))
    t = jnp.arange(S)
    outs = []
    for gi, w in enumerate(POOL_WINDOWS):
        sl = slice(gi * POOL_GROUP, (gi + 1) * POOL_GROUP)
        lo = jnp.clip(t - w // 2, 0, S)
        hi = jnp.clip(t + w - w // 2, 0, S)
        c = cs[:, :, sl]
        mean = (c[:, hi] - c[:, lo]) / (hi - lo).astype(jnp.float32)[None, :, None]
        d = (mean - uf[:, :, sl]).astype(u.dtype)
        outs.append(d @ pool_w[gi])
    return jnp.concatenate(outs, -1) * pool_scale


def centred_token_shift(f, mu_prev, mu_next):
    prev = jnp.pad(f[:, :-1], ((0, 0), (1, 0), (0, 0)))
    nxt = jnp.pad(f[:, 1:], ((0, 0), (0, 1), (0, 0)))
    return f + mu_prev * (prev - f) + mu_next * (nxt - f)


def wkv7_scan(r, w, k, v, kk, a, reverse):
    B, S, H, N = r.shape
    def step(state, inp):
        r_t, w_t, k_t, v_t, kk_t, a_t = inp
        sk = jnp.einsum('bhij,bhj->bhi', state, kk_t)
        state = (state * w_t[:, :, None, :]
                 - sk[..., None] * (kk_t * a_t)[:, :, None, :]
                 + v_t[..., None] * k_t[:, :, None, :])
        return state, jnp.einsum('bhij,bhj->bhi', state, r_t)
    xs = tuple(jnp.moveaxis(z, 1, 0) for z in (r, w, k, v, kk, a))
    s0 = jnp.zeros((B, H, N, N), jnp.float32)
    _, ys = lax.scan(step, s0, xs, reverse=reverse)
    return jnp.moveaxis(ys, 0, 1)


def rwkv7_bidir(f, w0, w_up, a0, a_up, g_up, k_k, k_a, r_k, gn_g, gn_b):
    B, S, _ = f.shape
    W = RWKV_WIDTH
    r, k, v = f[..., :W], f[..., W:2 * W], f[..., 2 * W:3 * W]
    o = 3 * W
    wd = f[..., o:o + 2 * DECAY_LORA].reshape(B, S, 2, DECAY_LORA)
    o += 2 * DECAY_LORA
    ad = f[..., o:o + 2 * AAA_LORA].reshape(B, S, 2, AAA_LORA)
    o += 2 * AAA_LORA
    gd = f[..., o:o + GATE_LORA]

    def heads(z):
        return z.reshape(B, S, RWKV_HEADS, HEAD_DIM).astype(jnp.float32)

    d = (w0 + jnp.einsum('bsdl,dlc->bsdc', jnp.tanh(wd), w_up)).astype(jnp.float32)
    decay = jnp.exp(-math.exp(-0.5) * jax.nn.sigmoid(d))
    a = jax.nn.sigmoid((a0 + jnp.einsum('bsdl,dlc->bsdc', ad, a_up)).astype(jnp.float32))
    g = jax.nn.sigmoid(gd) @ g_up
    kf = k.astype(jnp.float32)
    kk = heads(kf * k_k)
    kk = kk / jnp.maximum(jnp.sqrt(jnp.sum(kk * kk, -1, keepdims=True)), 1e-12)
    rh, vh = heads(r), heads(v)
    wkv = jnp.zeros_like(rh)
    bonus = jnp.zeros_like(rh)
    for di, rev in enumerate((False, True)):
        a_d = a[:, :, di]
        kh = heads(kf * (1.0 + (a_d - 1.0) * k_a))
        wkv = wkv + wkv7_scan(rh, heads(decay[:, :, di]), kh, vh, kk, heads(a_d), rev)
        bonus = bonus + jnp.sum(rh * kh * r_k, -1, keepdims=True) * vh
    mu = jnp.mean(wkv, -1, keepdims=True)
    var = jnp.mean(jnp.square(wkv - mu), -1, keepdims=True)
    y = ((wkv - mu) * lax.rsqrt(var + GN_EPS)).reshape(B, S, W) * gn_g + gn_b
    y = y + bonus.reshape(B, S, W)
    return (y * g).astype(f.dtype)


def gqa_axial(u, q_norm, k_norm, cos, sin):
    B, S, _ = u.shape
    q = u[..., :ATTN_WIDTH].reshape(B, S, ATTN_HEADS, HEAD_DIM)
    k = u[..., ATTN_WIDTH:ATTN_WIDTH + ATTN_KV_WIDTH].reshape(B, S, ATTN_KV_HEADS, HEAD_DIM)
    v = u[..., ATTN_WIDTH + ATTN_KV_WIDTH:].reshape(B, S, ATTN_KV_HEADS, HEAD_DIM)
    q = apply_axial_rope(rms_norm(q, q_norm), cos, sin)
    k = apply_axial_rope(rms_norm(k, k_norm), cos, sin)
    G = ATTN_HEADS // ATTN_KV_HEADS
    nb = S // Q_BLOCK
    qb = q.reshape(B, nb, Q_BLOCK, ATTN_KV_HEADS, G, HEAD_DIM).transpose(1, 0, 3, 4, 2, 5)
    scale = HEAD_DIM ** -0.5

    def block(q_blk):
        s = jnp.einsum('bkgqd,bskd->bkgqs', q_blk, k, preferred_element_type=jnp.float32) * scale
        p = jax.nn.softmax(s, axis=-1).astype(v.dtype)
        return jnp.einsum('bkgqs,bskd->bkgqd', p, v)

    o = lax.map(block, qb)
    return o.transpose(1, 0, 4, 2, 3, 5).reshape(B, S, ATTN_WIDTH)


def hier_moe(x, wg, bg, we, be, w_gate, w_up, w_down):
    B, S, D = x.shape
    N = B * S
    xt = x.reshape(N, D)
    glog = (xt @ wg).astype(jnp.float32) + bg
    grp = jnp.argmax(glog, -1)
    g_w = jnp.take_along_axis(jax.nn.softmax(glog, -1), grp[:, None], 1)
    elog = ((xt @ we).astype(jnp.float32) + be).reshape(N, N_GROUPS, EXPERTS_PER_GROUP)
    elog = jnp.take_along_axis(elog, grp[:, None, None], 1)[:, 0]
    top_v, top_i = lax.top_k(elog, TOP_K)
    gates = jax.nn.softmax(top_v, -1) * g_w
    eid = grp[:, None] * EXPERTS_PER_GROUP + top_i
    M = N * TOP_K
    e_flat = eid.reshape(M)
    tok = jnp.repeat(jnp.arange(N, dtype=jnp.int32), TOP_K)
    gate_flat = gates.reshape(M)
    order = jnp.argsort(e_flat)
    e_sorted = e_flat[order]
    counts = jnp.bincount(e_flat, length=N_EXPERTS)
    padded = (counts + MOE_BLOCK - 1) // MOE_BLOCK * MOE_BLOCK
    start = jnp.cumsum(counts) - counts
    ends_p = jnp.cumsum(padded)
    pstart = ends_p - padded
    dest = pstart[e_sorted] + jnp.arange(M) - start[e_sorted]
    n_blocks = -(-(M + N_EXPERTS * (MOE_BLOCK - 1)) // MOE_BLOCK)
    P = n_blocks * MOE_BLOCK
    row_tok = jnp.full((P,), N, jnp.int32).at[dest].set(tok[order])
    row_gate = jnp.zeros((P,), jnp.float32).at[dest].set(gate_flat[order])
    block_exp = jnp.minimum(
        jnp.searchsorted(ends_p, jnp.arange(n_blocks) * MOE_BLOCK, side='right'), N_EXPERTS - 1)
    x_pad = jnp.concatenate([xt, jnp.zeros((1, D), xt.dtype)], 0)
    xs = x_pad[row_tok].reshape(n_blocks, MOE_BLOCK, D)

    def expert_block(args):
        xb, e = args
        h = jax.nn.silu(xb @ w_gate[e]) * (xb @ w_up[e])
        return h @ w_down[e]

    ys = lax.map(expert_block, (xs, block_exp)).reshape(P, D)
    ys = ys * row_gate[:, None].astype(ys.dtype)
    out = jnp.zeros((N + 1, D), ys.dtype).at[row_tok].add(ys)[:N]
    return out.reshape(B, S, D)


def setup_inputs(seed: int = 0) -> dict:
    key = jax.random.key(seed)
    ks = iter(jax.random.split(key, 40))
    L, D = DEPTH, D_MODEL

    def nrm(shape, scale):
        return jax.random.normal(next(ks), shape, jnp.float32) * scale

    def unif(shape, lo, hi):
        return jax.random.uniform(next(ks), shape, jnp.float32, minval=lo, maxval=hi)

    return {
        "x": nrm((BATCH, SEQ, D), 1.0),
        "w_in": nrm((L, D, IN_WIDTH), D ** -0.5),
        "mu_prev": unif((L, RWKV_IN), 0.0, 0.5),
        "mu_next": unif((L, RWKV_IN), 0.0, 0.5),
        "pool_w": nrm((L, len(POOL_WINDOWS), POOL_GROUP, POOL_GROUP), POOL_GROUP ** -0.5),
        "pool_scale": 1.0 + nrm((L, POOL_WIDTH), 0.1),
        "rw_w0": nrm((L, 2, RWKV_WIDTH), 1.0) - 0.5,
        "rw_w_up": nrm((L, 2, DECAY_LORA, RWKV_WIDTH), 0.1),
        "rw_a0": nrm((L, 2, RWKV_WIDTH), 0.5),
        "rw_a_up": nrm((L, 2, AAA_LORA, RWKV_WIDTH), AAA_LORA ** -0.5),
        "rw_g_up": nrm((L, GATE_LORA, RWKV_WIDTH), GATE_LORA ** -0.5),
        "rw_k_k": 0.85 + nrm((L, RWKV_WIDTH), 0.05),
        "rw_k_a": 1.0 + nrm((L, RWKV_WIDTH), 0.05),
        "rw_r_k": nrm((L, RWKV_HEADS, HEAD_DIM), 0.1),
        "rw_gn_g": 1.0 + nrm((L, RWKV_WIDTH), 0.05),
        "rw_gn_b": nrm((L, RWKV_WIDTH), 0.02),
        "q_norm": 1.0 + nrm((L, HEAD_DIM), 0.05),
        "k_norm": 1.0 + nrm((L, HEAD_DIM), 0.05),
        "w_o": nrm((L, D, D), D ** -0.5 * DEEPNORM_BETA),
        "ln1_g": 1.0 + nrm((L, D), 0.05),
        "ln1_b": nrm((L, D), 0.02),
        "router_group": nrm((L, D, N_GROUPS), D ** -0.5),
        "router_group_b": nrm((L, N_GROUPS), 0.01),
        "router_expert": nrm((L, D, N_EXPERTS), D ** -0.5),
        "router_expert_b": nrm((L, N_EXPERTS), 0.01),
        "exp_gate": nrm((L, N_EXPERTS, D, EXPERT_HIDDEN), D ** -0.5),
        "exp_up": nrm((L, N_EXPERTS, D, EXPERT_HIDDEN), D ** -0.5),
        "exp_down": nrm((L, N_EXPERTS, EXPERT_HIDDEN, D), EXPERT_HIDDEN ** -0.5 * DEEPNORM_BETA),
        "ln2_g": 1.0 + nrm((L, D), 0.05),
        "ln2_b": nrm((L, D), 0.02),
    }


def reference(x, w_in, mu_prev, mu_next, pool_w, pool_scale, rw_w0, rw_w_up, rw_a0, rw_a_up,
              rw_g_up, rw_k_k, rw_k_a, rw_r_k, rw_gn_g, rw_gn_b, q_norm, k_norm, w_o,
              ln1_g, ln1_b, router_group, router_group_b, router_expert, router_expert_b,
              exp_gate, exp_up, exp_down, ln2_g, ln2_b):
    S = x.shape[1]
    cos, sin = axial_rope_tables(S)
    a0_end = POOL_WIDTH
    b0_end = POOL_WIDTH + RWKV_IN
    for l in range(DEPTH):
        proj = x @ w_in[l]
        y_pool = multiscale_pool(proj[..., :a0_end], pool_w[l], pool_scale[l])
        rw_in = centred_token_shift(proj[..., a0_end:b0_end], mu_prev[l], mu_next[l])
        y_rwkv = rwkv7_bidir(rw_in, rw_w0[l], rw_w_up[l], rw_a0[l], rw_a_up[l], rw_g_up[l],
                             rw_k_k[l], rw_k_a[l], rw_r_k[l], rw_gn_g[l], rw_gn_b[l])
        y_attn = gqa_axial(proj[..., b0_end:], q_norm[l], k_norm[l], cos, sin)
        y = jnp.concatenate([y_pool, y_rwkv, y_attn], -1) @ w_o[l]
        x = layer_norm(DEEPNORM_ALPHA * x + y, ln1_g[l], ln1_b[l])
        m = hier_moe(x, router_group[l], router_group_b[l], router_expert[l], router_expert_b[l],
                     exp_gate[l], exp_up[l], exp_down[l])
        x = layer_norm(DEEPNORM_ALPHA * x + m, ln2_g[l], ln2_b[l])
    return x
```

```cpp
#include <hip/hip_runtime.h>
#include <hip/hip_cooperative_groups.h>
#include <hip/hip_bf16.h>
#include <cstdio>
#include <cstdint>
namespace cg = cooperative_groups;

#ifndef MK_MULTI
#define MK_MULTI 0
#endif
#ifndef PROBE_DUP
#define PROBE_DUP 0
#endif
#ifndef PROBE_PREPDRY
#define PROBE_PREPDRY 1
#endif
#ifndef PROBE_X
#define PROBE_X 0
#endif
#ifndef PHMASK
#define PHMASK 1023
#endif
#ifndef MK_ALLCG
#define MK_ALLCG 0
#endif

#define GAS __attribute__((address_space(1)))
#define LAS __attribute__((address_space(3)))
typedef unsigned short bf16_t;
typedef short bf16x8 __attribute__((ext_vector_type(8)));
typedef float f32x4 __attribute__((ext_vector_type(4)));
typedef float f32x2 __attribute__((ext_vector_type(2)));
typedef float f32x16 __attribute__((ext_vector_type(16)));
typedef unsigned u32x4 __attribute__((ext_vector_type(4)));
typedef unsigned u32x2 __attribute__((ext_vector_type(2)));
typedef __bf16 bf16x2_t __attribute__((ext_vector_type(2)));

constexpr int NB = 16, SEQ = 2048, DM = 1024, NTOK = NB * SEQ, DEPTH = 4;
constexpr int INW = 1984, INP = 2048;
constexpr int C_RW = 256, C_Q = 1216, C_K = 1728, C_V = 1856;
constexpr int NEXP = 32, EH = 512;
constexpr float ALPHA = 1.6817928305074290f;
constexpr float LN_EPS = 1e-5f, GN_EPS = 64e-5f, QK_EPS = 1e-6f;
constexpr float QSCALE = 0.125f * 1.4426950408889634f;
constexpr int NWAVES = 8, NTHR = 512;
constexpr int LDS_BYTES = 163840;
constexpr int LISTCAP = 32768;

constexpr size_t MiB = 1u << 20;
constexpr size_t WS_CTL = 0, CTL_ZERO_BYTES = 1 * MiB;
constexpr size_t WS_SMALL = 1 * MiB;
constexpr size_t WS_WGU = 10 * MiB, WS_WD = 74 * MiB;
constexpr size_t WS_WIN = 983 * MiB  , WS_WO = 999 * MiB  ;
constexpr size_t WS_REC = 106 * MiB;
constexpr size_t WS_XN = 320 * MiB, WS_MIX = 384 * MiB, WS_PROJ = 448 * MiB;
constexpr size_t WS_R = 576 * MiB, WS_V = 592 * MiB, WS_KK = 608 * MiB, WS_KH = 624 * MiB  , WS_B = 656 * MiB  ;
constexpr size_t WS_G = 688 * MiB, WS_BON = 704 * MiB, WS_W = 720 * MiB  , WS_WKV = 784 * MiB  ;
constexpr size_t WS_LIST = 848 * MiB  , WS_GATE = 852 * MiB  ;
constexpr size_t WS_H = 106 * MiB  , WS_Y = 180 * MiB  ;
constexpr size_t WS_Z = 853 * MiB  , WS_STAT = 981 * MiB  , WS_RWB = 982 * MiB  ;
constexpr size_t WS_RB = 981 * MiB + 512 * 1024;
constexpr size_t WS_GLIST = 1007 * MiB;
constexpr size_t WS_END = 1014 * MiB;
constexpr size_t SM_ROPE = 0;
constexpr size_t SM_PWT = 16384;
constexpr size_t SM_WUPT = SM_PWT + 131072;
constexpr size_t SM_AUPT = SM_WUPT + 131072;
constexpr size_t SM_GUPT = SM_AUPT + 131072;
constexpr size_t SM_RWT = SM_GUPT + 131072;
static_assert(SM_RWT + 589824 <= 3 * MiB, "small region");
constexpr int CW_BAR = 4096;
constexpr int CW_CNT = 16384;
#define PT_I0 ((int)((unsigned)(NTOK / 64) * st[3] / (unsigned)G + st[2]))
#define PT_IHI ((int)((unsigned)(NTOK / 64) * (st[3] + st[4]) / (unsigned)G))
#define PT_STEP ((int)st[4])
#ifndef HANDOFF_SEAMS
#define HANDOFF_SEAMS 0x13
#endif
#ifndef PROBE_KEEPBAR
#define PROBE_KEEPBAR 0
#endif
constexpr int CW_PAN = 122880;
constexpr int CW_MH = 49152;
constexpr int CW_AQ = 20480;

__device__ __forceinline__ unsigned cvtpk(float lo, float hi) { f32x2 v = {lo, hi}; bf16x2_t b = __builtin_convertvector(v, bf16x2_t); return __builtin_bit_cast(unsigned, b); }
__device__ __forceinline__ float bflo(unsigned w) { return __uint_as_float(w << 16); }
__device__ __forceinline__ float bfhi(unsigned w) { return __uint_as_float(w & 0xffff0000u); }
__device__ __forceinline__ float sigmoidf_(float x) { return __builtin_amdgcn_rcpf(1.f + __expf(-x)); }
#define DPP_ADD(v, ctrl) ((v) + __builtin_bit_cast(float, __builtin_amdgcn_update_dpp(0, __builtin_bit_cast(int, (v)), (ctrl), 0xF, 0xF, true)))
__device__ __forceinline__ float red16(float v) {
    v = DPP_ADD(v, 0xB1); v = DPP_ADD(v, 0x4E); v = DPP_ADD(v, 0x141); v = DPP_ADD(v, 0x140); return v;
}
__device__ __forceinline__ float wave_sum(float v) { v = red16(v); v += __shfl_xor(v, 16); v += __shfl_xor(v, 32); return v; }

__device__ __forceinline__ void wait_count(const unsigned* p, unsigned need, unsigned* tmo) {
    unsigned v, sp = 0;
    for (;;) {
        asm volatile("s_load_dword %0, %1, 0x0 glc\n\ts_waitcnt lgkmcnt(0)" : "=s"(v) : "s"(p) : "memory");
        if (v >= need) break;
        if (++sp > 4000000u) { if ((threadIdx.x & 63) == 0) __hip_atomic_store(tmo, 1u, __ATOMIC_RELAXED, __HIP_MEMORY_SCOPE_AGENT); break; }
        __builtin_amdgcn_s_sleep(2); }
}
namespace pg8 {
constexpr int BM = 256, BK = 64, HALF = 128, HTB = HALF * BK * 2, STAGE_BYTES = 8 * HTB, NXCD = 8, WGM = 8;
__device__ __forceinline__ int lds_byte(int r, int c) { const int st = (r >> 4) * 2 + (c >> 5), rr = r & 15, cc = c & 31, ob = rr * 64 + cc * 2; return st * 1024 + (ob ^ (((ob >> 9) & 1) << 5)); }
__device__ __forceinline__ void stage_rc(int b, int& R, int& C) { const int st = b / 1024, sb = b % 1024, swz = sb ^ (((sb >> 9) & 1) << 5); R = (st >> 1) * 16 + swz / 64; C = (st & 1) * 32 + (swz % 64) / 2; }
__device__ __forceinline__ int perm32(int rho) { const int n = rho >> 4, i = rho & 15; return 8 * (i >> 2) + 4 * n + (i & 3); }
struct Unit { int pm, pn; };

struct OrderBase {
    int nM, nN, nwg, G, c;
    __device__ __forceinline__ void init(int nM_, int nN_, int G_, int c_) { nM = nM_; nN = nN_; nwg = nM * nN; G = G_; c = c_; }
    __device__ __forceinline__ bool next(int i, Unit& u) const {
        const long L = (long)i * G + c; if (L >= nwg) return false;
        int wgid = (int)L; { const int q = nwg / NXCD, r = nwg % NXCD, xcd = wgid % NXCD, off = wgid / NXCD; wgid = (xcd < r ? xcd * (q + 1) : r * (q + 1) + (xcd - r) * q) + off; }
        const int nig = WGM * nN, gid = wgid / nig, fm = gid * WGM, gsz = (nM - fm) < WGM ? (nM - fm) : WGM;
        u.pm = fm + ((wgid % nig) % gsz); u.pn = (wgid % nig) / gsz; return true;
    }
    __device__ __forceinline__ void a_ready(const Unit&) const {}
};
struct DenseOrder : OrderBase {
    const char* Bt; int Kb;
    __device__ __forceinline__ unsigned arow(const Unit& u, int r) const { return (unsigned)(u.pm * BM + r); }
    __device__ __forceinline__ const char* bptr(const Unit& u) const { return Bt + (size_t)u.pn * BM * Kb; }
};
struct XDenseOrder {
    const char* Bt; int Kb; int nN, p0, pc, rank, nloc;
    const unsigned* pcnt = nullptr; unsigned need = 0; unsigned* tmo = nullptr;
    __device__ __forceinline__ void init_xcd(int nM, int nN_, int Gt, volatile LAS unsigned* st) {
        const unsigned P = st[3], n = st[4]; nN = nN_;
        p0 = (int)((unsigned)nM * P / (unsigned)Gt); pc = (int)((unsigned)nM * (P + n) / (unsigned)Gt) - p0; rank = (int)st[2]; nloc = (int)n;
    }
    __device__ __forceinline__ bool next(int i, Unit& u) const {
        const int j = rank + nloc * i; if (j >= pc * nN) return false;
        const int nig = 8 * nN, fm = (j / nig) * 8, gsz = (pc - fm) < 8 ? (pc - fm) : 8, jj = j % nig;
        u.pm = p0 + fm + jj % gsz; u.pn = jj / gsz; return true;
    }
    __device__ __forceinline__ unsigned arow(const Unit& u, int r) const { return (unsigned)(u.pm * BM + r); }
    __device__ __forceinline__ const char* bptr(const Unit& u) const { return Bt + (size_t)u.pn * BM * Kb; }
    __device__ __forceinline__ void a_ready(const Unit& u) const { if (pcnt) wait_count(pcnt + 16 * u.pm, need, tmo); }
};
struct MoeOrder {
    const LAS int* tab; const GAS int* list; const char* wbase; size_t wstride; int Kb; int gather;
    int t0, tcnt, rank, nloc;
    __device__ __forceinline__ void init_xcd(int T, int Gt, volatile LAS unsigned* st) {
        const unsigned P = st[3], n = st[4];
        t0 = (int)((unsigned)T * P / (unsigned)Gt); tcnt = (int)((unsigned)T * (P + n) / (unsigned)Gt) - t0; rank = (int)st[2]; nloc = (int)n;
    }
    __device__ __forceinline__ bool next(int i, Unit& u) const {
        const int j = rank + nloc * i; if (j >= tcnt * 4) return false;
        const int fm = (j >> 5) * 8, gsz = (tcnt - fm) < 8 ? (tcnt - fm) : 8;
        u.pm = t0 + fm + (j & 31) % gsz; u.pn = (j & 31) / gsz; return true;
    }
    const unsigned* hcnt = nullptr; unsigned* tmo = nullptr;
    __device__ __forceinline__ void a_ready(const Unit& u) const {
        if (!hcnt) return;
        const unsigned* p = hcnt + 64 * u.pm; unsigned v, sp = 0;
        for (;;) {
            asm volatile("s_load_dword %0, %1, 0x0 glc\n\ts_waitcnt lgkmcnt(0)" : "=s"(v) : "s"(p) : "memory");
            if (v >= 32u) break;
            if (++sp > 4000000u) { if ((threadIdx.x & 63) == 0) __hip_atomic_store(tmo, 1u, __ATOMIC_RELAXED, __HIP_MEMORY_SCOPE_AGENT); break; }
            __builtin_amdgcn_s_sleep(2); }
    }
    __device__ __forceinline__ unsigned arow(const Unit& u, int r) const {
        if (!gather) return (unsigned)(u.pm * BM + r);
        const int e = tab[128 + u.pm]; const int pos = (u.pm - tab[e]) * BM + r;
        return pos < tab[64 + e] ? (unsigned)(list[e * LISTCAP + pos] >> 1) : 0u;
    }
    __device__ __forceinline__ const char* bptr(const Unit& u) const { const int e = tab[128 + u.pm]; return wbase + (size_t)e * wstride + (size_t)u.pn * BM * Kb; }
};

struct EpiProj {
    static constexpr bool PERM = true;
    bf16_t* O; int ldc; unsigned* pcnt;
    __device__ __forceinline__ void publish(int pm) const { if ((threadIdx.x & 63) == 0) __hip_atomic_fetch_add(pcnt + 16 * pm, 1u, __ATOMIC_RELAXED, __HIP_MEMORY_SCOPE_AGENT); }
    __device__ __forceinline__ void operator()(const f32x4 (&acc)[2][2][4][2], const Unit& u, int wr, int wc, int fr, int fq) const {
        const int row0 = u.pm * BM + wr * 64 + fr, col0 = u.pn * BM + wc * 32 + 8 * fq;
#pragma unroll
        for (int ai = 0; ai < 2; ++ai)
#pragma unroll
            for (int m = 0; m < 4; ++m) { bf16_t* rowp = O + (size_t)(row0 + ai * HALF + m * 16) * ldc + col0;
#pragma unroll
                for (int bj = 0; bj < 2; ++bj) { const f32x4 v0 = acc[ai][bj][m][0], v1 = acc[ai][bj][m][1];
                    u32x4 w; w.x = cvtpk(v0[0], v0[1]); w.y = cvtpk(v0[2], v0[3]); w.z = cvtpk(v1[0], v1[1]); w.w = cvtpk(v1[2], v1[3]);
                    *(GAS u32x4*)(rowp + bj * HALF) = w; } }
    }
};
struct EpiRes {
    static constexpr bool PERM = false;
    const bf16_t* base; float* out; int dry; unsigned* pcnt;
    __device__ __forceinline__ void publish(int pm) const { if ((threadIdx.x & 63) == 0) __hip_atomic_fetch_add(pcnt + 16 * pm, 1u, __ATOMIC_RELAXED, __HIP_MEMORY_SCOPE_AGENT); }
    __device__ __forceinline__ void operator()(const f32x4 (&acc)[2][2][4][2], const Unit& u, int wr, int wc, int fr, int fq) const {
        const int row0 = u.pm * BM + wr * 64 + fr, col0 = u.pn * BM + wc * 32 + 4 * fq;
#pragma unroll
        for (int ai = 0; ai < 2; ++ai) {
            u32x2 bw[4][2][2];
#pragma unroll
            for (int m = 0; m < 4; ++m)
#pragma unroll
                for (int bj = 0; bj < 2; ++bj)
#pragma unroll
                    for (int n = 0; n < 2; ++n) bw[m][bj][n] = *(const GAS u32x2*)(base + (size_t)(row0 + ai * HALF + m * 16) * DM + col0 + bj * HALF + n * 16);
#pragma unroll
            for (int m = 0; m < 4; ++m) { const size_t off = (size_t)(row0 + ai * HALF + m * 16) * DM + col0;
#pragma unroll
                for (int bj = 0; bj < 2; ++bj)
#pragma unroll
                    for (int n = 0; n < 2; ++n) { const u32x2 w = bw[m][bj][n];
                        const f32x4 bs = {__uint_as_float(w.x << 16), __uint_as_float(w.x & 0xffff0000u), __uint_as_float(w.y << 16), __uint_as_float(w.y & 0xffff0000u)};
                        if (!dry) *(GAS f32x4*)(out + off + bj * HALF + n * 16) = bs * ALPHA + acc[ai][bj][m][n]; } }
            asm volatile("" ::: "memory"); }
    }
};
struct EpiMoe1 {
    static constexpr bool PERM = true;
    bf16_t* H; unsigned* hcnt;
    __device__ __forceinline__ void operator()(const f32x4 (&acc)[2][2][4][2], const Unit& u, int wr, int wc, int fr, int fq) const {
        const int row0 = u.pm * BM + wr * 64 + fr, col0 = u.pn * HALF + wc * 32 + 8 * fq;
#pragma unroll
        for (int ai = 0; ai < 2; ++ai)
#pragma unroll
            for (int m = 0; m < 4; ++m) { bf16_t* rowp = H + (size_t)(row0 + ai * HALF + m * 16) * EH + col0;
                float h[8];
#pragma unroll
                for (int n = 0; n < 2; ++n)
#pragma unroll
                    for (int j = 0; j < 4; ++j) { const float g = acc[ai][0][m][n][j], up = acc[ai][1][m][n][j]; h[n * 4 + j] = g * __builtin_amdgcn_rcpf(1.f + __expf(-g)) * up; }
                u32x4 w; w.x = cvtpk(h[0], h[1]); w.y = cvtpk(h[2], h[3]); w.z = cvtpk(h[4], h[5]); w.w = cvtpk(h[6], h[7]);
                *(GAS u32x4*)rowp = w; }
    }
    __device__ __forceinline__ void publish(int pm) const { if (hcnt && (threadIdx.x & 63) == 0) __hip_atomic_fetch_add(hcnt + 64 * pm, 1u, __ATOMIC_RELAXED, __HIP_MEMORY_SCOPE_AGENT); }
};
struct EpiMoe2 {
    __device__ __forceinline__ void publish(int) const {}
    static constexpr bool PERM = true;
    bf16_t* Y; const LAS int* tab; const GAS int* list; const GAS float* glist;
    __device__ __forceinline__ void operator()(const f32x4 (&acc)[2][2][4][2], const Unit& u, int wr, int wc, int fr, int fq) const {
        const int e = tab[128 + u.pm], pos0 = (u.pm - tab[e]) * BM + wr * 64 + fr, cnt = tab[64 + e], col0 = u.pn * BM + wc * 32 + 8 * fq;
        int pr[8]; float gv[8];
#pragma unroll
        for (int i = 0; i < 8; ++i) { const int pos = pos0 + (i >> 2) * HALF + (i & 3) * 16, pc = pos < cnt ? pos : cnt - 1;
            pr[i] = list[e * LISTCAP + pc]; gv[i] = glist[e * LISTCAP + pc]; }
#pragma unroll
        for (int ai = 0; ai < 2; ++ai)
#pragma unroll
            for (int m = 0; m < 4; ++m) { const int pos = pos0 + ai * HALF + m * 16;
                if (pos < cnt) { const float gt = gv[ai * 4 + m]; bf16_t* rowp = Y + (size_t)pr[ai * 4 + m] * DM + col0;
#pragma unroll
                    for (int bj = 0; bj < 2; ++bj) { const f32x4 v0 = acc[ai][bj][m][0] * gt, v1 = acc[ai][bj][m][1] * gt;
                        u32x4 w; w.x = cvtpk(v0[0], v0[1]); w.y = cvtpk(v0[2], v0[3]); w.z = cvtpk(v1[0], v1[1]); w.w = cvtpk(v1[2], v1[3]);
                        *(GAS u32x4*)(rowp + bj * HALF) = w; } } }
    }
};

template <class Epi, class Sched>
__device__ __forceinline__ void gemm_phase(LAS unsigned char* lds, const char* A, const int K, const Sched& S, const Epi& E) {
    int tid_ = threadIdx.x; asm volatile("" : "+v"(tid_)); const int tid = tid_, wid = __builtin_amdgcn_readfirstlane(tid >> 6), lane = tid & 63, wr = wid >> 2, wc = wid & 3, fr = lane & 15, fq = lane >> 4;
    const int nt = K / BK; const unsigned Kb = (unsigned)K * 2u;
    int Rr[2]; unsigned Cb[2], voffB[2];
#pragma unroll
    for (int i = 0; i < 2; ++i) { int R, C; stage_rc(tid * 16 + i * 8192, R, C); const int Rb = Epi::PERM ? ((R & ~31) + perm32(R & 31)) : R;
        Rr[i] = R; Cb[i] = (unsigned)C * 2u; voffB[i] = (unsigned)(Rb * K + C) * 2u; }
    const size_t kstep = (size_t)(BK * 2);
    const size_t hstep = (size_t)HALF * K * 2;
    const unsigned ldsw = (unsigned)wid * 1024u;
    const int aoff = lds_byte(wr * 64 + fr, fq * 8), boff = lds_byte(wc * 32 + fr, fq * 8);
#define PG8_SA(b, h) (((b) * 2 + (h)) * HTB)
#define PG8_SB(b, h) ((4 + (b) * 2 + (h)) * HTB)
#define PG8_STAGE(bufoff, gbase, voff) do { _Pragma("unroll") for (int _i = 0; _i < 2; ++_i) \
        __builtin_amdgcn_global_load_lds((const unsigned*)((const char*)(gbase) + (voff)[_i]), (LAS unsigned*)(lds + (bufoff) + ldsw + _i * 8192), 16, 0, 0); } while (0)
#define PG8_STAGEA(bufoff, arr, h, kb) do { _Pragma("unroll") for (int _i = 0; _i < 2; ++_i) \
        __builtin_amdgcn_global_load_lds((const unsigned*)((A + (size_t)(kb)) + (arr)[h][_i]), (LAS unsigned*)(lds + (bufoff) + ldsw + _i * 8192), 16, 0, 0); } while (0)
#define PG8_SETA(arr, u) do { _Pragma("unroll") for (int _h = 0; _h < 2; ++_h) _Pragma("unroll") for (int _i = 0; _i < 2; ++_i) (arr)[_h][_i] = S.arow((u), _h * HALF + Rr[_i]) * Kb + Cb[_i]; } while (0)
#define PG8_LDA(dst, b, h) do { _Pragma("unroll") for (int m = 0; m < 4; ++m) _Pragma("unroll") for (int k = 0; k < 2; ++k) dst[m][k] = *(const LAS bf16x8*)(lds + PG8_SA(b, h) + aoff + m * 2048 + k * 1024); } while (0)
#define PG8_LDB(dst, b, h) do { _Pragma("unroll") for (int n = 0; n < 2; ++n) _Pragma("unroll") for (int k = 0; k < 2; ++k) dst[n][k] = *(const LAS bf16x8*)(lds + PG8_SB(b, h) + boff + n * 2048 + k * 1024); } while (0)
#define PG8_MMA(ai, bj, At, Bt) do { __builtin_amdgcn_s_setprio(1); _Pragma("unroll") for (int m = 0; m < 4; ++m) _Pragma("unroll") for (int n = 0; n < 2; ++n) _Pragma("unroll") for (int k = 0; k < 2; ++k) \
        acc[ai][bj][m][n] = __builtin_amdgcn_mfma_f32_16x16x32_bf16(Bt[n][k], At[m][k], acc[ai][bj][m][n], 0, 0, 0); __builtin_amdgcn_s_setprio(0); } while (0)
#define PG8_WAIT_V(n) asm volatile("s_waitcnt vmcnt(" #n ")" ::: "memory")
#define PG8_WAIT_L(n) asm volatile("s_waitcnt lgkmcnt(" #n ")" ::: "memory")
#define PG8_BAR __builtin_amdgcn_s_barrier()
#define PG8_SCHED __builtin_amdgcn_sched_barrier(0)
    Unit cur, nxt; int ui = 0;
    if (!S.next(0, cur)) return;
    f32x4 acc[2][2][4][2];
#pragma unroll
    for (int a = 0; a < 2; ++a)
#pragma unroll
        for (int b = 0; b < 2; ++b)
#pragma unroll
            for (int m = 0; m < 4; ++m)
#pragma unroll
                for (int n = 0; n < 2; ++n) acc[a][b][m][n] = (f32x4){0.f, 0.f, 0.f, 0.f};
    bf16x8 At[4][2], B0[2][2], B1[2][2];
    unsigned ac[2][2], an[2][2];
    int ppm = -1;
    S.a_ready(cur);
    PG8_SETA(ac, cur);
    const char* cB = S.bptr(cur);
    PG8_STAGE(PG8_SB(0, 0), cB, voffB); PG8_STAGE(PG8_SB(0, 1), cB + hstep, voffB); PG8_STAGEA(PG8_SA(0, 0), ac, 0, 0); PG8_STAGEA(PG8_SA(0, 1), ac, 1, 0);
    if (wr == 1) PG8_BAR;
    PG8_WAIT_V(2); PG8_BAR;
    PG8_STAGE(PG8_SB(1, 0), cB + kstep, voffB); PG8_STAGEA(PG8_SA(1, 0), ac, 0, kstep); PG8_STAGE(PG8_SB(1, 1), cB + hstep + kstep, voffB);
    PG8_WAIT_V(6); PG8_BAR;
    for (;;) {
        const bool has_next = S.next(ui + 1, nxt);
        const char* nB = cB;
        if (has_next) { PG8_SETA(an, nxt); nB = S.bptr(nxt); }
        else {
#pragma unroll
            for (int h = 0; h < 2; ++h)
#pragma unroll
                for (int i = 0; i < 2; ++i) an[h][i] = ac[h][i]; }
        for (int t = 0; t < nt; t += 2) {
            const bool last = (t == nt - 2);
            if (last && has_next) S.a_ready(nxt);
            const size_t k1 = (size_t)(t + 1) * kstep;
            const size_t k2 = last ? 0 : (size_t)(t + 2) * kstep, k3 = k2 + kstep;
            const char* b2 = last ? nB : cB + (size_t)(t + 2) * kstep; const char* b3 = b2 + kstep;
            unsigned a2[2][2];
#pragma unroll
            for (int h = 0; h < 2; ++h)
#pragma unroll
                for (int i = 0; i < 2; ++i) a2[h][i] = last ? an[h][i] : ac[h][i];
            PG8_LDB(B0, 0, 0); PG8_LDB(B1, 0, 1); PG8_SCHED; PG8_LDA(At, 0, 0); PG8_STAGEA(PG8_SA(1, 1), ac, 1, k1);
            PG8_WAIT_V(8); PG8_WAIT_L(0); PG8_BAR; PG8_MMA(0, 0, At, B0); PG8_MMA(0, 1, At, B1); PG8_BAR; PG8_SCHED;
            PG8_LDA(At, 0, 1); PG8_STAGE(PG8_SB(0, 0), b2, voffB); PG8_STAGE(PG8_SB(0, 1), b2 + hstep, voffB); PG8_STAGEA(PG8_SA(0, 0), a2, 0, k2);
            PG8_WAIT_V(8); PG8_WAIT_L(0); PG8_BAR; PG8_MMA(1, 0, At, B0); PG8_MMA(1, 1, At, B1); PG8_BAR; PG8_SCHED;
            PG8_LDB(B0, 1, 0); PG8_LDB(B1, 1, 1); PG8_SCHED; PG8_LDA(At, 1, 0); PG8_STAGEA(PG8_SA(0, 1), a2, 1, k2);
            PG8_WAIT_V(8); PG8_WAIT_L(0); PG8_BAR; PG8_MMA(0, 0, At, B0); PG8_MMA(0, 1, At, B1); PG8_BAR; PG8_SCHED;
            PG8_LDA(At, 1, 1); PG8_STAGE(PG8_SB(1, 0), b3, voffB); PG8_STAGE(PG8_SB(1, 1), b3 + hstep, voffB); PG8_STAGEA(PG8_SA(1, 0), a2, 0, k3);
            PG8_WAIT_V(8); PG8_WAIT_L(0); PG8_BAR; PG8_MMA(1, 0, At, B0); PG8_MMA(1, 1, At, B1); PG8_BAR; PG8_SCHED;
        }
        if (wr == 0) PG8_BAR;
        E(acc, cur, wr, wc, fr, fq);
        if (ppm >= 0) E.publish(ppm);
        ppm = cur.pm;
        if (!has_next) break;
#pragma unroll
        for (int a = 0; a < 2; ++a)
#pragma unroll
            for (int b = 0; b < 2; ++b)
#pragma unroll
                for (int m = 0; m < 4; ++m)
#pragma unroll
                    for (int n = 0; n < 2; ++n) acc[a][b][m][n] = (f32x4){0.f, 0.f, 0.f, 0.f};
        cur = nxt; cB = nB; ++ui;
#pragma unroll
        for (int h = 0; h < 2; ++h)
#pragma unroll
            for (int i = 0; i < 2; ++i) ac[h][i] = an[h][i];
        if (wr == 1) PG8_BAR;
    }
    PG8_WAIT_V(0);
    if (ppm >= 0) E.publish(ppm);
    PG8_BAR;
#undef PG8_SA
#undef PG8_SB
#undef PG8_STAGE
#undef PG8_STAGEA
#undef PG8_SETA
#undef PG8_LDA
#undef PG8_LDB
#undef PG8_MMA
#undef PG8_WAIT_V
#undef PG8_WAIT_L
#undef PG8_BAR
#undef PG8_SCHED
}
}

namespace attn_body {
using bf16 = __hip_bfloat16;
using bf16x8 = __attribute__((ext_vector_type(8))) short;
using s16x4 = __attribute__((ext_vector_type(4))) short;
using f32x16 = __attribute__((ext_vector_type(16))) float;
using u32x4 = __attribute__((ext_vector_type(4))) unsigned;
constexpr int D = 64, QP = INP, KP = INP, VP = INP, OP = DM;
constexpr int NW = 8, QBLK = 32, QB = QBLK * NW, KVBLK = 64;
__device__ __forceinline__ int crow(int r, int hi) { return (r & 3) + 8 * (r >> 2) + 4 * hi; }
#define SBAR() __builtin_amdgcn_sched_barrier(0)
constexpr int NSLOT = 3, SLOTB = 8192;
constexpr int LDS_K = 0, LDS_V = NSLOT * SLOTB, LDS_WS = 2 * NSLOT * SLOTB, LDS_OST = LDS_WS + NW * 64 * 4, LDS_BYTES_A = LDS_OST + NW * 4096;
__device__ __forceinline__ void glds16(const void* gsrc, unsigned lds_dst) { unsigned keep;
  asm volatile("s_mov_b32 %0, m0\n\ts_mov_b32 m0, %2\n\ts_nop 0\n\tglobal_load_lds_dwordx4 %1, off\n\ts_mov_b32 m0, %0" : "=&s"(keep) : "v"(gsrc), "s"(lds_dst) : "memory"); }
__device__ __forceinline__ float max3f(float a, float b, float c) { float r; asm("v_max3_f32 %0, %1, %2, %3" : "=v"(r) : "v"(a), "v"(b), "v"(c)); return r; }
__device__ __forceinline__ float max2f(float a, float b) { float r; asm("v_max_f32_e32 %0, %1, %2" : "=v"(r) : "v"(a), "v"(b)); return r; }
__device__ __forceinline__ float fadd_s(float a, float b) { float r; asm("v_add_f32_e32 %0, %1, %2" : "=v"(r) : "v"(a), "v"(b)); return r; }
__device__ __forceinline__ float fsub_s(float a, float b) { float r; asm("v_sub_f32_e32 %0, %1, %2" : "=v"(r) : "v"(a), "v"(b)); return r; }
typedef float f32x2_t __attribute__((ext_vector_type(2)));
__device__ __forceinline__ unsigned cvtpk_s(float lo, float hi) { f32x2_t v = {lo, hi}; bf16x2_t b = __builtin_convertvector(v, bf16x2_t); return __builtin_bit_cast(unsigned, b); }
#define WAIT_BAR(N) asm volatile("s_waitcnt vmcnt(" #N ") lgkmcnt(0)\n\ts_barrier" ::: "memory")
__device__ __forceinline__ void qkt(f32x16& p0, f32x16& p1, const char* Kslot, const bf16x8* qr, const f32x16& negm, int r32, int hi) {
  const char* kb = Kslot + hi * 1024 + r32 * 16;
  #pragma unroll
  for (int d0 = 0; d0 < 4; ++d0) {
    const bf16x8 b0 = *reinterpret_cast<const bf16x8*>(kb + d0 * 2048);
    const bf16x8 b1 = *reinterpret_cast<const bf16x8*>(kb + d0 * 2048 + 512);
    if (d0 == 0) { p0 = __builtin_amdgcn_mfma_f32_32x32x16_bf16(b0, qr[0], negm, 0, 0, 0); p1 = __builtin_amdgcn_mfma_f32_32x32x16_bf16(b1, qr[0], negm, 0, 0, 0); }
    else { p0 = __builtin_amdgcn_mfma_f32_32x32x16_bf16(b0, qr[d0], p0, 0, 0, 0); p1 = __builtin_amdgcn_mfma_f32_32x32x16_bf16(b1, qr[d0], p1, 0, 0, 0); } }
}
typedef __attribute__((address_space(3))) const char* lds_cptr;
typedef short v4i16_t __attribute__((ext_vector_type(4)));
__device__ __forceinline__ void kload8(bf16x8* kf, lds_cptr kp) {
  kf[0] = *(const __attribute__((address_space(3))) bf16x8*)(kp);        kf[1] = *(const __attribute__((address_space(3))) bf16x8*)(kp + 512);
  kf[2] = *(const __attribute__((address_space(3))) bf16x8*)(kp + 2048); kf[3] = *(const __attribute__((address_space(3))) bf16x8*)(kp + 2560);
  kf[4] = *(const __attribute__((address_space(3))) bf16x8*)(kp + 4096); kf[5] = *(const __attribute__((address_space(3))) bf16x8*)(kp + 4608);
  kf[6] = *(const __attribute__((address_space(3))) bf16x8*)(kp + 6144); kf[7] = *(const __attribute__((address_space(3))) bf16x8*)(kp + 6656);
}
__device__ __forceinline__ void kload2(bf16x8* kf, lds_cptr kp, int j) { kf[2 * j] = *(const __attribute__((address_space(3))) bf16x8*)(kp + j * 2048); kf[2 * j + 1] = *(const __attribute__((address_space(3))) bf16x8*)(kp + j * 2048 + 512); }
__device__ __forceinline__ s16x4 vtr(lds_cptr p) { return __builtin_bit_cast(s16x4, __builtin_amdgcn_ds_read_tr16_b64_v4i16((__attribute__((address_space(3))) v4i16_t*)p)); }
__device__ __forceinline__ float rowmax(const f32x16& p0, const f32x16& p1) {
  float a = max3f(p0[0], p0[1], p1[0]), b = max3f(p0[2], p0[3], p1[1]); a = max3f(a, p1[2], p1[3]);
  #pragma unroll
  for (int r = 4; r < 16; r += 4) { a = max3f(a, p0[r], p0[r + 1]); b = max3f(b, p0[r + 2], p0[r + 3]); a = max3f(a, p1[r], p1[r + 1]); b = max3f(b, p1[r + 2], p1[r + 3]); }
  const float m = max2f(a, b);
  auto rr = __builtin_amdgcn_permlane32_swap(__float_as_uint(m), __float_as_uint(m), false, false);
  return max2f(__uint_as_float(rr[0]), __uint_as_float(rr[1]));
}
__device__ __forceinline__ void pv(f32x16* o, int vb, bf16x8 pa0, bf16x8 pa1, bf16x8 pa2, bf16x8 pa3) {
  #pragma unroll
  for (int d0 = 0; d0 < 2; ++d0) { s16x4 lo[4], hi[4];
    #pragma unroll
    for (int ks = 0; ks < 4; ++ks) {
      asm volatile("ds_read_b64_tr_b16 %0,%1 offset:%c2" : "=&v"(lo[ks]) : "v"(vb), "i"(d0 * 4096 + ks * 1024) : "memory");
      asm volatile("ds_read_b64_tr_b16 %0,%1 offset:%c2" : "=&v"(hi[ks]) : "v"(vb), "i"(d0 * 4096 + ks * 1024 + 512) : "memory"); }
    asm volatile("s_waitcnt lgkmcnt(0)" ::: "memory"); SBAR();
    #define PK(k) (bf16x8){lo[k][0], lo[k][1], lo[k][2], lo[k][3], hi[k][0], hi[k][1], hi[k][2], hi[k][3]}
    o[d0] = __builtin_amdgcn_mfma_f32_32x32x16_bf16(pa0, PK(0), o[d0], 0, 0, 0);
    o[d0] = __builtin_amdgcn_mfma_f32_32x32x16_bf16(pa1, PK(1), o[d0], 0, 0, 0);
    o[d0] = __builtin_amdgcn_mfma_f32_32x32x16_bf16(pa2, PK(2), o[d0], 0, 0, 0);
    o[d0] = __builtin_amdgcn_mfma_f32_32x32x16_bf16(pa3, PK(3), o[d0], 0, 0, 0);
    #undef PK
  }
}
#define ATTN_STORE16(p, v) (*(GAS u32x4*)(p) = (v))
template <int THRL> __device__ __forceinline__ void attn_unit(int b, int h, int kvh, int qb, const bf16* Q, const bf16* __restrict__ K, const bf16* __restrict__ V, bf16* O, char* shm) {
  int tid_ = threadIdx.x; asm volatile("" : "+v"(tid_)); const int tid = tid_, lane = tid & 63, r32 = lane & 31, hi = lane >> 5; const int wid = __builtin_amdgcn_readfirstlane(tid >> 6);
  const long rowbase = (long)b * SEQ; const int q0 = qb * QB;
  const bf16* Qw = Q + (rowbase + q0 + wid * QBLK) * QP + h * D;
  const bf16* Kh = K + rowbase * KP + kvh * D, *Vh = V + rowbase * VP + kvh * D;
  const unsigned lds0 = (unsigned)(uintptr_t)shm;
  float* wsf = (float*)(shm + LDS_WS) + wid * 64;
  const bf16* ksrc = Kh + (long)lane * KP + wid * 8;
  const bf16* vsrc = Vh + (long)(16 * (wid & 3) + (lane >> 2)) * VP + (wid >> 2) * 32 + (lane & 3) * 8;
  const unsigned kdst = lds0 + LDS_K + wid * 1024, vdst = lds0 + LDS_V + wid * 1024;
  #define DMA_K(t, slot) glds16(ksrc + (long)(t) * KVBLK * KP, (unsigned)__builtin_amdgcn_readfirstlane(kdst + (slot)))
  #define DMA_V(t, slot) glds16(vsrc + (long)(t) * KVBLK * VP, (unsigned)__builtin_amdgcn_readfirstlane(vdst + (slot)))
  const int vb0 = (int)(lds0 + LDS_V) + ((lane >> 4) & 1) * 32 + (lane & 3) * 8 + (4 * hi + ((lane & 15) >> 2)) * 64;
  const char* Kbase = shm + LDS_K; bf16x8 kf[8];
  const lds_cptr shm3 = (lds_cptr)shm; const lds_cptr kp0 = shm3 + LDS_K + hi * 1024 + r32 * 16; const lds_cptr vp0 = shm3 + LDS_V + ((lane >> 4) & 1) * 32 + (lane & 3) * 8 + (4 * hi + ((lane & 15) >> 2)) * 64;
  constexpr int NT = SEQ / KVBLK;
  DMA_K(0, 0); DMA_V(0, 0); DMA_K(1, SLOTB);
  bf16x8 qr[4];
  #pragma unroll
  for (int d0 = 0; d0 < 4; ++d0) qr[d0] = *(const GAS bf16x8*)(&Qw[(long)r32 * QP + d0 * 16 + hi * 8]);
  float mhat = 0.f, l_reg = 0.f; f32x16 o[2]; o[0] = f32x16{}; o[1] = f32x16{}; f32x16 negm = f32x16{}; asm volatile("" : "+v"(negm));
  bool resc = false;
  #define START(P0, P1) do { const float rm = rowmax(P0, P1); resc = false; \
    { const float dl = rm; mhat = fadd_s(mhat, dl); \
      _Pragma("unroll") for (int r = 0; r < 16; ++r) { P0[r] = fsub_s(P0[r], dl); P1[r] = fsub_s(P1[r], dl); } \
      _Pragma("unroll") for (int r = 0; r < 16; ++r) negm[r] = -mhat; asm volatile("" : "+v"(negm)); } \
    _Pragma("unroll") for (int r = 0; r < 16; ++r) P0[r] = __builtin_amdgcn_exp2f(P0[r]); } while (0)
  #define RESC() do { if (resc) { asm volatile("s_waitcnt lgkmcnt(0)" ::: "memory"); \
      _Pragma("unroll") for (int d_ = 0; d_ < 2; ++d_) _Pragma("unroll") for (int r = 0; r < 16; ++r) o[d_][r] *= wsf[crow(r, hi)]; } } while (0)
  f32x16 pA0 = {}, pA1 = {}, pB0 = {}, pB1 = {};
  int sl_prev = 0, sl_cur = 0, sl_next = SLOTB;
  #define ROT() do { sl_prev = sl_cur; sl_cur = sl_next; sl_next = (sl_next == (NSLOT - 1) * SLOTB) ? 0 : sl_next + SLOTB; } while (0)
  DMA_K(2, 2 * SLOTB);
  WAIT_BAR(3);
  qkt(pA0, pA1, Kbase, qr, negm, r32, hi); asm volatile("s_nop 15\n\ts_nop 7" : "+v"(pA0), "+v"(pA1));
  START(pA0, pA1);
  _Pragma("unroll") for (int r = 0; r < 16; ++r) pA1[r] = __builtin_amdgcn_exp2f(pA1[r]);
  WAIT_BAR(0);
  DMA_K(3, 0); DMA_V(1, SLOTB);
  ROT();
  kload8(kf, kp0 + sl_cur);
  WAIT_BAR(2);
  s16x4 vlo[8] = {}, vhi[8] = {}; u32x4 pw0 = {}, pw1 = {}, pw2 = {}, pw3 = {};
  #define PKW(P, B) cvtpk_s(P[B], P[B + 1])
  #define PAF(k) __builtin_bit_cast(bf16x8, pw##k)
  #define VFR(i) (bf16x8){vlo[i][0], vlo[i][1], vlo[i][2], vlo[i][3], vhi[i][0], vhi[i][1], vhi[i][2], vhi[i][3]}
  #define PIN(x) asm volatile("" : "+v"(x))
  #define MX3(a, b, c) __builtin_fmaxf(__builtin_fmaxf((a), (b)), (c))
  #define GAPA(MF, A0, A1, A2, A3, W0, W1, PW) do { MF; sacc += A0; sacc += A1; sacc += A2; sacc += A3; PIN(sacc); W0; W1; PIN(PW); SBAR(); } while (0)
  #define EX(v) __builtin_amdgcn_exp2f(v)
  #define GAPB(MF, X, B) do { MF; X[B] = EX(X[B]); X[B + 1] = EX(X[B + 1]); X[B + 2] = EX(X[B + 2]); X[B + 3] = EX(X[B + 3]); PIN(X); SBAR(); } while (0)
  #define VRD(i) do { vlo[i] = vtr(vp_ + (((i) >> 2) * 4096 + ((i) & 3) * 1024)); vhi[i] = vtr(vp_ + (((i) >> 2) * 4096 + ((i) & 3) * 1024 + 512)); } while (0)
  #define KRD(G, j) do { if (G) { kload2(kf, kp0 + sl_next, j); SBAR(); } } while (0)
  #define STEP(C0, C1, P0, P1, t, GK, GV, GL) do { SBAR(); \
    const lds_cptr vp_ = vp0 + sl_prev; \
    VRD(0); SBAR(); float sacc = (P0[0] + P0[1]); \
    GAPA(C0 = __builtin_amdgcn_mfma_f32_32x32x16_bf16(kf[0], qr[0], negm, 0, 0, 0), P0[2], P0[3], P0[4], P0[5],     pw0[0] = PKW(P0, 0), pw0[1] = PKW(P0, 2), pw0); \
    VRD(4); SBAR(); GAPA(C1 = __builtin_amdgcn_mfma_f32_32x32x16_bf16(kf[1], qr[0], negm, 0, 0, 0), P0[6], P0[7], P0[8], P0[9],     pw0[2] = PKW(P0, 4), pw0[3] = PKW(P0, 6), pw0); \
    VRD(1); SBAR(); GAPA(C0 = __builtin_amdgcn_mfma_f32_32x32x16_bf16(kf[2], qr[1], C0, 0, 0, 0),   P0[10], P0[11], P0[12], P0[13], pw1[0] = PKW(P0, 8), pw1[1] = PKW(P0, 10), pw1); \
    VRD(5); SBAR(); GAPA(C1 = __builtin_amdgcn_mfma_f32_32x32x16_bf16(kf[3], qr[1], C1, 0, 0, 0),   P0[14], P0[15], P1[0], P1[1],   pw1[2] = PKW(P0, 12), pw1[3] = PKW(P0, 14), pw1); \
    VRD(2); SBAR(); GAPA(C0 = __builtin_amdgcn_mfma_f32_32x32x16_bf16(kf[4], qr[2], C0, 0, 0, 0),   P1[2], P1[3], P1[4], P1[5],     pw2[0] = PKW(P1, 0), pw2[1] = PKW(P1, 2), pw2); \
    VRD(6); SBAR(); GAPA(C1 = __builtin_amdgcn_mfma_f32_32x32x16_bf16(kf[5], qr[2], C1, 0, 0, 0),   P1[6], P1[7], P1[8], P1[9],     pw2[2] = PKW(P1, 4), pw2[3] = PKW(P1, 6), pw2); \
    VRD(3); SBAR(); GAPA(C0 = __builtin_amdgcn_mfma_f32_32x32x16_bf16(kf[6], qr[3], C0, 0, 0, 0),   P1[10], P1[11], P1[12], P1[13], pw3[0] = PKW(P1, 8), pw3[1] = PKW(P1, 10), pw3); \
    VRD(7); SBAR(); GAPA(C1 = __builtin_amdgcn_mfma_f32_32x32x16_bf16(kf[7], qr[3], C1, 0, 0, 0),   P1[14], P1[15], 0.f, 0.f,       pw3[2] = PKW(P1, 12), pw3[3] = PKW(P1, 14), pw3); \
    l_reg += sacc; \
    if (GK) { DMA_K((t) + 3, sl_cur); } if (GV) { DMA_V((t) + 1, sl_next); } \
    { float a = MX3(C0[0], C0[1], C1[0]), b = MX3(C0[2], C0[3], C1[1]); a = MX3(a, C1[2], C1[3]); \
      _Pragma("unroll") for (int r = 4; r < 16; r += 4) { a = MX3(a, C0[r], C0[r + 1]); b = MX3(b, C0[r + 2], C0[r + 3]); a = MX3(a, C1[r], C1[r + 1]); b = MX3(b, C1[r + 2], C1[r + 3]); } \
      float rm = __builtin_fmaxf(a, b); { auto rr = __builtin_amdgcn_permlane32_swap(__float_as_uint(rm), __float_as_uint(rm), false, false); rm = __builtin_fmaxf(__uint_as_float(rr[0]), __uint_as_float(rr[1])); } \
      resc = false; \
      if (__builtin_expect(__any(rm > (float)THRL), 0)) { const float dl = __builtin_fmaxf(rm, 0.f); mhat += dl; \
        _Pragma("unroll") for (int r = 0; r < 16; ++r) { C0[r] -= dl; C1[r] -= dl; } \
        _Pragma("unroll") for (int r = 0; r < 16; ++r) negm[r] = -mhat; asm volatile("" : "+v"(negm)); \
        const float f = __builtin_amdgcn_exp2f(-dl); l_reg *= f; if (hi == 0) wsf[r32] = f; resc = true; } } \
    SBAR(); \
    GAPB(o[0] = __builtin_amdgcn_mfma_f32_32x32x16_bf16(PAF(0), VFR(0), o[0], 0, 0, 0), C0, 0); \
    GAPB(o[1] = __builtin_amdgcn_mfma_f32_32x32x16_bf16(PAF(0), VFR(4), o[1], 0, 0, 0), C0, 4); \
    KRD(GL, 0); GAPB(o[0] = __builtin_amdgcn_mfma_f32_32x32x16_bf16(PAF(1), VFR(1), o[0], 0, 0, 0), C0, 8); \
    KRD(GL, 1); GAPB(o[1] = __builtin_amdgcn_mfma_f32_32x32x16_bf16(PAF(1), VFR(5), o[1], 0, 0, 0), C0, 12); \
    KRD(GL, 2); GAPB(o[0] = __builtin_amdgcn_mfma_f32_32x32x16_bf16(PAF(2), VFR(2), o[0], 0, 0, 0), C1, 0); \
    KRD(GL, 3); GAPB(o[1] = __builtin_amdgcn_mfma_f32_32x32x16_bf16(PAF(2), VFR(6), o[1], 0, 0, 0), C1, 4); \
    GAPB(o[0] = __builtin_amdgcn_mfma_f32_32x32x16_bf16(PAF(3), VFR(3), o[0], 0, 0, 0), C1, 8); \
    GAPB(o[1] = __builtin_amdgcn_mfma_f32_32x32x16_bf16(PAF(3), VFR(7), o[1], 0, 0, 0), C1, 12); \
    } while (0)
  int t = 1;
  for (; t + 5 < NT; t += 2) {
    STEP(pB0, pB1, pA0, pA1, t, true, true, true);     WAIT_BAR(2); RESC(); ROT();
    STEP(pA0, pA1, pB0, pB1, t + 1, true, true, true); WAIT_BAR(2); RESC(); ROT();
  }
  #define ENDW(tt) do { if ((tt) + 3 < NT) { WAIT_BAR(2); } else if ((tt) + 2 < NT) { WAIT_BAR(1); } else { WAIT_BAR(0); } } while (0)
  for (; t + 1 < NT; t += 2) {
    STEP(pB0, pB1, pA0, pA1, t, (t + 3 < NT), (t + 1 < NT), (t + 1 < NT));         ENDW(t);     RESC(); ROT();
    STEP(pA0, pA1, pB0, pB1, t + 1, (t + 4 < NT), (t + 2 < NT), (t + 2 < NT));     ENDW(t + 1); RESC(); ROT();
  }
  STEP(pB0, pB1, pA0, pA1, NT - 1, false, false, false); RESC();
  { float sacc = pB0[0] + pB0[1]; _Pragma("unroll") for (int r = 2; r < 16; ++r) sacc += pB0[r]; _Pragma("unroll") for (int r = 0; r < 16; ++r) sacc += pB1[r]; l_reg += sacc;
    pw0 = (u32x4){PKW(pB0, 0), PKW(pB0, 2), PKW(pB0, 4), PKW(pB0, 6)}; pw1 = (u32x4){PKW(pB0, 8), PKW(pB0, 10), PKW(pB0, 12), PKW(pB0, 14)}; pw2 = (u32x4){PKW(pB1, 0), PKW(pB1, 2), PKW(pB1, 4), PKW(pB1, 6)}; pw3 = (u32x4){PKW(pB1, 8), PKW(pB1, 10), PKW(pB1, 12), PKW(pB1, 14)};
    SBAR(); pv(o, vb0 + sl_cur, PAF(0), PAF(1), PAF(2), PAF(3)); }
  #undef PKW
  #undef PAF
  #undef VFR
  #undef PIN
  #undef MX3
  #undef GAPA
  #undef GAPB
  #undef EX
  #undef VRD
  #undef KRD
  #undef STEP
  #undef ENDW
  { auto rr = __builtin_amdgcn_permlane32_swap(__float_as_uint(l_reg), __float_as_uint(l_reg), false, false); l_reg = __uint_as_float(rr[0]) + __uint_as_float(rr[1]); }
  if (hi == 0) wsf[32 + r32] = l_reg; asm volatile("s_waitcnt lgkmcnt(0)" ::: "memory");
  float rli[16];
  #pragma unroll
  for (int r = 0; r < 16; ++r) rli[r] = __builtin_amdgcn_rcpf(wsf[32 + crow(r, hi)]);
  bf16* Ow = O + (rowbase + q0 + wid * QBLK) * OP + h * D;
  { bf16* stg = (bf16*)(shm + LDS_OST) + wid * 2048;
    #pragma unroll
    for (int r = 0; r < 16; ++r) { const int orow = crow(r, hi);
      #pragma unroll
      for (int d0 = 0; d0 < 2; ++d0) stg[orow * 64 + d0 * 32 + r32] = __float2bfloat16(o[d0][r] * rli[r]); }
    asm volatile("s_waitcnt lgkmcnt(0)" ::: "memory");
    #pragma unroll
    for (int i = 0; i < 4; ++i) { const int row = i * 8 + (lane >> 3), ch = lane & 7; const u32x4 v = *(const u32x4*)(stg + row * 64 + ch * 8); ATTN_STORE16(Ow + (long)row * OP + ch * 8, v); } }
  asm volatile("s_waitcnt lgkmcnt(0)\n\ts_barrier" ::: "memory");
  #undef DMA_K
  #undef DMA_V
  #undef START
  #undef RESC
  #undef ROT
}
#undef SBAR
#undef WAIT_BAR
}

typedef GAS unsigned gu32;
#define RLX_AGENT __ATOMIC_RELAXED, __HIP_MEMORY_SCOPE_AGENT
#define XB_TMO      128
#define XB_XCNT(j)  (256  + 64 * (j))
#define XB_XSUB(j)  (1280 + 64 * (j))
#define XB_XGEN(j)  (2304 + 64 * (j))
#define XB_TOP      3328
#define XB_TOPGEN   3392
#define XCD_BAR_WORDS 3456
#define XB_SPIN_CAP (1u << 22)
__device__ __forceinline__ unsigned xb_ld(unsigned* p)              { return __hip_atomic_load(p, __ATOMIC_RELAXED, __HIP_MEMORY_SCOPE_AGENT); }
__device__ __forceinline__ unsigned xb_add(unsigned* p, unsigned v) { return __hip_atomic_fetch_add(p, v, __ATOMIC_RELAXED, __HIP_MEMORY_SCOPE_AGENT); }
__device__ __forceinline__ unsigned xb_xcc_id() { return (unsigned)__builtin_amdgcn_s_getreg((3 << 11) | 20) & 0xFu; }
#define XB_SPIN(cond, bar) do { unsigned _sp = 0; while (cond) { __builtin_amdgcn_s_sleep(1); \
    if ((++_sp & 255u) == 0u) { if (xb_ld(&(bar)[XB_TMO])) break; if (_sp > XB_SPIN_CAP) { atomicAdd(&(bar)[XB_TMO], 1u); break; } } } } while (0)
struct XcdBarrier { unsigned* bar; unsigned x; volatile LAS unsigned* st; };
__device__ __forceinline__ XcdBarrier xcd_barrier_post(unsigned* bar, volatile LAS unsigned* st) {
    XcdBarrier b; b.bar = bar; b.x = xb_xcc_id(); b.st = st;
    if (threadIdx.x == 0) st[2] = xb_add(&bar[XB_XCNT(b.x)], 1u);
    return b;
}
__device__ __forceinline__ void xcd_barrier_complete(unsigned* bar, unsigned x, unsigned& nloc, unsigned& nx) {
    const unsigned G = gridDim.x * gridDim.y * gridDim.z;
    unsigned sum, cnt, mine, sp = 0u;
    for (;;) {
        sum = 0u; cnt = 0u; mine = 0u;
#pragma unroll
        for (unsigned j = 0; j < 16; ++j) { const unsigned c = xb_ld(&bar[XB_XCNT(j)]); sum += c; cnt += (c > 0u) ? 1u : 0u; mine = (j == x) ? c : mine; }
        if (sum == G) break;
        __builtin_amdgcn_s_sleep(1);
        if ((++sp & 255u) == 0u) { if (xb_ld(&bar[XB_TMO])) break; if (sp > XB_SPIN_CAP) { atomicAdd(&bar[XB_TMO], 1u); break; } }
    }
    nloc = mine > 0u ? mine : 1u; nx = cnt > 0u ? cnt : 1u;
}
__device__ __forceinline__ void xcd_barrier(const XcdBarrier& b) {
    asm volatile("s_waitcnt vmcnt(0)" ::: "memory");
    __syncthreads();
    if (threadIdx.x == 0) {
        unsigned* bar = b.bar;
        __builtin_amdgcn_s_waitcnt(0);
        unsigned nloc = b.st[0], nx = b.st[1];
        if (nloc == 0u) { xcd_barrier_complete(bar, b.x, nloc, nx); b.st[0] = nloc; b.st[1] = nx; }
        const unsigned old = xb_add(&bar[XB_XSUB(b.x)], 1u);
        const unsigned gen = old / nloc;
        if (old + 1u == (gen + 1u) * nloc) {
            __builtin_amdgcn_fence(__ATOMIC_RELEASE, "agent");
            asm volatile("s_waitcnt vmcnt(0)" ::: "memory");
            const unsigned og = xb_add(&bar[XB_TOP], 1u);
            const unsigned tg = og / nx;
            if (og + 1u == (tg + 1u) * nx) xb_add(&bar[XB_TOPGEN], 1u);
            else XB_SPIN(xb_ld(&bar[XB_TOPGEN]) == tg, bar);
            __builtin_amdgcn_fence(__ATOMIC_ACQUIRE, "agent");
            xb_add(&bar[XB_XGEN(b.x)], 1u);
            asm volatile("s_waitcnt vmcnt(0)" ::: "memory");
        } else {
            XB_SPIN(xb_ld(&bar[XB_XGEN(b.x)]) == gen, bar);
            __builtin_amdgcn_fence(__ATOMIC_ACQUIRE, "agent");
            asm volatile("s_waitcnt vmcnt(0)" ::: "memory");
        }
    }
    __syncthreads();
}

struct Args { const float* in[30]; float* out; unsigned char* ws; int ph_lo, ph_hi, multi, pad; };
typedef const __attribute__((address_space(4))) unsigned char* kptr_t;
struct PArgs { kptr_t kp; unsigned char* ws_; float* out_;
    __device__ __forceinline__ const float* in(int i) const { return (const float*)(const GAS float*)(*(const float* const __attribute__((address_space(4)))*)(kp + 8 * i)); }
    __device__ __forceinline__ unsigned char* ws() const { return (unsigned char*)(GAS unsigned char*)ws_; }
    __device__ __forceinline__ float* out() const { return (float*)(GAS float*)out_; } };
enum { I_X = 0, I_WIN, I_MUP, I_MUN, I_POOLW, I_POOLS, I_W0, I_WUP, I_A0, I_AUP, I_GUP, I_KK, I_KA, I_RK, I_GNG, I_GNB, I_QN, I_KN, I_WO, I_LN1G, I_LN1B,
       I_RG, I_RGB, I_RE, I_REB, I_EG, I_EU, I_ED, I_LN2G, I_LN2B };
constexpr int LDSCTL_OFF = 163840 - 256;
constexpr int MOE_TAB_OFF = 131072 + 2048;

__device__ __forceinline__ void transpose_item(const float* W, int N, int k0, int n0, bf16_t* WT, int Kout, int row0, LAS float* scr, int lane) {
    float tv[32];
#pragma unroll
    for (int i = 0; i < 32; ++i) { const int kk = 2 * i + (lane >> 5); tv[i] = ((const GAS float*)W)[(size_t)(k0 + kk) * N + n0 + (lane & 31)]; }
#pragma unroll
    for (int i = 0; i < 32; ++i) { const int kk = 2 * i + (lane >> 5); scr[kk * 33 + (lane & 31)] = tv[i]; }
    asm volatile("s_waitcnt lgkmcnt(0)" ::: "memory");
    const int c = lane & 7;
#pragma unroll
    for (int j = 0; j < 4; ++j) { const int n = (lane >> 3) + 8 * j; const LAS float* s = scr + (8 * c) * 33 + n;
        u32x4 o; o.x = cvtpk(s[0 * 33], s[1 * 33]); o.y = cvtpk(s[2 * 33], s[3 * 33]); o.z = cvtpk(s[4 * 33], s[5 * 33]); o.w = cvtpk(s[6 * 33], s[7 * 33]);
        *(GAS u32x4*)(WT + (size_t)(row0 + n) * Kout + k0 + 8 * c) = o; }
    asm volatile("s_waitcnt lgkmcnt(0)" ::: "memory");
}
__device__ __forceinline__ void sincos_d(double a, double& s, double& c) {
    const double TWO_PI = 6.283185307179586476925;
    const double n = rint(a / TWO_PI); const double r = a - n * TWO_PI;
    const double q = r * 0.25, q2 = q * q;
    const double sq = q * (1.0 + q2 * (-1.0 / 6 + q2 * (1.0 / 120 + q2 * (-1.0 / 5040 + q2 * (1.0 / 362880 + q2 * (-1.0 / 39916800 + q2 * (1.0 / 6227020800.0)))))));
    const double cq = 1.0 + q2 * (-0.5 + q2 * (1.0 / 24 + q2 * (-1.0 / 720 + q2 * (1.0 / 40320 + q2 * (-1.0 / 3628800 + q2 * (1.0 / 479001600.0 + q2 * (-1.0 / 87178291200.0)))))));
    const double s2 = 2 * sq * cq, c2 = 1 - 2 * sq * sq;
    s = 2 * s2 * c2; c = 1 - 2 * s2 * s2;
}
__device__ __forceinline__ void convert_layer_weights(const PArgs& a, LAS unsigned char* lds, int l, int vcu, int G, int sel) {
    unsigned char* ws = a.ws();
    int tid_ = threadIdx.x; asm volatile("" : "+v"(tid_)); const int tid = tid_, lane = tid & 63, wave = __builtin_amdgcn_readfirstlane(tid >> 6);
    const int gw = vcu * NWAVES + wave, NGW = G * NWAVES;
    const size_t gt = (size_t)vcu * NTHR + tid, NGT = (size_t)G * NTHR;
    LAS float* scr = (LAS float*)(lds + wave * 16384);
    constexpr int I_A = 16 * 62, I_B = 16 * 32, I_C = 32 * 16 * 16, I_E = 32 * 8 * 32, PER_L = I_A + I_B + 2 * I_C + I_E;
    const int it_lo = (sel & 1) ? 0 : I_A + I_B, it_hi = (sel & 2) ? PER_L : I_A + I_B;
    for (int it = it_lo + gw; it < it_hi; it += NGW) {
        int r = it;
        if (r < I_A) { const int kb = r / 62, nb = r % 62; transpose_item(a.in(I_WIN) + (size_t)l * DM * INW, INW, 64 * kb, 32 * nb, (bf16_t*)(ws + WS_WIN + (size_t)l * 4 * MiB), DM, 32 * nb, scr, lane); continue; } r -= I_A;
        if (r < I_B) { const int kb = r / 32, nb = r % 32; transpose_item(a.in(I_WO) + (size_t)l * DM * DM, DM, 64 * kb, 32 * nb, (bf16_t*)(ws + WS_WO + (size_t)l * 2 * MiB), DM, 32 * nb, scr, lane); continue; } r -= I_B;
        if (r < 2 * I_C) { const int up = r >= I_C; if (up) r -= I_C; const int e = r / 256, rr = r % 256, kb = rr / 16, nb = rr % 16; const int n0 = 32 * nb;
            transpose_item(a.in(up ? I_EU : I_EG) + ((size_t)l * NEXP + e) * DM * EH, EH, 64 * kb, n0, (bf16_t*)(ws + WS_WGU) + (size_t)e * 1024 * DM, DM, 256 * (n0 >> 7) + (n0 & 127) + (up ? 128 : 0), scr, lane); continue; } r -= 2 * I_C;
        { const int e = r / 256, rr = r % 256, kb = rr / 32, nb = rr % 32;
            transpose_item(a.in(I_ED) + ((size_t)l * NEXP + e) * EH * DM, DM, 64 * kb, 32 * nb, (bf16_t*)(ws + WS_WD) + (size_t)e * DM * EH, EH, 32 * nb, scr, lane); }
    }
    if (sel & 1) for (size_t i = gt; i < (size_t)64 * DM / 8; i += NGT) *(GAS u32x4*)((bf16_t*)(ws + WS_WIN + (size_t)l * 4 * MiB) + (size_t)INW * DM + i * 8) = (u32x4){0u, 0u, 0u, 0u};
}
__device__ __forceinline__ void phase_prologue(const PArgs& a, LAS unsigned char* lds, int vcu, int G) {
    unsigned char* ws = a.ws();
    int tid_ = threadIdx.x; asm volatile("" : "+v"(tid_)); const int tid = tid_, lane = tid & 63, wave = __builtin_amdgcn_readfirstlane(tid >> 6);
    const int gw = vcu * NWAVES + wave, NGW = G * NWAVES;
    const size_t gt = (size_t)vcu * NTHR + tid, NGT = (size_t)G * NTHR;
    LAS float* scr = (LAS float*)(lds + wave * 16384);
    convert_layer_weights(a, lds, 0, vcu, G, 3);
#pragma unroll 1
    for (int l = 1; l < DEPTH; ++l) convert_layer_weights(a, lds, l, vcu, G, 1);
    for (size_t i = gt; i < (size_t)NTOK * DM / 8; i += NGT) { const f32x4 v0 = *(const GAS f32x4*)(a.in(I_X) + i * 8), v1 = *(const GAS f32x4*)(a.in(I_X) + i * 8 + 4);
        u32x4 o; o.x = cvtpk(v0[0], v0[1]); o.y = cvtpk(v0[2], v0[3]); o.z = cvtpk(v1[0], v1[1]); o.w = cvtpk(v1[2], v1[3]);
        *(GAS u32x4*)((bf16_t*)(ws + WS_XN) + i * 8) = o; }
    unsigned char* sm = ws + WS_SMALL;
    for (size_t i = gt; i < 64 * 16; i += NGT) { const int pos = (int)(i >> 4), f = (int)(i & 15); double inv = 1.0; for (int k = 0; k < f; ++k) inv *= 0.56234132519034908;
        double s, c; sincos_d((double)pos * inv, s, c); float* R = (float*)(sm + SM_ROPE) + pos * 32; R[f] = (float)c; R[16 + f] = (float)s; }
    for (size_t i = gt; i < (size_t)DEPTH * 4 * 64 * 64; i += NGT) { const int k = (int)(i & 63), n = (int)((i >> 6) & 63); const size_t lg = i >> 12;
        ((bf16_t*)(sm + SM_PWT))[i] = (bf16_t)(cvtpk(a.in(I_POOLW)[(lg * 64 + k) * 64 + n], 0.f) & 0xffffu); }
    for (size_t i = gt; i < (size_t)DEPTH * 2 * 256 * 32; i += NGT) { const int k = (int)(i & 31), n = (int)((i >> 5) & 255); const size_t ld = i >> 13;
        ((bf16_t*)(sm + SM_WUPT))[i] = (bf16_t)(cvtpk(a.in(I_WUP)[(ld * 32 + k) * 256 + n], 0.f) & 0xffffu);
        ((bf16_t*)(sm + SM_AUPT))[i] = (bf16_t)(cvtpk(a.in(I_AUP)[(ld * 32 + k) * 256 + n], 0.f) & 0xffffu); }
    for (size_t i = gt; i < (size_t)DEPTH * 256 * 64; i += NGT) { const int k = (int)(i & 63), n = (int)((i >> 6) & 255); const size_t l = i >> 14;
        ((bf16_t*)(sm + SM_GUPT))[i] = (bf16_t)(cvtpk(a.in(I_GUP)[(l * 64 + k) * 256 + n], 0.f) & 0xffffu); }
    for (size_t i = gt; i < (size_t)DEPTH * 48 * 1024; i += NGT) { const int k = (int)(i & 1023); const int c = (int)((i >> 10) % 48); const size_t l = i / (48 * 1024);
        const float w = (c < 32 ? ((const GAS float*)a.in(I_RE))[(l * DM + k) * 32 + c] : (c < 36 ? ((const GAS float*)a.in(I_RG))[(l * DM + k) * 4 + (c - 32)] : 0.f)) * ((const GAS float*)a.in(I_LN1G))[l * DM + k];
        const unsigned hi_ = cvtpk(w, 0.f) & 0xffffu; const float lo_ = w - __uint_as_float(hi_ << 16);
        bf16_t* RWB = (bf16_t*)(ws + WS_RWB) + l * 2 * 48 * 1024; RWB[c * 1024 + k] = (bf16_t)hi_; RWB[48 * 1024 + c * 1024 + k] = (bf16_t)(cvtpk(lo_, 0.f) & 0xffffu); }
    for (int it = gw; it < DEPTH * 48; it += NGW) { const int l = it / 48, c = it % 48; float sb_ = 0.f;
        if (c < 36) for (int k = lane; k < DM; k += 64) sb_ += ((const GAS float*)a.in(I_LN1B))[l * DM + k] * (c < 32 ? ((const GAS float*)a.in(I_RE))[((size_t)l * DM + k) * 32 + c] : ((const GAS float*)a.in(I_RG))[((size_t)l * DM + k) * 4 + (c - 32)]);
        sb_ = wave_sum(sb_); if (lane == 0) ((GAS float*)(ws + WS_RB))[it] = sb_; }
}

constexpr size_t REC_BYTES = 13568, REC_AOP = 0  , REC_AY = 5120  , REC_AS = 7168  , REC_GC = 11264  , REC_VT = 11520  ;
__device__ __forceinline__ int permp(int x) { return (x & 3) | ((x & 4) << 1) | ((x & 8) >> 1); }
__device__ __forceinline__ bf16x8 pack_frag(const float (&x)[8]) { u32x4 o; o.x = cvtpk(x[0], x[1]); o.y = cvtpk(x[2], x[3]); o.z = cvtpk(x[4], x[5]); o.w = cvtpk(x[6], x[7]); return __builtin_bit_cast(bf16x8, o); }
__device__ __forceinline__ void swap32(float a, float b, float& lo, float& hi) {
    auto rr = __builtin_amdgcn_permlane32_swap(__float_as_uint(a), __float_as_uint(b), false, false); lo = __uint_as_float(rr[0]); hi = __uint_as_float(rr[1]); }

__device__ __forceinline__ void scan_pre_item(const PArgs& a, LAS bf16_t* X, int bh, int dir, int c, int lane, int var = 0) {
    unsigned char* ws0 = a.ws_; asm volatile("" : "+s"(ws0)); unsigned char* ws = (unsigned char*)(GAS unsigned char*)ws0;
    asm volatile("" : "+v"(lane));
    const int l31 = lane & 31, hi = lane >> 5;
    {
        const int item = (bh * 2 + dir) * 128 + c;
        const size_t hb = (size_t)bh * SEQ * 64 + lane;
        const GAS bf16_t* gKK = (const GAS bf16_t*)(ws + WS_KK) + hb; const GAS bf16_t* gB = (const GAS bf16_t*)(ws + WS_B + (size_t)dir * 16 * MiB) + hb;
        const GAS bf16_t* gKH = (const GAS bf16_t*)(ws + WS_KH + (size_t)dir * 16 * MiB) + hb; const GAS bf16_t* gR = (const GAS bf16_t*)(ws + WS_R) + hb; const GAS bf16_t* gV = (const GAS bf16_t*)(ws + WS_V) + hb;
        const GAS float* gW = (const GAS float*)(ws + WS_W + (size_t)dir * 32 * MiB) + hb;
        unsigned char* rec = ws + WS_REC + (size_t)item * REC_BYTES;
        float ah[16], bhh[16], khh[16], rh[16]; unsigned vv2[8] = {0u, 0u, 0u, 0u, 0u, 0u, 0u, 0u};
        float g = 1.f;
        {
            float wv[16]; unsigned short kkr[16], br[16], khr[16], rr_[16], vr[16];
#pragma unroll
            for (int t = 0; t < 16; ++t) { const int tt = dir ? SEQ - 1 - (16 * c + t) : 16 * c + t; const size_t o = (size_t)tt * 64;
                wv[t] = gW[o]; kkr[t] = gKK[o]; br[t] = gB[o]; khr[t] = gKH[o]; rr_[t] = gR[o]; vr[t] = gV[o]; }
            asm volatile("" ::: "memory");
#pragma unroll
            for (int t = 0; t < 16; ++t) {
                const float w = wv[t], kk = __uint_as_float((unsigned)kkr[t] << 16), b = __uint_as_float((unsigned)br[t] << 16), kh = __uint_as_float((unsigned)khr[t] << 16), r = __uint_as_float((unsigned)rr_[t] << 16);
                vv2[t >> 1] |= (unsigned)vr[t] << (16 * (t & 1));
                ah[t] = g * kk; g *= w; const float ig = __builtin_amdgcn_rcpf(g); bhh[t] = b * ig; khh[t] = kh * ig; rh[t] = g * r; }
        }
        const float gC = g;
#pragma unroll
        for (int t = 0; t < 16; ++t) { X[(0 * 16 + t) * 64 + lane] = (bf16_t)(cvtpk(ah[t], 0.f) & 0xffffu); X[(1 * 16 + t) * 64 + lane] = (bf16_t)(cvtpk(bhh[t], 0.f) & 0xffffu);
            X[(2 * 16 + t) * 64 + lane] = (bf16_t)(cvtpk(khh[t], 0.f) & 0xffffu); X[(3 * 16 + t) * 64 + lane] = (bf16_t)(cvtpk(rh[t], 0.f) & 0xffffu); }
        f32x16 Nacc = f32x16{};
        { const LAS bf16_t* pa = X + ((l31 < 16 ? 1 : 2) * 16 + (l31 & 15)) * 64 + 8 * hi; const LAS bf16_t* pb = X + ((l31 < 16 ? 0 : 3) * 16 + (l31 & 15)) * 64 + 8 * hi;
#pragma unroll
          for (int ks = 0; ks < 4; ++ks) Nacc = __builtin_amdgcn_mfma_f32_32x32x16_bf16(*(const LAS bf16x8*)(pa + 16 * ks), *(const LAS bf16x8*)(pb + 16 * ks), Nacc, 0, 0, 0); }
        float NB[16], NK[16];
        { const int lim = (l31 & 15) + (l31 >> 4);
#pragma unroll
          for (int r = 0; r < 16; ++r) { float lo_, oth; swap32(Nacc[r], Nacc[r], lo_, oth);
              const int r7 = r & 7, s_own = (r7 & 3) + 8 * (r7 >> 2), s_oth = s_own + 4;
              const float vo = (s_own < lim) ? Nacc[r] : 0.f, vt = (s_oth < lim) ? oth : 0.f;
              if (r < 8) { NB[s_own] = vo; NB[s_oth] = vt; } else { NK[s_own] = vo; NK[s_oth] = vt; } } }
        float Tc[16], Mc[16];
#pragma unroll
        for (int s_ = 0; s_ < 16; ++s_) { Tc[s_] = (s_ == lane) ? 1.f : 0.f; Mc[s_] = 0.f; }
        if (var < 2) {
#pragma unroll
        for (int p = 0; p < 15; ++p)
#pragma unroll
            for (int s_ = 0; s_ <= p; ++s_) { const float tb_ = __int_as_float(__builtin_amdgcn_readlane(__float_as_int(Tc[s_]), p)); Tc[s_] -= tb_ * NB[p]; }
#pragma unroll
        for (int p = 1; p < 16; ++p)
#pragma unroll
            for (int s_ = 0; s_ < p; ++s_) { const float nb_ = __int_as_float(__builtin_amdgcn_readlane(__float_as_int(NK[s_]), p)); Mc[s_] += nb_ * Tc[p]; }
        }
        f32x16 Ap0, Ap1;
        { float ta[8], f0[8], f1[8];
#pragma unroll
          for (int jj = 0; jj < 8; ++jj) { float lo_, hi_; swap32(Tc[jj], Tc[8 + jj], lo_, hi_); ta[jj] = lo_; swap32(ah[jj], ah[8 + jj], f0[jj], f1[jj]); }
          const bf16x8 TA = pack_frag(ta);
          Ap0 = __builtin_amdgcn_mfma_f32_32x32x16_bf16(TA, pack_frag(f0), f32x16{}, 0, 0, 0); Ap1 = __builtin_amdgcn_mfma_f32_32x32x16_bf16(TA, pack_frag(f1), f32x16{}, 0, 0, 0); }
        if (var == 0) {
#define FRAG_OFF(m, ks, p) ((ks) * 1024 + ((m) + 32 * ((p) >> 3)) * 16 + ((p) & 7) * 2)
        { LAS unsigned char* AL = (LAS unsigned char*)X;
          { const int ksl = l31 >> 4, pj = permp(l31 & 15);
#pragma unroll
            for (int r = 0; r < 8; ++r) { const int t = (r & 3) + 8 * (r >> 2) + 4 * hi;
                *(LAS bf16_t*)(AL + FRAG_OFF(t, ksl, pj)) = (bf16_t)(cvtpk(Ap0[r], 0.f) & 0xffffu); *(LAS bf16_t*)(AL + FRAG_OFF(t, 2 + ksl, pj)) = (bf16_t)(cvtpk(Ap1[r], 0.f) & 0xffffu); } }
          { const int ksj = lane >> 4, pj = permp(lane & 15);
#pragma unroll
            for (int t = 0; t < 16; ++t) *(LAS bf16_t*)(AL + FRAG_OFF(16 + t, ksj, pj)) = (bf16_t)(cvtpk(rh[t], 0.f) & 0xffffu); }
          if (lane < 16) { float m0[8], m1[8];
#pragma unroll
              for (int jj = 0; jj < 8; ++jj) { m0[jj] = Mc[jj]; m1[jj] = Mc[8 + jj]; }
              *(LAS bf16x8*)(AL + 4096 + lane * 16) = pack_frag(m0); *(LAS bf16x8*)(AL + 4096 + (lane + 32) * 16) = pack_frag(m1);
              *(LAS u32x4*)(AL + 4096 + (16 + lane) * 16) = (u32x4){0u, 0u, 0u, 0u}; *(LAS u32x4*)(AL + 4096 + (48 + lane) * 16) = (u32x4){0u, 0u, 0u, 0u}; }
          asm volatile("s_waitcnt lgkmcnt(0)" ::: "memory");
#pragma unroll
          for (int k = 0; k < 5; ++k) { const u32x4 v = *(const LAS u32x4*)(AL + k * 1024 + lane * 16); *(GAS u32x4*)(rec + REC_AOP + k * 1024 + lane * 16) = v; }
          asm volatile("s_waitcnt lgkmcnt(0)" ::: "memory"); }
        if (lane >= 16 && lane < 32) { unsigned char* AY = rec + REC_AY; const int t = lane - 16;
            float y0[8], y1[8], y2[8], y3[8];
#pragma unroll
            for (int jj = 0; jj < 8; ++jj) { y0[jj] = -NB[permp(jj)]; y1[jj] = -NB[permp(8 + jj)]; y2[jj] = NK[jj]; y3[jj] = NK[8 + jj]; }
            *(GAS bf16x8*)(AY + t * 16) = pack_frag(y0); *(GAS bf16x8*)(AY + (t + 32) * 16) = pack_frag(y1); *(GAS bf16x8*)(AY + 1024 + t * 16) = pack_frag(y2); *(GAS bf16x8*)(AY + 1024 + (t + 32) * 16) = pack_frag(y3);
            const u32x4 z = {0u, 0u, 0u, 0u};
            *(GAS u32x4*)(AY + (16 + t) * 16) = z; *(GAS u32x4*)(AY + (48 + t) * 16) = z; *(GAS u32x4*)(AY + 1024 + (16 + t) * 16) = z; *(GAS u32x4*)(AY + 1024 + (48 + t) * 16) = z; }
        { unsigned char* AS = rec + REC_AS + (lane >> 5) * 2048; const int jl = lane & 31;
            float s0[8], s1[8], s2[8], s3[8];
#pragma unroll
            for (int jj = 0; jj < 8; ++jj) { s0[jj] = -bhh[permp(jj)] * gC; s1[jj] = -bhh[permp(8 + jj)] * gC; s2[jj] = khh[jj] * gC; s3[jj] = khh[8 + jj] * gC; }
            *(GAS bf16x8*)(AS + jl * 16) = pack_frag(s0); *(GAS bf16x8*)(AS + (jl + 32) * 16) = pack_frag(s1); *(GAS bf16x8*)(AS + 1024 + jl * 16) = pack_frag(s2); *(GAS bf16x8*)(AS + 1024 + (jl + 32) * 16) = pack_frag(s3); }
        { const int jl = lane & 31; ((GAS float*)(rec + REC_GC))[(lane >> 5) * 32 + ((jl >> 2) & 1) * 16 + (jl & 3) + 4 * (jl >> 3)] = gC; }
        { unsigned char* VT = rec + REC_VT + (lane >> 5) * 1024; const int il = lane & 31;
            *(GAS u32x4*)(VT + il * 16) = (u32x4){vv2[0], vv2[1], vv2[2], vv2[3]};
            *(GAS u32x4*)(VT + (il + 32) * 16) = (u32x4){vv2[4], vv2[5], vv2[6], vv2[7]}; }
        } else { asm volatile("" :: "v"(Ap0[0]), "v"(Ap1[0]), "v"(Mc[0]), "v"(NB[1]), "v"(NK[1]), "v"(gC), "v"(vv2[0])); }
#undef FRAG_OFF
    }
}

constexpr int FT_STRIDE = 968, DT_STRIDE = 264, DT_OFF = 64 * FT_STRIDE * 2;
static_assert(DT_OFF + 64 * DT_STRIDE * 2 <= LDSCTL_OFF, "prep LDS");
__device__ __forceinline__ void unpack8(const u32x4 w, float (&x)[8]) { x[0] = bflo(w.x); x[1] = bfhi(w.x); x[2] = bflo(w.y); x[3] = bfhi(w.y); x[4] = bflo(w.z); x[5] = bfhi(w.z); x[6] = bflo(w.w); x[7] = bfhi(w.w); }
__device__ __forceinline__ u32x4 pack8(const float (&x)[8]) { u32x4 o; o.x = cvtpk(x[0], x[1]); o.y = cvtpk(x[2], x[3]); o.z = cvtpk(x[4], x[5]); o.w = cvtpk(x[6], x[7]); return o; }
__device__ __forceinline__ void unpack4(const u32x2 w, float (&x)[4]) { x[0] = bflo(w.x); x[1] = bfhi(w.x); x[2] = bflo(w.y); x[3] = bfhi(w.y); }

__device__ __forceinline__ void phase_prep(const PArgs& a_in, LAS unsigned char* lds, int l, int dry, int i0, int ihi, int istep, const unsigned* pcnt) {
    int tid_ = threadIdx.x; asm volatile("" : "+v"(tid_)); const int tid = tid_, lane = tid & 63, wave = __builtin_amdgcn_readfirstlane(tid >> 6), l31 = lane & 31, hi = lane >> 5;
    LAS bf16_t* Ft = (LAS bf16_t*)lds; LAS bf16_t* Dt = (LAS bf16_t*)(lds + DT_OFF);
    for (int item = i0; item < (dry >= 5 ? 0 : ihi); item += istep) {
        const int tb = item * 64, t0 = tb & (SEQ - 1), bidx = tb / SEQ;
        if (pcnt) { const int pm = item >> 2, q = item & 3; unsigned* tmo = (unsigned*)(a_in.ws() + WS_CTL) + 8;
            wait_count(pcnt + 16 * pm, 64u, tmo);
            if (q == 0 && t0 > 0) wait_count(pcnt + 16 * (pm - 1), 64u, tmo);
            if (q == 3 && t0 + 64 < SEQ) wait_count(pcnt + 16 * (pm + 1), 64u, tmo); }
        PArgs a = a_in; asm volatile("" : "+s"(a.kp), "+s"(a.ws_));
        unsigned char* ws = a.ws(); unsigned char* sm = ws + WS_SMALL; bf16_t* PROJ = (bf16_t*)(ws + WS_PROJ); bf16_t* MIX = (bf16_t*)(ws + WS_MIX); const float* ROPE = (const float*)(sm + SM_ROPE);
        int tv = tid; asm volatile("" : "+v"(tv));
        {
            u32x4 raw[10];
#pragma unroll
            for (int it = 0; it < 10; ++it) { const int idx = tv + NTHR * it, chunk = idx & 7, hv = idx >> 3, tok = hv / 10, head = hv - tok * 10;
                const int col = head < 8 ? C_Q + head * 64 : C_K + (head - 8) * 64;
                raw[it] = *(const GAS u32x4*)(PROJ + (size_t)(tb + tok) * INP + col + chunk * 8); }
#pragma unroll
            for (int it = 0; it < 10; ++it) { const int idx = tv + NTHR * it, chunk = idx & 7, hv = idx >> 3, tok = hv / 10, head = hv - tok * 10;
                const int col = head < 8 ? C_Q + head * 64 : C_K + (head - 8) * 64;
                bf16_t* p = PROJ + (size_t)(tb + tok) * INP + col + chunk * 8;
                float x[8]; unpack8(raw[it], x);
                float ss = 0.f;
#pragma unroll
                for (int j = 0; j < 8; ++j) ss += x[j] * x[j];
                ss += __shfl_xor(ss, 1); ss += __shfl_xor(ss, 2); ss += __shfl_xor(ss, 4);
                const float rs = rsqrtf(ss * (1.f / 64.f) + QK_EPS);
                const GAS float* gw = (const GAS float*)(a.in(head < 8 ? I_QN : I_KN) + l * 64 + chunk * 8);
                const int t = t0 + tok, pos = chunk < 4 ? (t >> 6) : (t & 63);
                const GAS float* ct = (const GAS float*)(ROPE + pos * 32 + (chunk & 1) * 8);
                const float sgn = (chunk & 2) ? 1.f : -1.f, qs = head < 8 ? QSCALE : 1.f;
                float y[8], o[8];
#pragma unroll
                for (int j = 0; j < 8; ++j) y[j] = x[j] * rs * gw[j];
#pragma unroll
                for (int j = 0; j < 8; ++j) { const float yp = __shfl_xor(y[j], 2); o[j] = (y[j] * ct[j] + sgn * yp * ct[16 + j]) * qs; }
                if (!dry) *(GAS u32x4*)p = pack8(o); }
        }
        asm volatile("" ::: "memory");
        if (tv < 480) {
            const int ch8 = tv % 120, tg = tv / 120, c = ch8 * 8;
            float mp[8], mn[8];
#pragma unroll
            for (int j = 0; j < 8; ++j) { mp[j] = ((const GAS float*)a.in(I_MUP))[l * 960 + c + j]; mn[j] = ((const GAS float*)a.in(I_MUN))[l * 960 + c + j]; }
            const int mode = (c >= 768 && c < 832) ? 1 : (c >= 896 ? 2 : 0);
#pragma unroll
            for (int hf = 0; hf < 2; ++hf) {
                asm volatile("" ::: "memory");
                const int tk0 = tg * 16 + hf * 8;
                u32x4 rw[10];
#pragma unroll
                for (int r = 0; r < 10; ++r) { const int t = t0 + tk0 - 1 + r;
                    rw[r] = (t >= 0 && t < SEQ) ? *(const GAS u32x4*)(PROJ + (size_t)(tb + tk0 - 1 + r) * INP + C_RW + c) : (u32x4){0u, 0u, 0u, 0u}; }
#pragma unroll
                for (int k = 0; k < 8; ++k) { float pp[8], p[8], pn[8], f[8]; unpack8(rw[k], pp); unpack8(rw[k + 1], p); unpack8(rw[k + 2], pn);
#pragma unroll
                    for (int j = 0; j < 8; ++j) f[j] = p[j] + mp[j] * (pp[j] - p[j]) + mn[j] * (pn[j] - p[j]);
                    if (mode == 1) {
#pragma unroll
                        for (int j = 0; j < 8; ++j) f[j] = 1.f - 2.f * __builtin_amdgcn_rcpf(__expf(2.f * f[j]) + 1.f);
                    } else if (mode == 2) {
#pragma unroll
                        for (int j = 0; j < 8; ++j) f[j] = sigmoidf_(f[j]);
                    }
                    *(LAS u32x4*)(Ft + (tk0 + k) * FT_STRIDE + c) = pack8(f); }
            }
        }
        asm volatile("" ::: "memory");
#pragma unroll 1
        for (int it = 0; it < 4; ++it) {
            asm volatile("" ::: "memory");
            const int idx = tv + NTHR * it, tok = idx >> 5, ch8 = idx & 31, g = ch8 >> 3, w = 2 << g, t = t0 + tok;
            const bf16_t* base = PROJ + (size_t)(bidx * SEQ) * INP + ch8 * 8;
            u32x4 rw[16];
#pragma unroll
            for (int i = 0; i < 16; ++i) { const int r = t - (w >> 1) + i; rw[i] = (i < w && r >= 0 && r < SEQ) ? *(const GAS u32x4*)(base + (size_t)r * INP) : (u32x4){0u, 0u, 0u, 0u}; }
            const u32x4 ur = *(const GAS u32x4*)(base + (size_t)t * INP);
            float acc[8] = {0.f, 0.f, 0.f, 0.f, 0.f, 0.f, 0.f, 0.f};
#pragma unroll
            for (int i = 0; i < 16; ++i) { float v[8]; unpack8(rw[i], v);
#pragma unroll
                for (int j = 0; j < 8; ++j) acc[j] += v[j]; }
            const int lo = max(t - (w >> 1), 0), hiw = min(t + (w >> 1), SEQ);
            float u[8]; unpack8(ur, u);
            const float inv = 1.f / (float)(hiw - lo);
            float d[8];
#pragma unroll
            for (int j = 0; j < 8; ++j) d[j] = acc[j] * inv - u[j];
            *(LAS u32x4*)(Dt + tok * DT_STRIDE + ch8 * 8) = pack8(d);
        }
        __syncthreads();
        if (dry != 2) {
        const int th = wave & 1, hd = wave >> 1, tokl = 32 * th + l31;
        const int ce = 64 * hd + 2 * l31;
#define TOKR(r) (32 * th + ((r) & 3) + 8 * ((r) >> 2) + 4 * hi)
        {
            const bf16_t* PWT = (const bf16_t*)(sm + SM_PWT) + (size_t)(l * 4 + hd) * 4096;
            f32x16 pe = f32x16{}, po = f32x16{};
#pragma unroll
            for (int s = 0; s < 4; ++s) { const bf16x8 A = *(const LAS bf16x8*)(Dt + tokl * DT_STRIDE + 64 * hd + 16 * s + 8 * hi);
                pe = __builtin_amdgcn_mfma_f32_32x32x16_bf16(A, *(const GAS bf16x8*)(PWT + (2 * l31) * 64 + 16 * s + 8 * hi), pe, 0, 0, 0);
                po = __builtin_amdgcn_mfma_f32_32x32x16_bf16(A, *(const GAS bf16x8*)(PWT + (2 * l31 + 1) * 64 + 16 * s + 8 * hi), po, 0, 0, 0); }
            const f32x2 sc = *(const GAS f32x2*)(a.in(I_POOLS) + l * 256 + ce);
#pragma unroll
            for (int r = 0; r < 16; ++r) *(GAS unsigned*)(MIX + (size_t)(tb + TOKR(r)) * DM + ce) = cvtpk(pe[r] * sc[0], po[r] * sc[1]);
        }
        {
            const LAS bf16_t* Frow = Ft + tokl * FT_STRIDE;
            const int bh = bidx * 4 + hd; const size_t hbase = ((size_t)bh * SEQ + t0) * 64 + 2 * l31;
            const f32x2 kkw = *(const GAS f32x2*)(a.in(I_KK) + l * 256 + ce), kaw = *(const GAS f32x2*)(a.in(I_KA) + l * 256 + ce), rkw = *(const GAS f32x2*)(a.in(I_RK) + l * 256 + ce);
            const bf16_t* WUPT = (const bf16_t*)(sm + SM_WUPT) + (size_t)l * 2 * 256 * 32; const bf16_t* AUPT = (const bf16_t*)(sm + SM_AUPT) + (size_t)l * 2 * 256 * 32;
            const bf16_t* GUPT = (const bf16_t*)(sm + SM_GUPT) + (size_t)l * 256 * 64;
            const int ne = ce, no = ce + 1;
            unsigned kp[16];
            float invn[16];
#pragma unroll
            for (int r = 0; r < 16; ++r) { kp[r] = *(const LAS unsigned*)(Ft + TOKR(r) * FT_STRIDE + 256 + ce);
                const float ve = bflo(kp[r]) * kkw[0], vo = bfhi(kp[r]) * kkw[1]; float q = ve * ve + vo * vo;
                q = red16(q); q += __shfl_xor(q, 16); invn[r] = 1.f / fmaxf(sqrtf(q), 1e-12f); }
            asm volatile("" ::: "memory"); __builtin_amdgcn_sched_barrier(0);
            {
                f32x16 d0e = f32x16{}, d0o = f32x16{}, d1e = f32x16{}, d1o = f32x16{};
#pragma unroll
                for (int s = 0; s < 2; ++s) { const int ko = 16 * s + 8 * hi; const bf16x8 A0 = *(const LAS bf16x8*)(Frow + 768 + ko), A1 = *(const LAS bf16x8*)(Frow + 800 + ko);
                    d0e = __builtin_amdgcn_mfma_f32_32x32x16_bf16(A0, *(const GAS bf16x8*)(WUPT + (0 * 256 + ne) * 32 + ko), d0e, 0, 0, 0);
                    d0o = __builtin_amdgcn_mfma_f32_32x32x16_bf16(A0, *(const GAS bf16x8*)(WUPT + (0 * 256 + no) * 32 + ko), d0o, 0, 0, 0);
                    d1e = __builtin_amdgcn_mfma_f32_32x32x16_bf16(A1, *(const GAS bf16x8*)(WUPT + (1 * 256 + ne) * 32 + ko), d1e, 0, 0, 0);
                    d1o = __builtin_amdgcn_mfma_f32_32x32x16_bf16(A1, *(const GAS bf16x8*)(WUPT + (1 * 256 + no) * 32 + ko), d1o, 0, 0, 0); }
                const f32x2 w00 = *(const GAS f32x2*)(a.in(I_W0) + (l * 2 + 0) * 256 + ce), w01 = *(const GAS f32x2*)(a.in(I_W0) + (l * 2 + 1) * 256 + ce);
#pragma unroll
                for (int r = 0; r < 16; ++r) { const size_t o = hbase + (size_t)TOKR(r) * 64;
                    const f32x2 x0 = {__expf(-0.6065306597126334f * sigmoidf_(w00[0] + d0e[r])), __expf(-0.6065306597126334f * sigmoidf_(w00[1] + d0o[r]))};
                    const f32x2 x1 = {__expf(-0.6065306597126334f * sigmoidf_(w01[0] + d1e[r])), __expf(-0.6065306597126334f * sigmoidf_(w01[1] + d1o[r]))};
                    if (dry != 3) { *(GAS f32x2*)((float*)(ws + WS_W) + o) = x0; *(GAS f32x2*)((float*)(ws + WS_W + 32 * MiB) + o) = x1; } else asm volatile("" :: "v"(x0), "v"(x1)); }
            }
            asm volatile("" ::: "memory"); __builtin_amdgcn_sched_barrier(0);
            {
                f32x16 a0e = f32x16{}, a0o = f32x16{}, a1e = f32x16{}, a1o = f32x16{};
#pragma unroll
                for (int s = 0; s < 2; ++s) { const int ko = 16 * s + 8 * hi; const bf16x8 A0 = *(const LAS bf16x8*)(Frow + 832 + ko), A1 = *(const LAS bf16x8*)(Frow + 864 + ko);
                    a0e = __builtin_amdgcn_mfma_f32_32x32x16_bf16(A0, *(const GAS bf16x8*)(AUPT + (0 * 256 + ne) * 32 + ko), a0e, 0, 0, 0);
                    a0o = __builtin_amdgcn_mfma_f32_32x32x16_bf16(A0, *(const GAS bf16x8*)(AUPT + (0 * 256 + no) * 32 + ko), a0o, 0, 0, 0);
                    a1e = __builtin_amdgcn_mfma_f32_32x32x16_bf16(A1, *(const GAS bf16x8*)(AUPT + (1 * 256 + ne) * 32 + ko), a1e, 0, 0, 0);
                    a1o = __builtin_amdgcn_mfma_f32_32x32x16_bf16(A1, *(const GAS bf16x8*)(AUPT + (1 * 256 + no) * 32 + ko), a1o, 0, 0, 0); }
                const f32x2 b00 = *(const GAS f32x2*)(a.in(I_A0) + (l * 2 + 0) * 256 + ce), b01 = *(const GAS f32x2*)(a.in(I_A0) + (l * 2 + 1) * 256 + ce);
#define ST2(base, lo_, hi_) do { const unsigned _o = cvtpk(lo_, hi_); if (dry != 3) *(GAS unsigned*)((bf16_t*)(ws + (base)) + o) = _o; else asm volatile("" :: "v"(_o)); } while (0)
#pragma unroll
                for (int r = 0; r < 16; ++r) { const size_t o = hbase + (size_t)TOKR(r) * 64;
                    const unsigned rp = *(const LAS unsigned*)(Ft + TOKR(r) * FT_STRIDE + ce);
                    const float ke = bflo(kp[r]), ko_ = bfhi(kp[r]), re = bflo(rp), ro = bfhi(rp);
                    const float s0e = sigmoidf_(b00[0] + a0e[r]), s0o = sigmoidf_(b00[1] + a0o[r]), s1e = sigmoidf_(b01[0] + a1e[r]), s1o = sigmoidf_(b01[1] + a1o[r]);
                    const float kke = ke * kkw[0] * invn[r], kko = ko_ * kkw[1] * invn[r];
                    const float h0e = ke * (1.f + (s0e - 1.f) * kaw[0]), h0o = ko_ * (1.f + (s0o - 1.f) * kaw[1]), h1e = ke * (1.f + (s1e - 1.f) * kaw[0]), h1o = ko_ * (1.f + (s1o - 1.f) * kaw[1]);
                    float bs = re * (h0e + h1e) * rkw[0] + ro * (h0o + h1o) * rkw[1];
                    bs = red16(bs); bs += __shfl_xor(bs, 16);
                    const unsigned vp = *(const LAS unsigned*)(Ft + TOKR(r) * FT_STRIDE + 512 + ce);
                    if (dry != 3) *(GAS unsigned*)((bf16_t*)(ws + WS_V) + o) = vp; else asm volatile("" :: "v"(vp));
                    ST2(WS_BON, bs * bflo(vp), bs * bfhi(vp));
                    if (dry != 3) *(GAS unsigned*)((bf16_t*)(ws + WS_R) + o) = rp; else asm volatile("" :: "v"(rp));
                    ST2(WS_KK, kke, kko); ST2(WS_KH, h0e, h0o); ST2(WS_KH + 16 * MiB, h1e, h1o); ST2(WS_B, kke * s0e, kko * s0o); ST2(WS_B + 16 * MiB, kke * s1e, kko * s1o); }
            }
            asm volatile("" ::: "memory"); __builtin_amdgcn_sched_barrier(0);
            {
                f32x16 ge = f32x16{}, go = f32x16{};
#pragma unroll
                for (int s = 0; s < 4; ++s) { const int ko = 16 * s + 8 * hi; const bf16x8 A0 = *(const LAS bf16x8*)(Frow + 896 + ko);
                    ge = __builtin_amdgcn_mfma_f32_32x32x16_bf16(A0, *(const GAS bf16x8*)(GUPT + ne * 64 + ko), ge, 0, 0, 0);
                    go = __builtin_amdgcn_mfma_f32_32x32x16_bf16(A0, *(const GAS bf16x8*)(GUPT + no * 64 + ko), go, 0, 0, 0); }
#pragma unroll
                for (int r = 0; r < 16; ++r) { const size_t o = hbase + (size_t)TOKR(r) * 64;
                    ST2(WS_G, ge[r], go[r]); }
#undef ST2
            }
        }
#undef TOKR
        }
        __syncthreads();
    }
    asm volatile("s_waitcnt vmcnt(0)" ::: "memory");
    __syncthreads();
    if (dry != 2 && dry != 4) {
#pragma unroll 1
        for (int item = i0; item < ihi; item += istep) {
            const int tb = item * 64, t0 = tb & (SEQ - 1), bidx = tb / SEQ;
#pragma unroll 1
            for (int q4 = 0; q4 < 4; ++q4) { const int itx = wave * 4 + q4, hd2 = itx & 3, qb = (itx >> 2) & 3, dir = itx >> 4;
                const int c0 = (t0 >> 4) + qb;
                int lz = lane; asm volatile("" : "+v"(lz));
                scan_pre_item(a_in, (LAS bf16_t*)(lds + wave * 8192), bidx * 4 + hd2, dir, dir ? 127 - c0 : c0, lz, dry >= 5 ? dry - 5 : 0); }
        }
    }
    __syncthreads();
}

typedef _Float16 h16x8 __attribute__((ext_vector_type(8)));
typedef _Float16 h16x4 __attribute__((ext_vector_type(4)));
constexpr int SC_CHUNK = 16, SC_NCH = SEQ / SC_CHUNK, SC_STEPB = 768  , SC_BUFB = SC_CHUNK * SC_STEPB, SC_YOFF = 2 * SC_BUFB, SC_YB = SC_CHUNK * 512 * 4;
static_assert(SC_YOFF + 2 * SC_YB <= LDSCTL_OFF, "scan LDS");
__device__ __forceinline__ float fmix_lo(float a, unsigned pk, float c) { float d; asm("v_fma_mix_f32 %0, %1, %2, %3 op_sel:[0,0,0] op_sel_hi:[0,1,0]" : "=v"(d) : "v"(a), "v"(pk), "v"(c)); return d; }
__device__ __forceinline__ float fmix_hi(float a, unsigned pk, float c) { float d; asm("v_fma_mix_f32 %0, %1, %2, %3 op_sel:[0,1,0] op_sel_hi:[0,1,0]" : "=v"(d) : "v"(a), "v"(pk), "v"(c)); return d; }
__device__ __forceinline__ float fmixn_lo(float a, unsigned pk, float c) { float d; asm("v_fma_mix_f32 %0, -%1, %2, %3 op_sel:[0,0,0] op_sel_hi:[0,1,0]" : "=v"(d) : "v"(a), "v"(pk), "v"(c)); return d; }
__device__ __forceinline__ float fmixn_hi(float a, unsigned pk, float c) { float d; asm("v_fma_mix_f32 %0, -%1, %2, %3 op_sel:[0,1,0] op_sel_hi:[0,1,0]" : "=v"(d) : "v"(a), "v"(pk), "v"(c)); return d; }
__device__ __forceinline__ unsigned h2pack(float lo, float hi) { typedef _Float16 h2 __attribute__((ext_vector_type(2))); h2 v = {(_Float16)lo, (_Float16)hi}; return __builtin_bit_cast(unsigned, v); }
struct ScOp { u32x4 q0, q1; u32x2 q2; unsigned short v; };
template <int DIR, int VAR>
__device__ __forceinline__ void scan_item(const PArgs& a, LAS unsigned char* lds, int bh, int half, int dummy) {
    unsigned char* ws = a.ws();
    int tid_ = threadIdx.x; asm volatile("" : "+v"(tid_)); const int tid = tid_, lane = tid & 63, wave = __builtin_amdgcn_readfirstlane(tid >> 6), c4 = lane & 15;
    const int irow = 32 * half + 4 * wave + (lane >> 4);
    const size_t hb = (size_t)bh * SEQ * 64;
    const bf16_t* gKK = (const bf16_t*)(ws + WS_KK) + hb; const bf16_t* gB = (const bf16_t*)(ws + WS_B + (size_t)DIR * 16 * MiB) + hb;
    const bf16_t* gKH = (const bf16_t*)(ws + WS_KH + (size_t)DIR * 16 * MiB) + hb; const bf16_t* gR = (const bf16_t*)(ws + WS_R) + hb; const bf16_t* gV = (const bf16_t*)(ws + WS_V) + hb;
    const float* gW = (const float*)(ws + WS_W + (size_t)DIR * 32 * MiB) + hb;
    float* gY = (float*)(ws + (dummy ? 950 * MiB : WS_WKV) + (size_t)DIR * 32 * MiB) + hb;
    const int sst = tid >> 4, sq = tid & 15; const size_t so = (size_t)sst * 64 + sq * 4; const int sd = sst * SC_STEPB + sq * 16;
    const int vt = tid - 256; const size_t vo = (size_t)(vt >> 3) * 64 + (vt & 7) * 8; const int vd = (vt >> 3) * SC_STEPB + 640 + (vt & 7) * 16;
    u32x2 rkk = {}, rb = {}, rkh = {}, rr = {}; f32x4 rw = {}; u32x4 rv = {};
#define SC_T0(cidx) (DIR ? SEQ - SC_CHUNK * ((cidx) + 1) : SC_CHUNK * (cidx))
#define SC_LOAD(cidx) do { const size_t _o = (size_t)SC_T0(cidx) * 64; \
        if (tid < 256) { rkk = *(const GAS u32x2*)(gKK + _o + so); rb = *(const GAS u32x2*)(gB + _o + so); rkh = *(const GAS u32x2*)(gKH + _o + so); rr = *(const GAS u32x2*)(gR + _o + so); rw = *(const GAS f32x4*)(gW + _o + so); } \
        else if (tid < 384) rv = *(const GAS u32x4*)(gV + _o + vo); } while (0)
#define SC_H4(vv) (u32x2){h2pack(bflo((vv)[0]), bfhi((vv)[0])), h2pack(bflo((vv)[1]), bfhi((vv)[1]))}
#define SC_STORE(bufb) do { if (tid < 256) { const u32x2 _a = SC_H4(rkk), _b = SC_H4(rb), _c = SC_H4(rkh), _d = SC_H4(rr); \
            *(LAS u32x4*)(lds + (bufb) + sd) = (u32x4){_a.x, _a.y, _b.x, _b.y}; *(LAS u32x4*)(lds + (bufb) + sd + 256) = (u32x4){_c.x, _c.y, _d.x, _d.y}; \
            *(LAS u32x2*)(lds + (bufb) + sst * SC_STEPB + 512 + sq * 8) = (u32x2){h2pack(rw[0], rw[1]), h2pack(rw[2], rw[3])}; } \
        else if (tid < 384) { *(LAS u32x4*)(lds + (bufb) + vd) = (u32x4){h2pack(bflo(rv.x), bfhi(rv.x)), h2pack(bflo(rv.y), bfhi(rv.y)), h2pack(bflo(rv.z), bfhi(rv.z)), h2pack(bflo(rv.w), bfhi(rv.w))}; } } while (0)
#define SC_RD(op, p) do { (op).q0 = *(const LAS u32x4*)((p) + 16 * c4); (op).q1 = *(const LAS u32x4*)((p) + 256 + 16 * c4); (op).q2 = *(const LAS u32x2*)((p) + 512 + 8 * c4); \
        (op).v = *(const LAS unsigned short*)((p) + 640 + 2 * irow); } while (0)
    const int fl_step = tid >> 5, fl_row = tid & 31;
#define SC_FLUSH(ybufb, t0) do { const LAS float* _q = (const LAS float*)(lds + (ybufb)) + fl_step * 512 + fl_row * 16; f32x4 _s = {0.f, 0.f, 0.f, 0.f}; \
        _Pragma("unroll") for (int _k = 0; _k < 4; ++_k) { const int _c = (_k + (tid >> 2)) & 3; _s += *(const LAS f32x4*)(_q + 4 * _c); } \
        ((GAS float*)gY)[(size_t)((t0) + fl_step) * 64 + 32 * half + fl_row] = (_s[0] + _s[1]) + (_s[2] + _s[3]); } while (0)
    SC_LOAD(0); SC_STORE(0);
    __syncthreads();
    float S0 = 0.f, S1 = 0.f, S2 = 0.f, S3 = 0.f;
#pragma unroll 1
    for (int cidx = 0; cidx < SC_NCH; ++cidx) {
        const int cb = cidx & 1;
        if (cidx + 1 < SC_NCH && VAR != 4) SC_LOAD(cidx + 1);
        if (cidx > 0 && VAR != 4 && VAR != 3) SC_FLUSH(SC_YOFF + (cb ^ 1) * SC_YB, SC_T0(cidx - 1));
        const LAS unsigned char* buf = lds + cb * SC_BUFB;
        LAS float* yb = (LAS float*)(lds + SC_YOFF + cb * SC_YB) + tid;
        ScOp cur, nxt;
        SC_RD(nxt, buf + (DIR ? SC_CHUNK - 1 : 0) * SC_STEPB);
#pragma unroll
        for (int jj = 0; jj < SC_CHUNK; ++jj) {
            const int s = DIR ? SC_CHUNK - 1 - jj : jj;
            cur = nxt;
            if (jj + 1 < SC_CHUNK && VAR != 2) { SC_RD(nxt, buf + (DIR ? s - 1 : s + 1) * SC_STEPB); }
            __builtin_amdgcn_sched_barrier(0);
            const float dot = fmix_hi(S1, cur.q0.x, fmix_lo(S0, cur.q0.x, 0.f)) + fmix_hi(S3, cur.q0.y, fmix_lo(S2, cur.q0.y, 0.f));
            const float vi = (float)__builtin_bit_cast(_Float16, cur.v);
            const float u0 = fmix_lo(S0, cur.q2.x, fmix_lo(vi, cur.q1.x, 0.f)), u1 = fmix_hi(S1, cur.q2.x, fmix_hi(vi, cur.q1.x, 0.f));
            const float u2 = fmix_lo(S2, cur.q2.y, fmix_lo(vi, cur.q1.y, 0.f)), u3 = fmix_hi(S3, cur.q2.y, fmix_hi(vi, cur.q1.y, 0.f));
            const float sk = VAR == 1 ? dot : red16(dot);
            S0 = fmixn_lo(sk, cur.q0.z, u0); S1 = fmixn_hi(sk, cur.q0.z, u1); S2 = fmixn_lo(sk, cur.q0.w, u2); S3 = fmixn_hi(sk, cur.q0.w, u3);
            { const float yv = fmix_hi(S1, cur.q1.z, fmix_lo(S0, cur.q1.z, 0.f)) + fmix_hi(S3, cur.q1.w, fmix_lo(S2, cur.q1.w, 0.f)); if (VAR == 3) { if (jj == SC_CHUNK - 1) yb[s * 512] = yv; else asm volatile("" :: "v"(yv)); } else yb[s * 512] = yv; }
        }
        if (cidx + 1 < SC_NCH && VAR != 4) SC_STORE((cb ^ 1) * SC_BUFB);
        if (VAR != 5) __syncthreads();
    }
    SC_FLUSH(SC_YOFF + ((SC_NCH & 1) ^ 1) * SC_YB, SC_T0(SC_NCH - 1));
    __syncthreads();
#undef SC_T0
#undef SC_LOAD
#undef SC_H4
#undef SC_STORE
#undef SC_RD
#undef SC_FLUSH
}
#ifndef PROBE_SCANVAR
#define PROBE_SCANVAR 0
#endif
__device__ __forceinline__ void phase_scan(const PArgs& a, LAS unsigned char* lds, int dummy) {
    for (int item = blockIdx.x; item < 256; item += gridDim.x) {
        const int half = item & 1, dir = (item >> 1) & 1, bh = item >> 2;
        if (dummy) { if (dir) scan_item<1, PROBE_SCANVAR>(a, lds, bh, half, 1); else scan_item<0, PROBE_SCANVAR>(a, lds, bh, half, 1); }
        else { if (dir) scan_item<1, 0>(a, lds, bh, half, 0); else scan_item<0, 0>(a, lds, bh, half, 0); }
    }
}

constexpr int RING_D = 4, RING_FLAGS = 2 * RING_D * 13568;
__device__ __forceinline__ void scan_serial_wave(const PArgs& a, int bh, int dir, int it, int lane, LAS unsigned char* ring, volatile LAS int* flg) {
    unsigned char* ws = a.ws();
    const int l31 = lane & 31, hi = lane >> 5;
    GAS float* gY = (GAS float*)(ws + WS_WKV + (size_t)dir * 32 * MiB) + (size_t)bh * SEQ * 64 + 32 * it + l31;
    f32x16 ST0 = f32x16{}, ST1 = f32x16{};
#define SS_ISSUE(P, cc) do { { unsigned _sp = 0; while (flg[0] <= (cc) && ++_sp < 2000000u) __builtin_amdgcn_s_sleep(1); } asm volatile("" ::: "memory"); \
        const LAS unsigned char* _r = ring + ((cc) & (RING_D - 1)) * 13568 + lane * 16; \
        _Pragma("unroll") for (int _k = 0; _k < 5; ++_k) P##aop[_k] = *(const LAS bf16x8*)(_r + REC_AOP + _k * 1024); \
        P##vt = *(const LAS bf16x8*)(_r + REC_VT + it * 1024); \
        _Pragma("unroll") for (int _k = 0; _k < 2; ++_k) P##ay[_k] = *(const LAS bf16x8*)(_r + REC_AY + _k * 1024); \
        _Pragma("unroll") for (int _k = 0; _k < 4; ++_k) P##as[_k] = *(const LAS bf16x8*)(_r + REC_AS + _k * 1024); \
        __builtin_amdgcn_sched_barrier(0); } while (0)
#define SS_RELEASE(cc) do { asm volatile("s_waitcnt lgkmcnt(0)" ::: "memory"); __builtin_amdgcn_sched_barrier(0); \
        if (lane == 0) __hip_atomic_fetch_add((LAS int*)&flg[4 + ((cc) & (RING_D - 1))], 1, __ATOMIC_RELAXED, __HIP_MEMORY_SCOPE_WORKGROUP); } while (0)
#define SS_BODY(P, cc) do { \
        f32x4 gc_[8]; { const LAS unsigned char* _g = ring + ((cc) & (RING_D - 1)) * 13568 + REC_GC + hi * 64; \
          _Pragma("unroll") for (int _k = 0; _k < 8; ++_k) gc_[_k] = *(const LAS f32x4*)(_g + ((_k >> 2) * 32 + (_k & 3) * 4) * 4); } \
        f32x16 UQ = f32x16{}; \
        { float f[8]; \
          _Pragma("unroll") for (int s_ = 0; s_ < 2; ++s_) { _Pragma("unroll") for (int jj = 0; jj < 8; ++jj) f[jj] = ST0[8 * s_ + jj]; \
            UQ = __builtin_amdgcn_mfma_f32_32x32x16_bf16(P##aop[s_], pack_frag(f), UQ, 0, 0, 0); } \
          _Pragma("unroll") for (int s_ = 0; s_ < 2; ++s_) { _Pragma("unroll") for (int jj = 0; jj < 8; ++jj) f[jj] = ST1[8 * s_ + jj]; \
            UQ = __builtin_amdgcn_mfma_f32_32x32x16_bf16(P##aop[2 + s_], pack_frag(f), UQ, 0, 0, 0); } } \
        UQ = __builtin_amdgcn_mfma_f32_32x32x16_bf16(P##aop[4], P##vt, UQ, 0, 0, 0); \
        bf16x8 Uf; { float f[8]; _Pragma("unroll") for (int jj = 0; jj < 8; ++jj) f[jj] = UQ[jj]; Uf = pack_frag(f); } \
        f32x16 Y = f32x16{}; \
        _Pragma("unroll") for (int r = 0; r < 8; ++r) Y[r] = UQ[8 + r]; \
        Y = __builtin_amdgcn_mfma_f32_32x32x16_bf16(P##ay[0], Uf, Y, 0, 0, 0); \
        Y = __builtin_amdgcn_mfma_f32_32x32x16_bf16(P##ay[1], P##vt, Y, 0, 0, 0); \
        _Pragma("unroll") for (int q = 0; q < 4; ++q) _Pragma("unroll") for (int e = 0; e < 4; ++e) { ST0[4 * q + e] *= gc_[q][e]; ST1[4 * q + e] *= gc_[4 + q][e]; } \
        ST0 = __builtin_amdgcn_mfma_f32_32x32x16_bf16(P##as[0], Uf, ST0, 0, 0, 0); ST0 = __builtin_amdgcn_mfma_f32_32x32x16_bf16(P##as[1], P##vt, ST0, 0, 0, 0); \
        ST1 = __builtin_amdgcn_mfma_f32_32x32x16_bf16(P##as[2], Uf, ST1, 0, 0, 0); ST1 = __builtin_amdgcn_mfma_f32_32x32x16_bf16(P##as[3], P##vt, ST1, 0, 0, 0); \
        _Pragma("unroll") for (int r = 0; r < 8; ++r) { const int t = 16 * (cc) + (r & 3) + 8 * (r >> 2) + 4 * hi; const int tt = dir ? SEQ - 1 - t : t; gY[(size_t)tt * 64] = Y[r]; } } while (0)
    bf16x8 A_aop[5], A_vt, A_ay[2], A_as[4];
    bf16x8 B_aop[5], B_vt, B_ay[2], B_as[4];
    SS_ISSUE(A_, 0);
#pragma unroll 1
    for (int c = 0; c < 128; c += 2) {
        SS_ISSUE(B_, c + 1);
        SS_BODY(A_, c);
        SS_RELEASE(c);
        if (c + 2 < 128) SS_ISSUE(A_, c + 2);
        SS_BODY(B_, c + 1);
        SS_RELEASE(c + 1);
    }
#undef SS_ISSUE
#undef SS_RELEASE
#undef SS_BODY

}

__device__ __forceinline__ void glds4(const void* gsrc, unsigned lds_dst) { unsigned keep;
    asm volatile("s_mov_b32 %0, m0\n\ts_mov_b32 m0, %2\n\ts_nop 0\n\tglobal_load_lds_dword %1, off\n\ts_mov_b32 m0, %0" : "=&s"(keep) : "v"(gsrc), "s"(lds_dst) : "memory"); }
__device__ __forceinline__ void scan_loader_wave(const PArgs& a, int bh, int dir, int lane, LAS unsigned char* ring, volatile LAS int* flg) {
    unsigned char* ws = a.ws();
    const unsigned char* rec0 = ws + WS_REC + (size_t)((bh * 2 + dir) * 128) * REC_BYTES;
    const unsigned ring0 = (unsigned)(uintptr_t)ring;
#pragma unroll 1
    for (int c = 0; c < 128; ++c) {
        const int slot = c & (RING_D - 1);
        if (c >= RING_D) { unsigned sp = 0; while (flg[4 + slot] < 2 * (c / RING_D) && ++sp < 2000000u) __builtin_amdgcn_s_sleep(1); }
        asm volatile("" ::: "memory");
        const unsigned char* r = rec0 + (size_t)c * REC_BYTES; const unsigned dst = (unsigned)__builtin_amdgcn_readfirstlane(ring0 + slot * 13568);
#pragma unroll
        for (int k = 0; k < 13; ++k) { const int off = k < 5 ? REC_AOP + k * 1024 : k < 7 ? REC_AY + (k - 5) * 1024 : k < 11 ? REC_AS + (k - 7) * 1024 : REC_VT + (k - 11) * 1024;
            attn_body::glds16(r + off + lane * 16, dst + off); }
        glds4(r + REC_GC + lane * 4, dst + REC_GC);
        asm volatile("s_waitcnt vmcnt(14)" ::: "memory");
        if (lane == 0) flg[0] = c;
    }
    asm volatile("s_waitcnt vmcnt(0)" ::: "memory");
    if (lane == 0) flg[0] = 128;
}

constexpr int AQ_LDS = 100000;
__device__ __forceinline__ void rwkv_post(const PArgs& a, int l, int hv0, int nhv, int wave, int lane) {
    unsigned char* ws = a.ws();
    const int sub = lane >> 4, c4 = lane & 15;
    bf16_t* MIX = (bf16_t*)(ws + WS_MIX);
    for (int it = wave; it < nhv / 4; it += NWAVES) {
        const size_t hv = (size_t)hv0 + (size_t)it * 4 + sub; const size_t o = hv * 64 + 4 * c4;
        const f32x4 f = *(const GAS f32x4*)((const float*)(ws + WS_WKV) + o), bk = *(const GAS f32x4*)((const float*)(ws + WS_WKV + 32 * MiB) + o);
        float g4[4], bo[4]; unpack4(*(const GAS u32x2*)((const bf16_t*)(ws + WS_G) + o), g4); unpack4(*(const GAS u32x2*)((const bf16_t*)(ws + WS_BON) + o), bo);
        const f32x4 x = f + bk;
        const float mean = red16((x[0] + x[1]) + (x[2] + x[3])) * (1.f / 64.f);
        const f32x4 d = x - mean;
        const float var = red16((d[0] * d[0] + d[1] * d[1]) + (d[2] * d[2] + d[3] * d[3])) * (1.f / 64.f);
        const float rs = rsqrtf(var + GN_EPS);
        const int bh = (int)(hv / SEQ), t = (int)(hv % SEQ), bb = bh >> 2, hh = bh & 3, c = 64 * hh + 4 * c4;
        const f32x4 gg = *(const GAS f32x4*)(a.in(I_GNG) + l * 256 + c), gb = *(const GAS f32x4*)(a.in(I_GNB) + l * 256 + c);
        float y[4];
#pragma unroll
        for (int e = 0; e < 4; ++e) y[e] = (d[e] * rs * gg[e] + gb[e] + bo[e]) * g4[e];
        u32x2 ov; ov.x = cvtpk(y[0], y[1]); ov.y = cvtpk(y[2], y[3]);
        *(GAS u32x2*)(MIX + ((size_t)bb * SEQ + t) * DM + 256 + c) = ov;
    }
}
__device__ __forceinline__ void phase_attn_post(const PArgs& a, unsigned char* lds_generic, int l, int bx) {
    unsigned char* ws = a.ws();
    int tid_ = threadIdx.x; asm volatile("" : "+v"(tid_)); const int tid = tid_, lane = tid & 63, wave = __builtin_amdgcn_readfirstlane(tid >> 6);
    if (bx < 64) {
        LAS unsigned char* L = (LAS unsigned char*)lds_generic; volatile LAS int* flags = (volatile LAS int*)(L + RING_FLAGS);
        if (tid < 16) flags[tid] = 0;
        __syncthreads();
        if (wave < 4) scan_serial_wave(a, bx, wave >> 1, wave & 1, lane, L + (wave >> 1) * RING_D * 13568, flags + (wave >> 1) * 8);
        else if (wave < 6) scan_loader_wave(a, bx, wave - 4, lane, L + (wave - 4) * RING_D * 13568, flags + (wave - 4) * 8);
        asm volatile("s_waitcnt vmcnt(0)" ::: "memory");
        __syncthreads();
        rwkv_post(a, l, bx * SEQ, SEQ, wave, lane);
    }
    const attn_body::bf16* PROJ = (const attn_body::bf16*)(ws + WS_PROJ); attn_body::bf16* MIXO = (attn_body::bf16*)(ws + WS_MIX) + 512;
    unsigned* qhead = (unsigned*)(ws + WS_CTL) + CW_AQ + l * 64;
    volatile LAS unsigned* slot = (volatile LAS unsigned*)((LAS unsigned char*)lds_generic + AQ_LDS);
    for (;;) {
        if (tid == 0) *slot = __hip_atomic_fetch_add(qhead, 1u, __ATOMIC_RELAXED, __HIP_MEMORY_SCOPE_AGENT);
        __syncthreads();
        const int uidx = (int)__builtin_amdgcn_readfirstlane(*slot);
        __syncthreads();
        if (uidx >= 1024) break;
        const int grp = uidx >> 5, u = uidx & 31, b = grp >> 1, kvh = grp & 1, h = kvh * 4 + (u >> 3), qb = u & 7;
        attn_body::attn_unit<8>(b, h, kvh, qb, PROJ + C_Q, PROJ + C_K, PROJ + C_V, MIXO, (char*)lds_generic);
    }
}

constexpr int RT_LOG = 0, RT_INFO = 8 * 16 * 48 * 4;
__device__ __forceinline__ void phase_ln1_router(const PArgs& a, LAS unsigned char* lds, int l, int dry, int grank, const unsigned* pcnt) {
    unsigned char* ws = a.ws();
    int tid_ = threadIdx.x; asm volatile("" : "+v"(tid_)); const int tid = tid_, lane = tid & 63, wave = __builtin_amdgcn_readfirstlane(tid >> 6);
    const float* Z = (const float*)(ws + WS_Z); bf16_t* XN = (bf16_t*)(ws + WS_XN); float* STAT = (float*)(ws + WS_STAT);
    LAS float* LOGT = (LAS float*)(lds + RT_LOG) + wave * 16 * 48;
    LAS int* inf_e = (LAS int*)(lds + RT_INFO); LAS int* inf_r = inf_e + 256; LAS float* inf_g = (LAS float*)(inf_r + 256); LAS int* lcnt = (LAS int*)(inf_g + 256); LAS int* lbase = lcnt + 32;
    if (tid < 32) lcnt[tid] = 0;
    __syncthreads();
    unsigned* gcnt = (unsigned*)(ws + WS_CTL) + CW_CNT + l * 64;
    GAS int* list = (GAS int*)(ws + WS_LIST); GAS float* gate = (GAS float*)(ws + WS_GLIST);
    const bf16_t* RWH = (const bf16_t*)(ws + WS_RWB) + (size_t)l * 2 * 48 * 1024; const bf16_t* RWL = RWH + 48 * 1024;
    const float* lng = a.in(I_LN1G) + l * DM; const float* lnb = a.in(I_LN1B) + l * DM;
    for (int chunk = grank; chunk < NTOK / 128; chunk += gridDim.x) {
        const int tb = chunk * 128, tw = tb + wave * 16;
        if (pcnt) wait_count(pcnt + 16 * (chunk >> 1), 32u, (unsigned*)(ws + WS_CTL) + 8);
        float mymean = 0.f, myrstd = 0.f;
        { f32x4 lg[4], lb[4];
#pragma unroll
          for (int j = 0; j < 4; ++j) { lg[j] = *(const GAS f32x4*)(lng + 4 * lane + 256 * j); lb[j] = *(const GAS f32x4*)(lnb + 4 * lane + 256 * j); }
#pragma unroll 1
          for (int rd = 0; rd < 4; ++rd) {
            f32x4 x[4][4];
#pragma unroll
            for (int tk = 0; tk < 4; ++tk)
#pragma unroll
                for (int j = 0; j < 4; ++j) x[tk][j] = *(const GAS f32x4*)(Z + (size_t)(tw + rd * 4 + tk) * DM + 4 * lane + 256 * j);
#pragma unroll
            for (int tk = 0; tk < 4; ++tk) { const int tl = rd * 4 + tk; float s = 0.f;
#pragma unroll
                for (int j = 0; j < 4; ++j) s += (x[tk][j][0] + x[tk][j][1]) + (x[tk][j][2] + x[tk][j][3]);
                const float mean = wave_sum(s) * (1.f / DM); float s2 = 0.f;
#pragma unroll
                for (int j = 0; j < 4; ++j) { x[tk][j] = x[tk][j] - mean; s2 += (x[tk][j][0] * x[tk][j][0] + x[tk][j][1] * x[tk][j][1]) + (x[tk][j][2] * x[tk][j][2] + x[tk][j][3] * x[tk][j][3]); }
                const float rstd = rsqrtf(wave_sum(s2) * (1.f / DM) + LN_EPS);
                if ((lane & 15) == tl) { mymean = mean; myrstd = rstd; }
                if (lane == 0 && !dry) *(GAS f32x2*)(STAT + 2 * (size_t)(tw + tl)) = (f32x2){mean, rstd};
                bf16_t* xr = XN + (size_t)(tw + tl) * DM;
#pragma unroll
                for (int j = 0; j < 4; ++j) { const f32x4 v = x[tk][j] * rstd * lg[j] + lb[j];
                    u32x2 o; o.x = cvtpk(v[0], v[1]); o.y = cvtpk(v[2], v[3]); if (!dry) *(GAS u32x2*)(xr + 4 * lane + 256 * j) = o; } }
          } }
        { const int tk = lane & 15, kg = lane >> 4;
          const float* zr = Z + (size_t)(tw + tk) * DM + 8 * kg;
          f32x4 acc[3] = {f32x4{0.f, 0.f, 0.f, 0.f}, f32x4{0.f, 0.f, 0.f, 0.f}, f32x4{0.f, 0.f, 0.f, 0.f}};
#pragma unroll 4
          for (int s_ = 0; s_ < 32; ++s_) {
              const f32x4 z0 = *(const GAS f32x4*)(zr + 32 * s_), z1 = *(const GAS f32x4*)(zr + 32 * s_ + 4);
              float xv[8], xl[8];
#pragma unroll
              for (int e = 0; e < 4; ++e) { xv[e] = (z0[e] - mymean) * myrstd; xv[4 + e] = (z1[e] - mymean) * myrstd; }
              u32x4 ph; ph.x = cvtpk(xv[0], xv[1]); ph.y = cvtpk(xv[2], xv[3]); ph.z = cvtpk(xv[4], xv[5]); ph.w = cvtpk(xv[6], xv[7]);
              xl[0] = xv[0] - bflo(ph.x); xl[1] = xv[1] - bfhi(ph.x); xl[2] = xv[2] - bflo(ph.y); xl[3] = xv[3] - bfhi(ph.y);
              xl[4] = xv[4] - bflo(ph.z); xl[5] = xv[5] - bfhi(ph.z); xl[6] = xv[6] - bflo(ph.w); xl[7] = xv[7] - bfhi(ph.w);
              const bf16x8 Ah = __builtin_bit_cast(bf16x8, ph), Al = pack_frag(xl);
#pragma unroll
              for (int nb = 0; nb < 3; ++nb) { const size_t wo = (size_t)(16 * nb + tk) * 1024 + 32 * s_ + 8 * kg;
                  const bf16x8 Bh = *(const GAS bf16x8*)(RWH + wo), Bl = *(const GAS bf16x8*)(RWL + wo);
                  acc[nb] = __builtin_amdgcn_mfma_f32_16x16x32_bf16(Ah, Bh, acc[nb], 0, 0, 0);
                  acc[nb] = __builtin_amdgcn_mfma_f32_16x16x32_bf16(Ah, Bl, acc[nb], 0, 0, 0);
                  acc[nb] = __builtin_amdgcn_mfma_f32_16x16x32_bf16(Al, Bh, acc[nb], 0, 0, 0); } }
#pragma unroll
          for (int nb = 0; nb < 3; ++nb)
#pragma unroll
              for (int r = 0; r < 4; ++r) LOGT[(4 * kg + r) * 48 + 16 * nb + tk] = acc[nb][r]; }
        asm volatile("s_waitcnt lgkmcnt(0)" ::: "memory");
        if (lane < 16) {
            const LAS float* lt = LOGT + lane * 48;
            float gl[4];
#pragma unroll
            for (int g = 0; g < 4; ++g) gl[g] = lt[32 + g] + ((const GAS float*)a.in(I_RGB))[l * 4 + g] + ((const GAS float*)(ws + WS_RB))[l * 48 + 32 + g];
            int grp = 0; float gm = gl[0];
#pragma unroll
            for (int g = 1; g < 4; ++g) if (gl[g] > gm) { gm = gl[g]; grp = g; }
            float den = 0.f;
#pragma unroll
            for (int g = 0; g < 4; ++g) den += __expf(gl[g] - gm);
            const float gwt = 1.f / den;
            float el[8];
#pragma unroll
            for (int j = 0; j < 8; ++j) el[j] = lt[grp * 8 + j] + ((const GAS float*)a.in(I_REB))[l * 32 + grp * 8 + j] + ((const GAS float*)(ws + WS_RB))[l * 48 + grp * 8 + j];
            int i1 = 0; float v1 = el[0];
#pragma unroll
            for (int j = 1; j < 8; ++j) if (el[j] > v1) { v1 = el[j]; i1 = j; }
            int i2 = -1; float v2 = -INFINITY;
#pragma unroll
            for (int j = 0; j < 8; ++j) if (j != i1 && el[j] > v2) { v2 = el[j]; i2 = j; }
            const float e2 = __expf(v2 - v1), g1 = gwt / (1.f + e2), g2 = gwt * e2 / (1.f + e2);
            const int p = (wave * 16 + lane) * 2, ea = grp * 8 + i1, eb = grp * 8 + i2;
            inf_e[p] = ea; inf_g[p] = g1; inf_r[p] = atomicAdd((int*)&lcnt[ea], 1);
            inf_e[p + 1] = eb; inf_g[p + 1] = g2; inf_r[p + 1] = atomicAdd((int*)&lcnt[eb], 1);
        }
        __syncthreads();
        if (tid < 32) { const int n = lcnt[tid]; lbase[tid] = (n && !dry) ? (int)atomicAdd(gcnt + tid, (unsigned)n) : 0; lcnt[tid] = 0; }
        __syncthreads();
        if (tid < 256 && !dry) { const int e = inf_e[tid], pos = lbase[e] + inf_r[tid], pair = tb * 2 + tid;
            list[e * LISTCAP + pos] = pair; gate[e * LISTCAP + pos] = inf_g[tid]; }
        __syncthreads();
    }
}

__device__ __forceinline__ int moe_build_tab(const PArgs& a, LAS unsigned char* lds, int l) {
    LAS int* tab = (LAS int*)(lds + MOE_TAB_OFF);
    const unsigned* gcnt = (const unsigned*)(a.ws() + WS_CTL) + CW_CNT + l * 64;
    int tid_ = threadIdx.x; asm volatile("" : "+v"(tid_)); const int tid = tid_;
    if (tid < 64) {
        const int cnt = tid < 32 ? (int)__hip_atomic_load(gcnt + (tid & 31), __ATOMIC_RELAXED, __HIP_MEMORY_SCOPE_AGENT) : 0;
        const int nt = (cnt + 255) >> 8; int inc = nt;
#pragma unroll
        for (int d = 1; d < 32; d <<= 1) { const int o = __shfl_up(inc, d); if (tid >= d) inc += o; }
        const int ts = inc - nt;
        if (tid < 32) { tab[64 + tid] = cnt; tab[tid] = ts; for (int k = 0; k < nt; ++k) tab[128 + ts + k] = tid; if (tid == 31) tab[32] = inc; } }
    __syncthreads();
    return tab[32];
}

__device__ __forceinline__ void phase_ln2(const PArgs& a, int l, int grank, int G, int dry, unsigned* pcnt) {
    unsigned char* ws = a.ws();
    int tid_ = threadIdx.x; asm volatile("" : "+v"(tid_)); const int tid = tid_, lane = tid & 63, wave = __builtin_amdgcn_readfirstlane(tid >> 6);
    float* X = a.out(); bf16_t* XN = (bf16_t*)(ws + WS_XN); const bf16_t* Y = (const bf16_t*)(ws + WS_Y);
    const bool last = (l + 1 == DEPTH);
    f32x4 lg[4], lb[4];
#pragma unroll
    for (int j = 0; j < 4; ++j) { lg[j] = *(const GAS f32x4*)(a.in(I_LN2G) + l * DM + 4 * lane + 256 * j); lb[j] = *(const GAS f32x4*)(a.in(I_LN2B) + l * DM + 4 * lane + 256 * j); }
    for (int chunk = grank; chunk < NTOK / 128; chunk += G) {
    for (int ti = 0; ti < 16; ti += 2) {
        f32x4 x[2][4]; float s[2] = {0.f, 0.f};
#pragma unroll
        for (int u = 0; u < 2; ++u) { const int tok = chunk * 128 + wave + 8 * (ti + u);
            const bf16_t* xr = XN + (size_t)tok * DM; const bf16_t* y0 = Y + (size_t)(2 * tok) * DM; const bf16_t* y1 = y0 + DM;
#pragma unroll
            for (int j = 0; j < 4; ++j) { float xv[4], ya[4], yb[4]; unpack4(*(const GAS u32x2*)(xr + 4 * lane + 256 * j), xv);
                unpack4(*(const GAS u32x2*)(y0 + 4 * lane + 256 * j), ya); unpack4(*(const GAS u32x2*)(y1 + 4 * lane + 256 * j), yb);
#pragma unroll
                for (int e = 0; e < 4; ++e) x[u][j][e] = ALPHA * xv[e] + (ya[e] + yb[e]);
                s[u] += (x[u][j][0] + x[u][j][1]) + (x[u][j][2] + x[u][j][3]); } }
#pragma unroll
        for (int u = 0; u < 2; ++u) { const int tok = chunk * 128 + wave + 8 * (ti + u);
            float* row = X + (size_t)tok * DM; bf16_t* xr = XN + (size_t)tok * DM;
            const float mean = wave_sum(s[u]) * (1.f / DM); float s2 = 0.f;
#pragma unroll
            for (int j = 0; j < 4; ++j) { x[u][j] = x[u][j] - mean; s2 += (x[u][j][0] * x[u][j][0] + x[u][j][1] * x[u][j][1]) + (x[u][j][2] * x[u][j][2] + x[u][j][3] * x[u][j][3]); }
            const float rstd = rsqrtf(wave_sum(s2) * (1.f / DM) + LN_EPS);
#pragma unroll
            for (int j = 0; j < 4; ++j) { x[u][j] = x[u][j] * rstd * lg[j] + lb[j]; if (!dry) { if (last) *(GAS f32x4*)(row + 4 * lane + 256 * j) = x[u][j];
                else { u32x2 o; o.x = cvtpk(x[u][j][0], x[u][j][1]); o.y = cvtpk(x[u][j][2], x[u][j][3]); *(GAS u32x2*)(xr + 4 * lane + 256 * j) = o; } } } }
    }
        if (pcnt) { asm volatile("s_waitcnt vmcnt(0)" ::: "memory");
            if (lane == 0) __hip_atomic_fetch_add(pcnt + 16 * (chunk >> 1), 1u, __ATOMIC_RELAXED, __HIP_MEMORY_SCOPE_AGENT); }
    }
}

constexpr int NPH_L = 8, NPHASE = 1 + DEPTH * NPH_L;
__global__ void __launch_bounds__(NTHR, 2) hyb_fwd(Args args) {
    extern __shared__ __attribute__((aligned(16))) unsigned char lds_raw[];
    LAS unsigned char* lds = (LAS unsigned char*)lds_raw;
    const int tid = threadIdx.x;
    const int G = gridDim.x; const int bx = blockIdx.x; const int vcu = (G % 8 == 0) ? (bx % 8) * (G / 8) + bx / 8 : bx;
    unsigned char* ws = (unsigned char*)(GAS unsigned char*)args.ws;
    volatile LAS unsigned* st = (volatile LAS unsigned*)(lds + LDSCTL_OFF);
    if (tid < 64) st[tid] = 0u;
    __syncthreads();
    XcdBarrier bar; bar.bar = (unsigned*)(ws + WS_CTL) + CW_BAR; bar.x = 0; bar.st = st;
    if (!args.multi) bar = xcd_barrier_post((unsigned*)(ws + WS_CTL) + CW_BAR, st);
    int ph0 = args.ph_lo;
    if (ph0 == 0) {
        PArgs pa; pa.kp = (kptr_t)__builtin_amdgcn_kernarg_segment_ptr(); pa.ws_ = args.ws; pa.out_ = args.out;
        if (PHMASK & 1) phase_prologue(pa, lds, vcu, G);
        if (PROBE_DUP & 512) { cg::this_grid().sync(); phase_prologue(pa, lds, vcu, G); }
        ph0 = 1;
        if (ph0 < args.ph_hi) cg::this_grid().sync();
    }
    if (tid == 0) {
        if (args.multi) { st[2] = (unsigned)bx; st[3] = 0u; st[4] = (unsigned)G; }
        else { unsigned P = 0, n = 1;
            unsigned std_ = 1u;
            for (unsigned j = 0; j < 16; ++j) { const unsigned cj = xb_ld(bar.bar + XB_XCNT(j)); P += (j < bar.x) ? cj : 0u; n = (j == bar.x) ? cj : n; std_ &= (cj == (j < 8u ? 32u : 0u)) ? 1u : 0u; }
            st[3] = P; st[4] = n;
            st[5] = (G == 256) ? std_ : 0u; } }
    __syncthreads();
    for (int ph = ph0; ph < args.ph_hi; ++ph) {
        const int kq = (ph - 1) % NPH_L; const bool xl = !args.multi && st[5] != 0u;
        if (ph > ph0 && !(kq == 6 && !args.multi && !PROBE_KEEPBAR) && !(xl && (HANDOFF_SEAMS >> kq & 1))) {
            if (MK_ALLCG) cg::this_grid().sync(); else xcd_barrier(bar);
        }
#if PROBE_X == 5
        _Pragma("unroll 1") for (int q_ = 0; q_ < 4; ++q_) xcd_barrier(bar);
#endif
        PArgs pa; pa.kp = (kptr_t)__builtin_amdgcn_kernarg_segment_ptr(); asm volatile("" : "+s"(pa.kp)); pa.ws_ = args.ws; pa.out_ = args.out; asm volatile("" : "+s"(pa.ws_), "+s"(pa.out_));
        const int l = (ph - 1) / NPH_L, k = (ph - 1) % NPH_L;
        unsigned char* pws = pa.ws();
        const int nrep = ((PROBE_DUP >> k) & 1) ? 2 : 1;
        for (int rep = 0; rep < nrep; ++rep) {
        if (rep) xcd_barrier(bar);
        if (k == 0 && (PHMASK & 2)) {
            __syncthreads();
            pg8::XDenseOrder S; S.init_xcd(NTOK / 256, INP / 256, G, st); S.Bt = (const char*)(pws + WS_WIN + (size_t)l * 4 * MiB); S.Kb = DM * 2;
            if (l > 0 && !args.multi) { S.pcnt = (const unsigned*)(pws + WS_CTL) + CW_PAN + ((l - 1) * 4 + 1) * 2048; S.need = 16u; S.tmo = (unsigned*)(pws + WS_CTL) + 8; }
            pg8::EpiProj E{(bf16_t*)(pws + WS_PROJ), INP, (unsigned*)(pws + WS_CTL) + CW_PAN + (l * 4 + 2) * 2048};
            pg8::gemm_phase(lds, (const char*)(pws + WS_XN), DM, S, E);
        } else if (k == 1 && (PHMASK & 4)) {
#if PROBE_X == 6
            phase_prep(pa, lds, l, 4, PT_I0, PT_IHI, PT_STEP, nullptr); xcd_barrier(bar);
#endif
#if PROBE_X >= 8
            phase_prep(pa, lds, l, PROBE_X - 2, PT_I0, PT_IHI, PT_STEP, nullptr); xcd_barrier(bar);
#endif
            phase_prep(pa, lds, l, 0, PT_I0, PT_IHI, PT_STEP, args.multi ? nullptr : (const unsigned*)(pws + WS_CTL) + CW_PAN + (l * 4 + 2) * 2048);
#if PROBE_X == 7
            xcd_barrier(bar); phase_prep(pa, lds, l, 5, PT_I0, PT_IHI, PT_STEP, nullptr);
#endif
        } else if (k == 2 && (PHMASK & 16)) { phase_attn_post(pa, lds_raw, l, bx);
#if PROBE_X == 2
            xcd_barrier(bar); phase_attn_post(pa, lds_raw, l, bx);
#endif
        } else if (k == 3 && (PHMASK & 32)) {
            pg8::XDenseOrder S; S.init_xcd(NTOK / 256, DM / 256, G, st); S.Bt = (const char*)(pws + WS_WO + (size_t)l * 2 * MiB); S.Kb = DM * 2;
            pg8::EpiRes E{(const bf16_t*)(pws + WS_XN), (float*)(pws + WS_Z), nrep == 2 && rep == 0, (unsigned*)(pws + WS_CTL) + CW_PAN + (l * 4 + 0) * 2048};
            pg8::gemm_phase(lds, (const char*)(pws + WS_MIX), DM, S, E);
        } else if (k == 4 && (PHMASK & 64)) {
#if PROBE_X == 3
            phase_ln1_router(pa, lds, l, 1, (int)(st[2] + st[3]), nullptr); xcd_barrier(bar);
#endif
#if PROBE_X == 4
            phase_ln2(pa, l, vcu, G, 1, nullptr); xcd_barrier(bar);
#endif
            phase_ln1_router(pa, lds, l, 0, (int)(st[2] + st[3]), args.multi ? nullptr : (const unsigned*)(pws + WS_CTL) + CW_PAN + (l * 4 + 0) * 2048);
        } else if (k == 5 && (PHMASK & 128)) {
            const int T = moe_build_tab(pa, lds, l);
            pg8::MoeOrder S; S.tab = (const LAS int*)(lds + MOE_TAB_OFF); S.list = (const GAS int*)(pws + WS_LIST);
            S.wbase = (const char*)(pws + WS_WGU); S.wstride = (size_t)1024 * DM * 2; S.Kb = DM * 2; S.gather = 1;
            const bool ho = !args.multi && !PROBE_KEEPBAR;
            S.init_xcd(T, G, st);
            pg8::EpiMoe1 E{(bf16_t*)(pws + WS_H), ho ? (unsigned*)(pws + WS_CTL) + CW_MH + l * 18432 : nullptr};
            pg8::gemm_phase(lds, (const char*)(pws + WS_XN), DM, S, E);
        } else if (k == 6 && (PHMASK & 256)) {
            const int T = (!args.multi && !PROBE_KEEPBAR) ? ((const LAS int*)(lds + MOE_TAB_OFF))[32] : moe_build_tab(pa, lds, l);
            pg8::MoeOrder S; S.tab = (const LAS int*)(lds + MOE_TAB_OFF); S.list = (const GAS int*)(pws + WS_LIST);
            S.wbase = (const char*)(pws + WS_WD); S.wstride = (size_t)DM * EH * 2; S.Kb = EH * 2; S.gather = 0;
            S.init_xcd(T, G, st);
            if (!args.multi && !PROBE_KEEPBAR) { S.rank = S.nloc - 1 - S.rank;
                S.hcnt = (const unsigned*)(pws + WS_CTL) + CW_MH + l * 18432; S.tmo = (unsigned*)(pws + WS_CTL) + 8; }
            pg8::EpiMoe2 E{(bf16_t*)(pws + WS_Y), (const LAS int*)(lds + MOE_TAB_OFF), (const GAS int*)(pws + WS_LIST), (const GAS float*)(pws + WS_GLIST)};
            pg8::gemm_phase(lds, (const char*)(pws + WS_H), EH, S, E);
        } else if (k == 7 && (PHMASK & 512)) { phase_ln2(pa, l, (int)(st[2] + st[3]), G, nrep == 2 && rep == 0, (args.multi || l + 1 >= DEPTH) ? nullptr : (unsigned*)(pws + WS_CTL) + CW_PAN + (l * 4 + 1) * 2048); if (l + 1 < DEPTH) convert_layer_weights(pa, lds, l + 1, vcu, G, 2); }
        }
    }
}

extern "C" void kernel_launch(void* const* d_in, const int* in_sizes, int n_in, void* d_out, int out_size, void* d_ws, size_t ws_size, hipStream_t stream) {
    static int grid = 0;
    if (grid == 0) {
        if (n_in != 30 || out_size != NTOK * DM || ws_size < WS_END) { fprintf(stderr, "kernel_launch: unexpected shapes (n_in %d, out %d, ws %zu)\n", n_in, out_size, ws_size); grid = -1; return; }
        int dev = 0, cus = 0, per_cu = 0;
        hipGetDevice(&dev); hipDeviceGetAttribute(&cus, hipDeviceAttributeMultiprocessorCount, dev);
        if (hipFuncSetAttribute((const void*)hyb_fwd, hipFuncAttributeMaxDynamicSharedMemorySize, LDS_BYTES) != hipSuccess) { fprintf(stderr, "kernel_launch: hipFuncSetAttribute failed\n"); grid = -1; return; }
        if (hipOccupancyMaxActiveBlocksPerMultiprocessor(&per_cu, (const void*)hyb_fwd, NTHR, LDS_BYTES) != hipSuccess || per_cu < 1) { fprintf(stderr, "kernel_launch: occupancy query says %d\n", per_cu); per_cu = 1; }
        (void)hipGetLastError();
        grid = cus * 1;
        fprintf(stderr, "kernel_launch: %d CUs, occupancy %d, grid %d\n", cus, per_cu, grid);
    }
    if (grid < 0) return;
    hipMemsetAsync((char*)d_ws + WS_CTL, 0, CTL_ZERO_BYTES, stream);
    Args a{};
    for (int i = 0; i < 30; ++i) a.in[i] = (const float*)d_in[i];
    a.out = (float*)d_out; a.ws = (unsigned char*)d_ws;
#if MK_MULTI
    a.multi = 1;
    for (int ph = 0; ph < NPHASE; ++ph) { a.ph_lo = ph; a.ph_hi = ph + 1; hipLaunchKernelGGL(hyb_fwd, dim3(grid), dim3(NTHR), LDS_BYTES, stream, a); }
#else
    a.multi = 0; a.ph_lo = 0; a.ph_hi = NPHASE;
    void* kargs[] = {&a};
    hipError_t e = hipLaunchCooperativeKernel((const void*)hyb_fwd, dim3(grid), dim3(NTHR), kargs, LDS_BYTES, stream);
    if (e != hipSuccess) fprintf(stderr, "cooperative launch failed: %s (grid %d)\n", hipGetErrorString(e), grid);
#endif
}
```

```cpp
#include <hip/hip_runtime.h>
#include <hip/hip_cooperative_groups.h>
#include <hip/hip_bf16.h>
#include <cstdio>
#include <cstdint>
namespace cg = cooperative_groups;

#ifndef MK_MULTI
#define MK_MULTI 0
#endif
#ifndef PROBE_DUP
#define PROBE_DUP 0
#endif
#ifndef PROBE_PREPDRY
#define PROBE_PREPDRY 1
#endif
#ifndef PROBE_X
#define PROBE_X 0
#endif
#ifndef PHMASK
#define PHMASK 1023
#endif
#ifndef MK_ALLCG
#define MK_ALLCG 0
#endif

#define GAS __attribute__((address_space(1)))
#define LAS __attribute__((address_space(3)))
typedef unsigned short bf16_t;
typedef short bf16x8 __attribute__((ext_vector_type(8)));
typedef float f32x4 __attribute__((ext_vector_type(4)));
typedef float f32x2 __attribute__((ext_vector_type(2)));
typedef float f32x16 __attribute__((ext_vector_type(16)));
typedef unsigned u32x4 __attribute__((ext_vector_type(4)));
typedef unsigned u32x2 __attribute__((ext_vector_type(2)));
typedef __bf16 bf16x2_t __attribute__((ext_vector_type(2)));

constexpr int NB = 16, SEQ = 2048, DM = 1024, NTOK = NB * SEQ, DEPTH = 4;
constexpr int INW = 1984, INP = 2048;
constexpr int C_RW = 256, C_Q = 1216, C_K = 1728, C_V = 1856;
constexpr int NEXP = 32, EH = 512;
constexpr float ALPHA = 1.6817928305074290f;
constexpr float LN_EPS = 1e-5f, GN_EPS = 64e-5f, QK_EPS = 1e-6f;
constexpr float QSCALE = 0.125f * 1.4426950408889634f;
constexpr int NWAVES = 8, NTHR = 512;
constexpr int LDS_BYTES = 163840;
constexpr int LISTCAP = 32768;

constexpr size_t MiB = 1u << 20;
constexpr size_t WS_CTL = 0, CTL_ZERO_BYTES = 1 * MiB;
constexpr size_t WS_SMALL = 1 * MiB;
constexpr size_t WS_WGU = 10 * MiB, WS_WD = 74 * MiB;
constexpr size_t WS_WIN = 983 * MiB  , WS_WO = 999 * MiB  ;
constexpr size_t WS_REC = 106 * MiB;
constexpr size_t WS_XN = 320 * MiB, WS_MIX = 384 * MiB, WS_PROJ = 448 * MiB;
constexpr size_t WS_R = 576 * MiB, WS_V = 592 * MiB, WS_KK = 608 * MiB, WS_KH = 624 * MiB  , WS_B = 656 * MiB  ;
constexpr size_t WS_G = 688 * MiB, WS_BON = 704 * MiB, WS_W = 720 * MiB  , WS_WKV = 784 * MiB  ;
constexpr size_t WS_FC0 = 608 * MiB  , WS_FC1 = 720 * MiB  ;
constexpr size_t WS_WH0 = 672 * MiB  , WS_WH1 = 576 * MiB  ;
constexpr size_t WS_LIST = 848 * MiB  , WS_GATE = 852 * MiB  ;
constexpr size_t WS_H = 106 * MiB  , WS_Y = 180 * MiB  ;
constexpr size_t WS_Z = 853 * MiB  , WS_STAT = 981 * MiB  , WS_RWB = 982 * MiB  ;
constexpr size_t WS_RB = 981 * MiB + 512 * 1024;
constexpr size_t WS_GLIST = 1007 * MiB;
constexpr size_t WS_END = 1014 * MiB;
constexpr size_t SM_ROPE = 0;
constexpr size_t SM_PWT = 16384;
constexpr size_t SM_WUPT = SM_PWT + 131072;
constexpr size_t SM_AUPT = SM_WUPT + 131072;
constexpr size_t SM_GUPT = SM_AUPT + 131072;
constexpr size_t SM_RWT = SM_GUPT + 131072;
static_assert(SM_RWT + 589824 <= 3 * MiB, "small region");
constexpr int CW_BAR = 4096;
constexpr int CW_CNT = 16384;
#define PT_I0 ((int)((unsigned)(NTOK / 64) * st[3] / (unsigned)G + st[2]))
#define PT_IHI ((int)((unsigned)(NTOK / 64) * (st[3] + st[4]) / (unsigned)G))
#define PT_STEP ((int)st[4])
#ifndef PROBE_P2
#define PROBE_P2 0
#endif
#ifndef HANDOFF_SEAMS
#define HANDOFF_SEAMS 0x13
#endif
#ifndef PROBE_KEEPBAR
#define PROBE_KEEPBAR 0
#endif
constexpr int CW_PAN = 122880;
constexpr int CW_MH = 49152;
constexpr int CW_AQ = 20480;

__device__ __forceinline__ unsigned cvtpk(float lo, float hi) { f32x2 v = {lo, hi}; bf16x2_t b = __builtin_convertvector(v, bf16x2_t); return __builtin_bit_cast(unsigned, b); }
__device__ __forceinline__ float bflo(unsigned w) { return __uint_as_float(w << 16); }
__device__ __forceinline__ float bfhi(unsigned w) { return __uint_as_float(w & 0xffff0000u); }
__device__ __forceinline__ float sigmoidf_(float x) { return __builtin_amdgcn_rcpf(1.f + __expf(-x)); }
#define DPP_ADD(v, ctrl) ((v) + __builtin_bit_cast(float, __builtin_amdgcn_update_dpp(0, __builtin_bit_cast(int, (v)), (ctrl), 0xF, 0xF, true)))
__device__ __forceinline__ float red16(float v) {
    v = DPP_ADD(v, 0xB1); v = DPP_ADD(v, 0x4E); v = DPP_ADD(v, 0x141); v = DPP_ADD(v, 0x140); return v;
}
__device__ __forceinline__ float wave_sum(float v) { v = red16(v); v += __shfl_xor(v, 16); v += __shfl_xor(v, 32); return v; }

__device__ __forceinline__ void wait_count(const unsigned* p, unsigned need, unsigned* tmo) {
    unsigned v, sp = 0;
    for (;;) {
        asm volatile("s_load_dword %0, %1, 0x0 glc\n\ts_waitcnt lgkmcnt(0)" : "=s"(v) : "s"(p) : "memory");
        if (v >= need) break;
        if (++sp > 4000000u) { if ((threadIdx.x & 63) == 0) __hip_atomic_store(tmo, 1u, __ATOMIC_RELAXED, __HIP_MEMORY_SCOPE_AGENT); break; }
        __builtin_amdgcn_s_sleep(2); }
}
namespace pg8 {
constexpr int BM = 256, BK = 64, HALF = 128, HTB = HALF * BK * 2, STAGE_BYTES = 8 * HTB, NXCD = 8, WGM = 8;
__device__ __forceinline__ int lds_byte(int r, int c) { const int st = (r >> 4) * 2 + (c >> 5), rr = r & 15, cc = c & 31, ob = rr * 64 + cc * 2; return st * 1024 + (ob ^ (((ob >> 9) & 1) << 5)); }
__device__ __forceinline__ void stage_rc(int b, int& R, int& C) { const int st = b / 1024, sb = b % 1024, swz = sb ^ (((sb >> 9) & 1) << 5); R = (st >> 1) * 16 + swz / 64; C = (st & 1) * 32 + (swz % 64) / 2; }
__device__ __forceinline__ int perm32(int rho) { const int n = rho >> 4, i = rho & 15; return 8 * (i >> 2) + 4 * n + (i & 3); }
struct Unit { int pm, pn; };

struct OrderBase {
    int nM, nN, nwg, G, c;
    __device__ __forceinline__ void init(int nM_, int nN_, int G_, int c_) { nM = nM_; nN = nN_; nwg = nM * nN; G = G_; c = c_; }
    __device__ __forceinline__ bool next(int i, Unit& u) const {
        const long L = (long)i * G + c; if (L >= nwg) return false;
        int wgid = (int)L; { const int q = nwg / NXCD, r = nwg % NXCD, xcd = wgid % NXCD, off = wgid / NXCD; wgid = (xcd < r ? xcd * (q + 1) : r * (q + 1) + (xcd - r) * q) + off; }
        const int nig = WGM * nN, gid = wgid / nig, fm = gid * WGM, gsz = (nM - fm) < WGM ? (nM - fm) : WGM;
        u.pm = fm + ((wgid % nig) % gsz); u.pn = (wgid % nig) / gsz; return true;
    }
    __device__ __forceinline__ void a_ready(const Unit&) const {}
};
struct DenseOrder : OrderBase {
    const char* Bt; int Kb;
    __device__ __forceinline__ unsigned arow(const Unit& u, int r) const { return (unsigned)(u.pm * BM + r); }
    __device__ __forceinline__ const char* bptr(const Unit& u) const { return Bt + (size_t)u.pn * BM * Kb; }
};
struct XDenseOrder {
    const char* Bt; int Kb; int nN, p0, pc, rank, nloc;
    const unsigned* pcnt = nullptr; unsigned need = 0; unsigned* tmo = nullptr;
    __device__ __forceinline__ void init_xcd(int nM, int nN_, int Gt, volatile LAS unsigned* st) {
        const unsigned P = st[3], n = st[4]; nN = nN_;
        p0 = (int)((unsigned)nM * P / (unsigned)Gt); pc = (int)((unsigned)nM * (P + n) / (unsigned)Gt) - p0; rank = (int)st[2]; nloc = (int)n;
    }
    __device__ __forceinline__ bool next(int i, Unit& u) const {
        const int j = rank + nloc * i; if (j >= pc * nN) return false;
        const int nig = 8 * nN, fm = (j / nig) * 8, gsz = (pc - fm) < 8 ? (pc - fm) : 8, jj = j % nig;
        u.pm = p0 + fm + jj % gsz; u.pn = jj / gsz; return true;
    }
    __device__ __forceinline__ unsigned arow(const Unit& u, int r) const { return (unsigned)(u.pm * BM + r); }
    __device__ __forceinline__ const char* bptr(const Unit& u) const { return Bt + (size_t)u.pn * BM * Kb; }
    __device__ __forceinline__ void a_ready(const Unit& u) const { if (pcnt) wait_count(pcnt + 16 * u.pm, need, tmo); }
};
struct MoeOrder {
    const LAS int* tab; const GAS int* list; const char* wbase; size_t wstride; int Kb; int gather;
    int t0, tcnt, rank, nloc;
    __device__ __forceinline__ void init_xcd(int T, int Gt, volatile LAS unsigned* st) {
        const unsigned P = st[3], n = st[4];
        t0 = (int)((unsigned)T * P / (unsigned)Gt); tcnt = (int)((unsigned)T * (P + n) / (unsigned)Gt) - t0; rank = (int)st[2]; nloc = (int)n;
    }
    __device__ __forceinline__ bool next(int i, Unit& u) const {
        const int j = rank + nloc * i; if (j >= tcnt * 4) return false;
        const int fm = (j >> 5) * 8, gsz = (tcnt - fm) < 8 ? (tcnt - fm) : 8;
        u.pm = t0 + fm + (j & 31) % gsz; u.pn = (j & 31) / gsz; return true;
    }
    const unsigned* hcnt = nullptr; unsigned* tmo = nullptr;
    __device__ __forceinline__ void a_ready(const Unit& u) const {
        if (!hcnt) return;
        const unsigned* p = hcnt + 64 * u.pm; unsigned v, sp = 0;
        for (;;) {
            asm volatile("s_load_dword %0, %1, 0x0 glc\n\ts_waitcnt lgkmcnt(0)" : "=s"(v) : "s"(p) : "memory");
            if (v >= 32u) break;
            if (++sp > 4000000u) { if ((threadIdx.x & 63) == 0) __hip_atomic_store(tmo, 1u, __ATOMIC_RELAXED, __HIP_MEMORY_SCOPE_AGENT); break; }
            __builtin_amdgcn_s_sleep(2); }
    }
    __device__ __forceinline__ unsigned arow(const Unit& u, int r) const {
        if (!gather) return (unsigned)(u.pm * BM + r);
        const int e = tab[128 + u.pm]; const int pos = (u.pm - tab[e]) * BM + r;
        return pos < tab[64 + e] ? (unsigned)(list[e * LISTCAP + pos] >> 1) : 0u;
    }
    __device__ __forceinline__ const char* bptr(const Unit& u) const { const int e = tab[128 + u.pm]; return wbase + (size_t)e * wstride + (size_t)u.pn * BM * Kb; }
};

struct EpiProj {
    static constexpr bool PERM = true;
    bf16_t* O; int ldc; unsigned* pcnt;
    __device__ __forceinline__ void publish(int pm) const { if ((threadIdx.x & 63) == 0) __hip_atomic_fetch_add(pcnt + 16 * pm, 1u, __ATOMIC_RELAXED, __HIP_MEMORY_SCOPE_AGENT); }
    __device__ __forceinline__ void operator()(const f32x4 (&acc)[2][2][4][2], const Unit& u, int wr, int wc, int fr, int fq) const {
        const int row0 = u.pm * BM + wr * 64 + fr, col0 = u.pn * BM + wc * 32 + 8 * fq;
#pragma unroll
        for (int ai = 0; ai < 2; ++ai)
#pragma unroll
            for (int m = 0; m < 4; ++m) { bf16_t* rowp = O + (size_t)(row0 + ai * HALF + m * 16) * ldc + col0;
#pragma unroll
                for (int bj = 0; bj < 2; ++bj) { const f32x4 v0 = acc[ai][bj][m][0], v1 = acc[ai][bj][m][1];
                    u32x4 w; w.x = cvtpk(v0[0], v0[1]); w.y = cvtpk(v0[2], v0[3]); w.z = cvtpk(v1[0], v1[1]); w.w = cvtpk(v1[2], v1[3]);
                    *(GAS u32x4*)(rowp + bj * HALF) = w; } }
    }
};
struct EpiRes {
    static constexpr bool PERM = false;
    const bf16_t* base; float* out; int dry; unsigned* pcnt;
    __device__ __forceinline__ void publish(int pm) const { if ((threadIdx.x & 63) == 0) __hip_atomic_fetch_add(pcnt + 16 * pm, 1u, __ATOMIC_RELAXED, __HIP_MEMORY_SCOPE_AGENT); }
    __device__ __forceinline__ void operator()(const f32x4 (&acc)[2][2][4][2], const Unit& u, int wr, int wc, int fr, int fq) const {
        const int row0 = u.pm * BM + wr * 64 + fr, col0 = u.pn * BM + wc * 32 + 4 * fq;
#pragma unroll
        for (int ai = 0; ai < 2; ++ai)
#pragma unroll
            for (int m = 0; m < 4; ++m) { const size_t off = (size_t)(row0 + ai * HALF + m * 16) * DM + col0;
#pragma unroll
                for (int bj = 0; bj < 2; ++bj)
#pragma unroll
                    for (int n = 0; n < 2; ++n) { const u32x2 bw = *(const GAS u32x2*)(base + off + bj * HALF + n * 16);
                        const f32x4 bs = {__uint_as_float(bw.x << 16), __uint_as_float(bw.x & 0xffff0000u), __uint_as_float(bw.y << 16), __uint_as_float(bw.y & 0xffff0000u)};
                        if (!dry) *(GAS f32x4*)(out + off + bj * HALF + n * 16) = bs * ALPHA + acc[ai][bj][m][n]; }
                asm volatile("" ::: "memory"); }
    }
};
struct EpiMoe1 {
    static constexpr bool PERM = true;
    bf16_t* H; unsigned* hcnt;
    __device__ __forceinline__ void operator()(const f32x4 (&acc)[2][2][4][2], const Unit& u, int wr, int wc, int fr, int fq) const {
        const int row0 = u.pm * BM + wr * 64 + fr, col0 = u.pn * HALF + wc * 32 + 8 * fq;
#pragma unroll
        for (int ai = 0; ai < 2; ++ai)
#pragma unroll
            for (int m = 0; m < 4; ++m) { bf16_t* rowp = H + (size_t)(row0 + ai * HALF + m * 16) * EH + col0;
                float h[8];
#pragma unroll
                for (int n = 0; n < 2; ++n)
#pragma unroll
                    for (int j = 0; j < 4; ++j) { const float g = acc[ai][0][m][n][j], up = acc[ai][1][m][n][j]; h[n * 4 + j] = g * __builtin_amdgcn_rcpf(1.f + __expf(-g)) * up; }
                u32x4 w; w.x = cvtpk(h[0], h[1]); w.y = cvtpk(h[2], h[3]); w.z = cvtpk(h[4], h[5]); w.w = cvtpk(h[6], h[7]);
                *(GAS u32x4*)rowp = w; }
    }
    __device__ __forceinline__ void publish(int pm) const { if (hcnt && (threadIdx.x & 63) == 0) __hip_atomic_fetch_add(hcnt + 64 * pm, 1u, __ATOMIC_RELAXED, __HIP_MEMORY_SCOPE_AGENT); }
};
struct EpiMoe2 {
    __device__ __forceinline__ void publish(int) const {}
    static constexpr bool PERM = true;
    bf16_t* Y; const LAS int* tab; const GAS int* list; const GAS float* glist;
    __device__ __forceinline__ void operator()(const f32x4 (&acc)[2][2][4][2], const Unit& u, int wr, int wc, int fr, int fq) const {
        const int e = tab[128 + u.pm], pos0 = (u.pm - tab[e]) * BM + wr * 64 + fr, cnt = tab[64 + e], col0 = u.pn * BM + wc * 32 + 8 * fq;
        int pr[8]; float gv[8];
#pragma unroll
        for (int i = 0; i < 8; ++i) { const int pos = pos0 + (i >> 2) * HALF + (i & 3) * 16, pc = pos < cnt ? pos : cnt - 1;
            pr[i] = list[e * LISTCAP + pc]; gv[i] = glist[e * LISTCAP + pc]; }
#pragma unroll
        for (int ai = 0; ai < 2; ++ai)
#pragma unroll
            for (int m = 0; m < 4; ++m) { const int pos = pos0 + ai * HALF + m * 16;
                if (pos < cnt) { const float gt = gv[ai * 4 + m]; bf16_t* rowp = Y + (size_t)pr[ai * 4 + m] * DM + col0;
#pragma unroll
                    for (int bj = 0; bj < 2; ++bj) { const f32x4 v0 = acc[ai][bj][m][0] * gt, v1 = acc[ai][bj][m][1] * gt;
                        u32x4 w; w.x = cvtpk(v0[0], v0[1]); w.y = cvtpk(v0[2], v0[3]); w.z = cvtpk(v1[0], v1[1]); w.w = cvtpk(v1[2], v1[3]);
                        *(GAS u32x4*)(rowp + bj * HALF) = w; } } }
    }
};

template <class Epi, class Sched>
__device__ __forceinline__ void gemm_phase(LAS unsigned char* lds, const char* A, const int K, const Sched& S, const Epi& E) {
    int tid_ = threadIdx.x; asm volatile("" : "+v"(tid_)); const int tid = tid_, wid = __builtin_amdgcn_readfirstlane(tid >> 6), lane = tid & 63, wr = wid >> 2, wc = wid & 3, fr = lane & 15, fq = lane >> 4;
    const int nt = K / BK; const unsigned Kb = (unsigned)K * 2u;
    int Rr[2]; unsigned Cb[2], voffB[2];
#pragma unroll
    for (int i = 0; i < 2; ++i) { int R, C; stage_rc(tid * 16 + i * 8192, R, C); const int Rb = Epi::PERM ? ((R & ~31) + perm32(R & 31)) : R;
        Rr[i] = R; Cb[i] = (unsigned)C * 2u; voffB[i] = (unsigned)(Rb * K + C) * 2u; }
    const size_t kstep = (size_t)(BK * 2);
    const size_t hstep = (size_t)HALF * K * 2;
    const unsigned ldsw = (unsigned)wid * 1024u;
    const int aoff = lds_byte(wr * 64 + fr, fq * 8), boff = lds_byte(wc * 32 + fr, fq * 8);
#define PG8_SA(b, h) (((b) * 2 + (h)) * HTB)
#define PG8_SB(b, h) ((4 + (b) * 2 + (h)) * HTB)
#define PG8_STAGE(bufoff, gbase, voff) do { _Pragma("unroll") for (int _i = 0; _i < 2; ++_i) \
        __builtin_amdgcn_global_load_lds((const unsigned*)((const char*)(gbase) + (voff)[_i]), (LAS unsigned*)(lds + (bufoff) + ldsw + _i * 8192), 16, 0, 0); } while (0)
#define PG8_STAGEA(bufoff, arr, h, kb) do { _Pragma("unroll") for (int _i = 0; _i < 2; ++_i) \
        __builtin_amdgcn_global_load_lds((const unsigned*)((A + (size_t)(kb)) + (arr)[h][_i]), (LAS unsigned*)(lds + (bufoff) + ldsw + _i * 8192), 16, 0, 0); } while (0)
#define PG8_SETA(arr, u) do { _Pragma("unroll") for (int _h = 0; _h < 2; ++_h) _Pragma("unroll") for (int _i = 0; _i < 2; ++_i) (arr)[_h][_i] = S.arow((u), _h * HALF + Rr[_i]) * Kb + Cb[_i]; } while (0)
#define PG8_LDA(dst, b, h) do { _Pragma("unroll") for (int m = 0; m < 4; ++m) _Pragma("unroll") for (int k = 0; k < 2; ++k) dst[m][k] = *(const LAS bf16x8*)(lds + PG8_SA(b, h) + aoff + m * 2048 + k * 1024); } while (0)
#define PG8_LDB(dst, b, h) do { _Pragma("unroll") for (int n = 0; n < 2; ++n) _Pragma("unroll") for (int k = 0; k < 2; ++k) dst[n][k] = *(const LAS bf16x8*)(lds + PG8_SB(b, h) + boff + n * 2048 + k * 1024); } while (0)
#define PG8_MMA(ai, bj, At, Bt) do { __builtin_amdgcn_s_setprio(1); _Pragma("unroll") for (int m = 0; m < 4; ++m) _Pragma("unroll") for (int n = 0; n < 2; ++n) _Pragma("unroll") for (int k = 0; k < 2; ++k) \
        acc[ai][bj][m][n] = __builtin_amdgcn_mfma_f32_16x16x32_bf16(Bt[n][k], At[m][k], acc[ai][bj][m][n], 0, 0, 0); __builtin_amdgcn_s_setprio(0); } while (0)
#define PG8_WAIT_V(n) asm volatile("s_waitcnt vmcnt(" #n ")" ::: "memory")
#define PG8_WAIT_L(n) asm volatile("s_waitcnt lgkmcnt(" #n ")" ::: "memory")
#define PG8_BAR __builtin_amdgcn_s_barrier()
#define PG8_SCHED __builtin_amdgcn_sched_barrier(0)
    Unit cur, nxt; int ui = 0;
    if (!S.next(0, cur)) return;
    f32x4 acc[2][2][4][2];
#pragma unroll
    for (int a = 0; a < 2; ++a)
#pragma unroll
        for (int b = 0; b < 2; ++b)
#pragma unroll
            for (int m = 0; m < 4; ++m)
#pragma unroll
                for (int n = 0; n < 2; ++n) acc[a][b][m][n] = (f32x4){0.f, 0.f, 0.f, 0.f};
    bf16x8 At[4][2], B0[2][2], B1[2][2];
    unsigned ac[2][2], an[2][2];
    int ppm = -1;
    S.a_ready(cur);
    PG8_SETA(ac, cur);
    const char* cB = S.bptr(cur);
    PG8_STAGE(PG8_SB(0, 0), cB, voffB); PG8_STAGE(PG8_SB(0, 1), cB + hstep, voffB); PG8_STAGEA(PG8_SA(0, 0), ac, 0, 0); PG8_STAGEA(PG8_SA(0, 1), ac, 1, 0);
    if (wr == 1) PG8_BAR;
    PG8_WAIT_V(2); PG8_BAR;
    PG8_STAGE(PG8_SB(1, 0), cB + kstep, voffB); PG8_STAGEA(PG8_SA(1, 0), ac, 0, kstep); PG8_STAGE(PG8_SB(1, 1), cB + hstep + kstep, voffB);
    PG8_WAIT_V(6); PG8_BAR;
    for (;;) {
        const bool has_next = S.next(ui + 1, nxt);
        const char* nB = cB;
        if (has_next) { PG8_SETA(an, nxt); nB = S.bptr(nxt); }
        else {
#pragma unroll
            for (int h = 0; h < 2; ++h)
#pragma unroll
                for (int i = 0; i < 2; ++i) an[h][i] = ac[h][i]; }
        for (int t = 0; t < nt; t += 2) {
            const bool last = (t == nt - 2);
            if (last && has_next) S.a_ready(nxt);
            const size_t k1 = (size_t)(t + 1) * kstep;
            const size_t k2 = last ? 0 : (size_t)(t + 2) * kstep, k3 = k2 + kstep;
            const char* b2 = last ? nB : cB + (size_t)(t + 2) * kstep; const char* b3 = b2 + kstep;
            unsigned a2[2][2];
#pragma unroll
            for (int h = 0; h < 2; ++h)
#pragma unroll
                for (int i = 0; i < 2; ++i) a2[h][i] = last ? an[h][i] : ac[h][i];
            PG8_LDB(B0, 0, 0); PG8_LDB(B1, 0, 1); PG8_SCHED; PG8_LDA(At, 0, 0); PG8_STAGEA(PG8_SA(1, 1), ac, 1, k1);
            PG8_WAIT_V(8); PG8_WAIT_L(0); PG8_BAR; PG8_MMA(0, 0, At, B0); PG8_MMA(0, 1, At, B1); PG8_BAR; PG8_SCHED;
            PG8_LDA(At, 0, 1); PG8_STAGE(PG8_SB(0, 0), b2, voffB); PG8_STAGE(PG8_SB(0, 1), b2 + hstep, voffB); PG8_STAGEA(PG8_SA(0, 0), a2, 0, k2);
            PG8_WAIT_V(8); PG8_WAIT_L(0); PG8_BAR; PG8_MMA(1, 0, At, B0); PG8_MMA(1, 1, At, B1); PG8_BAR; PG8_SCHED;
            PG8_LDB(B0, 1, 0); PG8_LDB(B1, 1, 1); PG8_SCHED; PG8_LDA(At, 1, 0); PG8_STAGEA(PG8_SA(0, 1), a2, 1, k2);
            PG8_WAIT_V(8); PG8_WAIT_L(0); PG8_BAR; PG8_MMA(0, 0, At, B0); PG8_MMA(0, 1, At, B1); PG8_BAR; PG8_SCHED;
            PG8_LDA(At, 1, 1); PG8_STAGE(PG8_SB(1, 0), b3, voffB); PG8_STAGE(PG8_SB(1, 1), b3 + hstep, voffB); PG8_STAGEA(PG8_SA(1, 0), a2, 0, k3);
            PG8_WAIT_V(8); PG8_WAIT_L(0); PG8_BAR; PG8_MMA(1, 0, At, B0); PG8_MMA(1, 1, At, B1); PG8_BAR; PG8_SCHED;
        }
        if (wr == 0) PG8_BAR;
        E(acc, cur, wr, wc, fr, fq);
        if (ppm >= 0) E.publish(ppm);
        ppm = cur.pm;
        if (!has_next) break;
#pragma unroll
        for (int a = 0; a < 2; ++a)
#pragma unroll
            for (int b = 0; b < 2; ++b)
#pragma unroll
                for (int m = 0; m < 4; ++m)
#pragma unroll
                    for (int n = 0; n < 2; ++n) acc[a][b][m][n] = (f32x4){0.f, 0.f, 0.f, 0.f};
        cur = nxt; cB = nB; ++ui;
#pragma unroll
        for (int h = 0; h < 2; ++h)
#pragma unroll
            for (int i = 0; i < 2; ++i) ac[h][i] = an[h][i];
        if (wr == 1) PG8_BAR;
    }
    PG8_WAIT_V(0);
    if (ppm >= 0) E.publish(ppm);
    PG8_BAR;
#undef PG8_SA
#undef PG8_SB
#undef PG8_STAGE
#undef PG8_STAGEA
#undef PG8_SETA
#undef PG8_LDA
#undef PG8_LDB
#undef PG8_MMA
#undef PG8_WAIT_V
#undef PG8_WAIT_L
#undef PG8_BAR
#undef PG8_SCHED
}
}

namespace attn_body {
using bf16 = __hip_bfloat16;
using bf16x8 = __attribute__((ext_vector_type(8))) short;
using s16x4 = __attribute__((ext_vector_type(4))) short;
using f32x16 = __attribute__((ext_vector_type(16))) float;
using u32x4 = __attribute__((ext_vector_type(4))) unsigned;
constexpr int D = 64, QP = INP, KP = INP, VP = INP, OP = DM;
constexpr int NW = 8, QBLK = 32, QB = QBLK * NW, KVBLK = 64;
__device__ __forceinline__ int crow(int r, int hi) { return (r & 3) + 8 * (r >> 2) + 4 * hi; }
#define SBAR() __builtin_amdgcn_sched_barrier(0)
constexpr int NSLOT = 3, SLOTB = 8192;
constexpr int LDS_K = 0, LDS_V = NSLOT * SLOTB, LDS_WS = 2 * NSLOT * SLOTB, LDS_OST = LDS_WS + NW * 64 * 4, LDS_BYTES_A = LDS_OST + NW * 4096;
__device__ __forceinline__ void glds16(const void* gsrc, unsigned lds_dst) { unsigned keep;
  asm volatile("s_mov_b32 %0, m0\n\ts_mov_b32 m0, %2\n\ts_nop 0\n\tglobal_load_lds_dwordx4 %1, off\n\ts_mov_b32 m0, %0" : "=&s"(keep) : "v"(gsrc), "s"(lds_dst) : "memory"); }
__device__ __forceinline__ float max3f(float a, float b, float c) { float r; asm("v_max3_f32 %0, %1, %2, %3" : "=v"(r) : "v"(a), "v"(b), "v"(c)); return r; }
__device__ __forceinline__ float max2f(float a, float b) { float r; asm("v_max_f32_e32 %0, %1, %2" : "=v"(r) : "v"(a), "v"(b)); return r; }
__device__ __forceinline__ float fadd_s(float a, float b) { float r; asm("v_add_f32_e32 %0, %1, %2" : "=v"(r) : "v"(a), "v"(b)); return r; }
__device__ __forceinline__ float fsub_s(float a, float b) { float r; asm("v_sub_f32_e32 %0, %1, %2" : "=v"(r) : "v"(a), "v"(b)); return r; }
typedef float f32x2_t __attribute__((ext_vector_type(2)));
__device__ __forceinline__ unsigned cvtpk_s(float lo, float hi) { f32x2_t v = {lo, hi}; bf16x2_t b = __builtin_convertvector(v, bf16x2_t); return __builtin_bit_cast(unsigned, b); }
#define WAIT_BAR(N) asm volatile("s_waitcnt vmcnt(" #N ") lgkmcnt(0)\n\ts_barrier" ::: "memory")
__device__ __forceinline__ void qkt(f32x16& p0, f32x16& p1, const char* Kslot, const bf16x8* qr, const f32x16& negm, int r32, int hi) {
  const char* kb = Kslot + hi * 1024 + r32 * 16;
  #pragma unroll
  for (int d0 = 0; d0 < 4; ++d0) {
    const bf16x8 b0 = *reinterpret_cast<const bf16x8*>(kb + d0 * 2048);
    const bf16x8 b1 = *reinterpret_cast<const bf16x8*>(kb + d0 * 2048 + 512);
    if (d0 == 0) { p0 = __builtin_amdgcn_mfma_f32_32x32x16_bf16(b0, qr[0], negm, 0, 0, 0); p1 = __builtin_amdgcn_mfma_f32_32x32x16_bf16(b1, qr[0], negm, 0, 0, 0); }
    else { p0 = __builtin_amdgcn_mfma_f32_32x32x16_bf16(b0, qr[d0], p0, 0, 0, 0); p1 = __builtin_amdgcn_mfma_f32_32x32x16_bf16(b1, qr[d0], p1, 0, 0, 0); } }
}
typedef __attribute__((address_space(3))) const char* lds_cptr;
typedef short v4i16_t __attribute__((ext_vector_type(4)));
__device__ __forceinline__ void kload8(bf16x8* kf, lds_cptr kp) {
  kf[0] = *(const __attribute__((address_space(3))) bf16x8*)(kp);        kf[1] = *(const __attribute__((address_space(3))) bf16x8*)(kp + 512);
  kf[2] = *(const __attribute__((address_space(3))) bf16x8*)(kp + 2048); kf[3] = *(const __attribute__((address_space(3))) bf16x8*)(kp + 2560);
  kf[4] = *(const __attribute__((address_space(3))) bf16x8*)(kp + 4096); kf[5] = *(const __attribute__((address_space(3))) bf16x8*)(kp + 4608);
  kf[6] = *(const __attribute__((address_space(3))) bf16x8*)(kp + 6144); kf[7] = *(const __attribute__((address_space(3))) bf16x8*)(kp + 6656);
}
__device__ __forceinline__ void kload2(bf16x8* kf, lds_cptr kp, int j) { kf[2 * j] = *(const __attribute__((address_space(3))) bf16x8*)(kp + j * 2048); kf[2 * j + 1] = *(const __attribute__((address_space(3))) bf16x8*)(kp + j * 2048 + 512); }
__device__ __forceinline__ s16x4 vtr(lds_cptr p) { return __builtin_bit_cast(s16x4, __builtin_amdgcn_ds_read_tr16_b64_v4i16((__attribute__((address_space(3))) v4i16_t*)p)); }
__device__ __forceinline__ float rowmax(const f32x16& p0, const f32x16& p1) {
  float a = max3f(p0[0], p0[1], p1[0]), b = max3f(p0[2], p0[3], p1[1]); a = max3f(a, p1[2], p1[3]);
  #pragma unroll
  for (int r = 4; r < 16; r += 4) { a = max3f(a, p0[r], p0[r + 1]); b = max3f(b, p0[r + 2], p0[r + 3]); a = max3f(a, p1[r], p1[r + 1]); b = max3f(b, p1[r + 2], p1[r + 3]); }
  const float m = max2f(a, b);
  auto rr = __builtin_amdgcn_permlane32_swap(__float_as_uint(m), __float_as_uint(m), false, false);
  return max2f(__uint_as_float(rr[0]), __uint_as_float(rr[1]));
}
__device__ __forceinline__ void pv(f32x16* o, int vb, bf16x8 pa0, bf16x8 pa1, bf16x8 pa2, bf16x8 pa3) {
  #pragma unroll
  for (int d0 = 0; d0 < 2; ++d0) { s16x4 lo[4], hi[4];
    #pragma unroll
    for (int ks = 0; ks < 4; ++ks) {
      asm volatile("ds_read_b64_tr_b16 %0,%1 offset:%c2" : "=&v"(lo[ks]) : "v"(vb), "i"(d0 * 4096 + ks * 1024) : "memory");
      asm volatile("ds_read_b64_tr_b16 %0,%1 offset:%c2" : "=&v"(hi[ks]) : "v"(vb), "i"(d0 * 4096 + ks * 1024 + 512) : "memory"); }
    asm volatile("s_waitcnt lgkmcnt(0)" ::: "memory"); SBAR();
    #define PK(k) (bf16x8){lo[k][0], lo[k][1], lo[k][2], lo[k][3], hi[k][0], hi[k][1], hi[k][2], hi[k][3]}
    o[d0] = __builtin_amdgcn_mfma_f32_32x32x16_bf16(pa0, PK(0), o[d0], 0, 0, 0);
    o[d0] = __builtin_amdgcn_mfma_f32_32x32x16_bf16(pa1, PK(1), o[d0], 0, 0, 0);
    o[d0] = __builtin_amdgcn_mfma_f32_32x32x16_bf16(pa2, PK(2), o[d0], 0, 0, 0);
    o[d0] = __builtin_amdgcn_mfma_f32_32x32x16_bf16(pa3, PK(3), o[d0], 0, 0, 0);
    #undef PK
  }
}
#define ATTN_STORE16(p, v) (*(GAS u32x4*)(p) = (v))
template <int THRL> __device__ __forceinline__ void attn_unit(int b, int h, int kvh, int qb, const bf16* Q, const bf16* __restrict__ K, const bf16* __restrict__ V, bf16* O, char* shm) {
  int tid_ = threadIdx.x; asm volatile("" : "+v"(tid_)); const int tid = tid_, lane = tid & 63, r32 = lane & 31, hi = lane >> 5; const int wid = __builtin_amdgcn_readfirstlane(tid >> 6);
  const long rowbase = (long)b * SEQ; const int q0 = qb * QB;
  const bf16* Qw = Q + (rowbase + q0 + wid * QBLK) * QP + h * D;
  const bf16* Kh = K + rowbase * KP + kvh * D, *Vh = V + rowbase * VP + kvh * D;
  const unsigned lds0 = (unsigned)(uintptr_t)shm;
  float* wsf = (float*)(shm + LDS_WS) + wid * 64;
  const bf16* ksrc = Kh + (long)lane * KP + wid * 8;
  const bf16* vsrc = Vh + (long)(16 * (wid & 3) + (lane >> 2)) * VP + (wid >> 2) * 32 + (lane & 3) * 8;
  const unsigned kdst = lds0 + LDS_K + wid * 1024, vdst = lds0 + LDS_V + wid * 1024;
  #define DMA_K(t, slot) glds16(ksrc + (long)(t) * KVBLK * KP, (unsigned)__builtin_amdgcn_readfirstlane(kdst + (slot)))
  #define DMA_V(t, slot) glds16(vsrc + (long)(t) * KVBLK * VP, (unsigned)__builtin_amdgcn_readfirstlane(vdst + (slot)))
  const int vb0 = (int)(lds0 + LDS_V) + ((lane >> 4) & 1) * 32 + (lane & 3) * 8 + (4 * hi + ((lane & 15) >> 2)) * 64;
  const char* Kbase = shm + LDS_K; bf16x8 kf[8];
  const lds_cptr shm3 = (lds_cptr)shm; const lds_cptr kp0 = shm3 + LDS_K + hi * 1024 + r32 * 16; const lds_cptr vp0 = shm3 + LDS_V + ((lane >> 4) & 1) * 32 + (lane & 3) * 8 + (4 * hi + ((lane & 15) >> 2)) * 64;
  constexpr int NT = SEQ / KVBLK;
  DMA_K(0, 0); DMA_V(0, 0); DMA_K(1, SLOTB);
  bf16x8 qr[4];
  #pragma unroll
  for (int d0 = 0; d0 < 4; ++d0) qr[d0] = *(const GAS bf16x8*)(&Qw[(long)r32 * QP + d0 * 16 + hi * 8]);
  float mhat = 0.f, l_reg = 0.f; f32x16 o[2]; o[0] = f32x16{}; o[1] = f32x16{}; f32x16 negm = f32x16{}; asm volatile("" : "+v"(negm));
  bool resc = false;
  #define START(P0, P1) do { const float rm = rowmax(P0, P1); resc = false; \
    { const float dl = rm; mhat = fadd_s(mhat, dl); \
      _Pragma("unroll") for (int r = 0; r < 16; ++r) { P0[r] = fsub_s(P0[r], dl); P1[r] = fsub_s(P1[r], dl); } \
      _Pragma("unroll") for (int r = 0; r < 16; ++r) negm[r] = -mhat; asm volatile("" : "+v"(negm)); } \
    _Pragma("unroll") for (int r = 0; r < 16; ++r) P0[r] = __builtin_amdgcn_exp2f(P0[r]); } while (0)
  #define RESC() do { if (resc) { asm volatile("s_waitcnt lgkmcnt(0)" ::: "memory"); \
      _Pragma("unroll") for (int d_ = 0; d_ < 2; ++d_) _Pragma("unroll") for (int r = 0; r < 16; ++r) o[d_][r] *= wsf[crow(r, hi)]; } } while (0)
  f32x16 pA0 = {}, pA1 = {}, pB0 = {}, pB1 = {};
  int sl_prev = 0, sl_cur = 0, sl_next = SLOTB;
  #define ROT() do { sl_prev = sl_cur; sl_cur = sl_next; sl_next = (sl_next == (NSLOT - 1) * SLOTB) ? 0 : sl_next + SLOTB; } while (0)
  DMA_K(2, 2 * SLOTB);
  WAIT_BAR(3);
  qkt(pA0, pA1, Kbase, qr, negm, r32, hi); asm volatile("s_nop 15\n\ts_nop 7" : "+v"(pA0), "+v"(pA1));
  START(pA0, pA1);
  _Pragma("unroll") for (int r = 0; r < 16; ++r) pA1[r] = __builtin_amdgcn_exp2f(pA1[r]);
  WAIT_BAR(0);
  DMA_K(3, 0); DMA_V(1, SLOTB);
  ROT();
  kload8(kf, kp0 + sl_cur);
  WAIT_BAR(2);
  s16x4 vlo[8] = {}, vhi[8] = {}; u32x4 pw0 = {}, pw1 = {}, pw2 = {}, pw3 = {};
  #define PKW(P, B) cvtpk_s(P[B], P[B + 1])
  #define PAF(k) __builtin_bit_cast(bf16x8, pw##k)
  #define VFR(i) (bf16x8){vlo[i][0], vlo[i][1], vlo[i][2], vlo[i][3], vhi[i][0], vhi[i][1], vhi[i][2], vhi[i][3]}
  #define PIN(x) asm volatile("" : "+v"(x))
  #define MX3(a, b, c) __builtin_fmaxf(__builtin_fmaxf((a), (b)), (c))
  #define GAPA(MF, A0, A1, A2, A3, W0, W1, PW) do { MF; sacc += A0; sacc += A1; sacc += A2; sacc += A3; PIN(sacc); W0; W1; PIN(PW); SBAR(); } while (0)
  #define EX(v) __builtin_amdgcn_exp2f(v)
  #define GAPB(MF, X, B) do { MF; X[B] = EX(X[B]); X[B + 1] = EX(X[B + 1]); X[B + 2] = EX(X[B + 2]); X[B + 3] = EX(X[B + 3]); PIN(X); SBAR(); } while (0)
  #define VRD(i) do { vlo[i] = vtr(vp_ + (((i) >> 2) * 4096 + ((i) & 3) * 1024)); vhi[i] = vtr(vp_ + (((i) >> 2) * 4096 + ((i) & 3) * 1024 + 512)); } while (0)
  #define KRD(G, j) do { if (G) { kload2(kf, kp0 + sl_next, j); SBAR(); } } while (0)
  #define STEP(C0, C1, P0, P1, t, GK, GV, GL) do { SBAR(); \
    const lds_cptr vp_ = vp0 + sl_prev; \
    VRD(0); SBAR(); float sacc = (P0[0] + P0[1]); \
    GAPA(C0 = __builtin_amdgcn_mfma_f32_32x32x16_bf16(kf[0], qr[0], negm, 0, 0, 0), P0[2], P0[3], P0[4], P0[5],     pw0[0] = PKW(P0, 0), pw0[1] = PKW(P0, 2), pw0); \
    VRD(4); SBAR(); GAPA(C1 = __builtin_amdgcn_mfma_f32_32x32x16_bf16(kf[1], qr[0], negm, 0, 0, 0), P0[6], P0[7], P0[8], P0[9],     pw0[2] = PKW(P0, 4), pw0[3] = PKW(P0, 6), pw0); \
    VRD(1); SBAR(); GAPA(C0 = __builtin_amdgcn_mfma_f32_32x32x16_bf16(kf[2], qr[1], C0, 0, 0, 0),   P0[10], P0[11], P0[12], P0[13], pw1[0] = PKW(P0, 8), pw1[1] = PKW(P0, 10), pw1); \
    VRD(5); SBAR(); GAPA(C1 = __builtin_amdgcn_mfma_f32_32x32x16_bf16(kf[3], qr[1], C1, 0, 0, 0),   P0[14], P0[15], P1[0], P1[1],   pw1[2] = PKW(P0, 12), pw1[3] = PKW(P0, 14), pw1); \
    VRD(2); SBAR(); GAPA(C0 = __builtin_amdgcn_mfma_f32_32x32x16_bf16(kf[4], qr[2], C0, 0, 0, 0),   P1[2], P1[3], P1[4], P1[5],     pw2[0] = PKW(P1, 0), pw2[1] = PKW(P1, 2), pw2); \
    VRD(6); SBAR(); GAPA(C1 = __builtin_amdgcn_mfma_f32_32x32x16_bf16(kf[5], qr[2], C1, 0, 0, 0),   P1[6], P1[7], P1[8], P1[9],     pw2[2] = PKW(P1, 4), pw2[3] = PKW(P1, 6), pw2); \
    VRD(3); SBAR(); GAPA(C0 = __builtin_amdgcn_mfma_f32_32x32x16_bf16(kf[6], qr[3], C0, 0, 0, 0),   P1[10], P1[11], P1[12], P1[13], pw3[0] = PKW(P1, 8), pw3[1] = PKW(P1, 10), pw3); \
    VRD(7); SBAR(); GAPA(C1 = __builtin_amdgcn_mfma_f32_32x32x16_bf16(kf[7], qr[3], C1, 0, 0, 0),   P1[14], P1[15], 0.f, 0.f,       pw3[2] = PKW(P1, 12), pw3[3] = PKW(P1, 14), pw3); \
    l_reg += sacc; \
    if (GK) { DMA_K((t) + 3, sl_cur); } if (GV) { DMA_V((t) + 1, sl_next); } \
    { float a = MX3(C0[0], C0[1], C1[0]), b = MX3(C0[2], C0[3], C1[1]); a = MX3(a, C1[2], C1[3]); \
      _Pragma("unroll") for (int r = 4; r < 16; r += 4) { a = MX3(a, C0[r], C0[r + 1]); b = MX3(b, C0[r + 2], C0[r + 3]); a = MX3(a, C1[r], C1[r + 1]); b = MX3(b, C1[r + 2], C1[r + 3]); } \
      float rm = __builtin_fmaxf(a, b); { auto rr = __builtin_amdgcn_permlane32_swap(__float_as_uint(rm), __float_as_uint(rm), false, false); rm = __builtin_fmaxf(__uint_as_float(rr[0]), __uint_as_float(rr[1])); } \
      resc = false; \
      if (__builtin_expect(__any(rm > (float)THRL), 0)) { const float dl = __builtin_fmaxf(rm, 0.f); mhat += dl; \
        _Pragma("unroll") for (int r = 0; r < 16; ++r) { C0[r] -= dl; C1[r] -= dl; } \
        _Pragma("unroll") for (int r = 0; r < 16; ++r) negm[r] = -mhat; asm volatile("" : "+v"(negm)); \
        const float f = __builtin_amdgcn_exp2f(-dl); l_reg *= f; if (hi == 0) wsf[r32] = f; resc = true; } } \
    SBAR(); \
    GAPB(o[0] = __builtin_amdgcn_mfma_f32_32x32x16_bf16(PAF(0), VFR(0), o[0], 0, 0, 0), C0, 0); \
    GAPB(o[1] = __builtin_amdgcn_mfma_f32_32x32x16_bf16(PAF(0), VFR(4), o[1], 0, 0, 0), C0, 4); \
    KRD(GL, 0); GAPB(o[0] = __builtin_amdgcn_mfma_f32_32x32x16_bf16(PAF(1), VFR(1), o[0], 0, 0, 0), C0, 8); \
    KRD(GL, 1); GAPB(o[1] = __builtin_amdgcn_mfma_f32_32x32x16_bf16(PAF(1), VFR(5), o[1], 0, 0, 0), C0, 12); \
    KRD(GL, 2); GAPB(o[0] = __builtin_amdgcn_mfma_f32_32x32x16_bf16(PAF(2), VFR(2), o[0], 0, 0, 0), C1, 0); \
    KRD(GL, 3); GAPB(o[1] = __builtin_amdgcn_mfma_f32_32x32x16_bf16(PAF(2), VFR(6), o[1], 0, 0, 0), C1, 4); \
    GAPB(o[0] = __builtin_amdgcn_mfma_f32_32x32x16_bf16(PAF(3), VFR(3), o[0], 0, 0, 0), C1, 8); \
    GAPB(o[1] = __builtin_amdgcn_mfma_f32_32x32x16_bf16(PAF(3), VFR(7), o[1], 0, 0, 0), C1, 12); \
    } while (0)
  int t = 1;
  for (; t + 5 < NT; t += 2) {
    STEP(pB0, pB1, pA0, pA1, t, true, true, true);     WAIT_BAR(2); RESC(); ROT();
    STEP(pA0, pA1, pB0, pB1, t + 1, true, true, true); WAIT_BAR(2); RESC(); ROT();
  }
  #define ENDW(tt) do { if ((tt) + 3 < NT) { WAIT_BAR(2); } else if ((tt) + 2 < NT) { WAIT_BAR(1); } else { WAIT_BAR(0); } } while (0)
  for (; t + 1 < NT; t += 2) {
    STEP(pB0, pB1, pA0, pA1, t, (t + 3 < NT), (t + 1 < NT), (t + 1 < NT));         ENDW(t);     RESC(); ROT();
    STEP(pA0, pA1, pB0, pB1, t + 1, (t + 4 < NT), (t + 2 < NT), (t + 2 < NT));     ENDW(t + 1); RESC(); ROT();
  }
  STEP(pB0, pB1, pA0, pA1, NT - 1, false, false, false); RESC();
  { float sacc = pB0[0] + pB0[1]; _Pragma("unroll") for (int r = 2; r < 16; ++r) sacc += pB0[r]; _Pragma("unroll") for (int r = 0; r < 16; ++r) sacc += pB1[r]; l_reg += sacc;
    pw0 = (u32x4){PKW(pB0, 0), PKW(pB0, 2), PKW(pB0, 4), PKW(pB0, 6)}; pw1 = (u32x4){PKW(pB0, 8), PKW(pB0, 10), PKW(pB0, 12), PKW(pB0, 14)}; pw2 = (u32x4){PKW(pB1, 0), PKW(pB1, 2), PKW(pB1, 4), PKW(pB1, 6)}; pw3 = (u32x4){PKW(pB1, 8), PKW(pB1, 10), PKW(pB1, 12), PKW(pB1, 14)};
    SBAR(); pv(o, vb0 + sl_cur, PAF(0), PAF(1), PAF(2), PAF(3)); }
  #undef PKW
  #undef PAF
  #undef VFR
  #undef PIN
  #undef MX3
  #undef GAPA
  #undef GAPB
  #undef EX
  #undef VRD
  #undef KRD
  #undef STEP
  #undef ENDW
  { auto rr = __builtin_amdgcn_permlane32_swap(__float_as_uint(l_reg), __float_as_uint(l_reg), false, false); l_reg = __uint_as_float(rr[0]) + __uint_as_float(rr[1]); }
  if (hi == 0) wsf[32 + r32] = l_reg; asm volatile("s_waitcnt lgkmcnt(0)" ::: "memory");
  float rli[16];
  #pragma unroll
  for (int r = 0; r < 16; ++r) rli[r] = __builtin_amdgcn_rcpf(wsf[32 + crow(r, hi)]);
  bf16* Ow = O + (rowbase + q0 + wid * QBLK) * OP + h * D;
  { bf16* stg = (bf16*)(shm + LDS_OST) + wid * 2048;
    #pragma unroll
    for (int r = 0; r < 16; ++r) { const int orow = crow(r, hi);
      #pragma unroll
      for (int d0 = 0; d0 < 2; ++d0) stg[orow * 64 + d0 * 32 + r32] = __float2bfloat16(o[d0][r] * rli[r]); }
    asm volatile("s_waitcnt lgkmcnt(0)" ::: "memory");
    #pragma unroll
    for (int i = 0; i < 4; ++i) { const int row = i * 8 + (lane >> 3), ch = lane & 7; const u32x4 v = *(const u32x4*)(stg + row * 64 + ch * 8); ATTN_STORE16(Ow + (long)row * OP + ch * 8, v); } }
  asm volatile("s_waitcnt lgkmcnt(0)\n\ts_barrier" ::: "memory");
  #undef DMA_K
  #undef DMA_V
  #undef START
  #undef RESC
  #undef ROT
}
#undef SBAR
#undef WAIT_BAR
}

typedef GAS unsigned gu32;
#define RLX_AGENT __ATOMIC_RELAXED, __HIP_MEMORY_SCOPE_AGENT
#define XB_TMO      128
#define XB_XCNT(j)  (256  + 64 * (j))
#define XB_XSUB(j)  (1280 + 64 * (j))
#define XB_XGEN(j)  (2304 + 64 * (j))
#define XB_TOP      3328
#define XB_TOPGEN   3392
#define XCD_BAR_WORDS 3456
#define XB_SPIN_CAP (1u << 22)
__device__ __forceinline__ unsigned xb_ld(unsigned* p)              { return __hip_atomic_load(p, __ATOMIC_RELAXED, __HIP_MEMORY_SCOPE_AGENT); }
__device__ __forceinline__ unsigned xb_add(unsigned* p, unsigned v) { return __hip_atomic_fetch_add(p, v, __ATOMIC_RELAXED, __HIP_MEMORY_SCOPE_AGENT); }
__device__ __forceinline__ unsigned xb_xcc_id() { return (unsigned)__builtin_amdgcn_s_getreg((3 << 11) | 20) & 0xFu; }
#define XB_SPIN(cond, bar) do { unsigned _sp = 0; while (cond) { __builtin_amdgcn_s_sleep(1); \
    if ((++_sp & 255u) == 0u) { if (xb_ld(&(bar)[XB_TMO])) break; if (_sp > XB_SPIN_CAP) { atomicAdd(&(bar)[XB_TMO], 1u); break; } } } } while (0)
struct XcdBarrier { unsigned* bar; unsigned x; volatile LAS unsigned* st; };
__device__ __forceinline__ XcdBarrier xcd_barrier_post(unsigned* bar, volatile LAS unsigned* st) {
    XcdBarrier b; b.bar = bar; b.x = xb_xcc_id(); b.st = st;
    if (threadIdx.x == 0) st[2] = xb_add(&bar[XB_XCNT(b.x)], 1u);
    return b;
}
__device__ __forceinline__ void xcd_barrier_complete(unsigned* bar, unsigned x, unsigned& nloc, unsigned& nx) {
    const unsigned G = gridDim.x * gridDim.y * gridDim.z;
    unsigned sum, cnt, mine, sp = 0u;
    for (;;) {
        sum = 0u; cnt = 0u; mine = 0u;
#pragma unroll
        for (unsigned j = 0; j < 16; ++j) { const unsigned c = xb_ld(&bar[XB_XCNT(j)]); sum += c; cnt += (c > 0u) ? 1u : 0u; mine = (j == x) ? c : mine; }
        if (sum == G) break;
        __builtin_amdgcn_s_sleep(1);
        if ((++sp & 255u) == 0u) { if (xb_ld(&bar[XB_TMO])) break; if (sp > XB_SPIN_CAP) { atomicAdd(&bar[XB_TMO], 1u); break; } }
    }
    nloc = mine > 0u ? mine : 1u; nx = cnt > 0u ? cnt : 1u;
}
__device__ __forceinline__ void xcd_barrier(const XcdBarrier& b) {
    asm volatile("s_waitcnt vmcnt(0)" ::: "memory");
    __syncthreads();
    if (threadIdx.x == 0) {
        unsigned* bar = b.bar;
        __builtin_amdgcn_s_waitcnt(0);
        unsigned nloc = b.st[0], nx = b.st[1];
        if (nloc == 0u) { xcd_barrier_complete(bar, b.x, nloc, nx); b.st[0] = nloc; b.st[1] = nx; }
        const unsigned old = xb_add(&bar[XB_XSUB(b.x)], 1u);
        const unsigned gen = old / nloc;
        if (old + 1u == (gen + 1u) * nloc) {
            __builtin_amdgcn_fence(__ATOMIC_RELEASE, "agent");
            asm volatile("s_waitcnt vmcnt(0)" ::: "memory");
            const unsigned og = xb_add(&bar[XB_TOP], 1u);
            const unsigned tg = og / nx;
            if (og + 1u == (tg + 1u) * nx) xb_add(&bar[XB_TOPGEN], 1u);
            else XB_SPIN(xb_ld(&bar[XB_TOPGEN]) == tg, bar);
            __builtin_amdgcn_fence(__ATOMIC_ACQUIRE, "agent");
            xb_add(&bar[XB_XGEN(b.x)], 1u);
            asm volatile("s_waitcnt vmcnt(0)" ::: "memory");
        } else {
            XB_SPIN(xb_ld(&bar[XB_XGEN(b.x)]) == gen, bar);
            __builtin_amdgcn_fence(__ATOMIC_ACQUIRE, "agent");
            asm volatile("s_waitcnt vmcnt(0)" ::: "memory");
        }
    }
    __syncthreads();
}

struct Args { const float* in[30]; float* out; unsigned char* ws; int ph_lo, ph_hi, multi, pad; };
typedef const __attribute__((address_space(4))) unsigned char* kptr_t;
struct PArgs { kptr_t kp; unsigned char* ws_; float* out_;
    __device__ __forceinline__ const float* in(int i) const { return (const float*)(const GAS float*)(*(const float* const __attribute__((address_space(4)))*)(kp + 8 * i)); }
    __device__ __forceinline__ unsigned char* ws() const { return (unsigned char*)(GAS unsigned char*)ws_; }
    __device__ __forceinline__ float* out() const { return (float*)(GAS float*)out_; } };
enum { I_X = 0, I_WIN, I_MUP, I_MUN, I_POOLW, I_POOLS, I_W0, I_WUP, I_A0, I_AUP, I_GUP, I_KK, I_KA, I_RK, I_GNG, I_GNB, I_QN, I_KN, I_WO, I_LN1G, I_LN1B,
       I_RG, I_RGB, I_RE, I_REB, I_EG, I_EU, I_ED, I_LN2G, I_LN2B };
constexpr int LDSCTL_OFF = 163840 - 256;
constexpr int MOE_TAB_OFF = 131072 + 2048;

__device__ __forceinline__ void transpose_item(const float* W, int N, int k0, int n0, bf16_t* WT, int Kout, int row0, LAS float* scr, int lane) {
    float tv[32];
#pragma unroll
    for (int i = 0; i < 32; ++i) { const int kk = 2 * i + (lane >> 5); tv[i] = ((const GAS float*)W)[(size_t)(k0 + kk) * N + n0 + (lane & 31)]; }
#pragma unroll
    for (int i = 0; i < 32; ++i) { const int kk = 2 * i + (lane >> 5); scr[kk * 33 + (lane & 31)] = tv[i]; }
    asm volatile("s_waitcnt lgkmcnt(0)" ::: "memory");
    const int c = lane & 7;
#pragma unroll
    for (int j = 0; j < 4; ++j) { const int n = (lane >> 3) + 8 * j; const LAS float* s = scr + (8 * c) * 33 + n;
        u32x4 o; o.x = cvtpk(s[0 * 33], s[1 * 33]); o.y = cvtpk(s[2 * 33], s[3 * 33]); o.z = cvtpk(s[4 * 33], s[5 * 33]); o.w = cvtpk(s[6 * 33], s[7 * 33]);
        *(GAS u32x4*)(WT + (size_t)(row0 + n) * Kout + k0 + 8 * c) = o; }
    asm volatile("s_waitcnt lgkmcnt(0)" ::: "memory");
}
__device__ __forceinline__ void sincos_d(double a, double& s, double& c) {
    const double TWO_PI = 6.283185307179586476925;
    const double n = rint(a / TWO_PI); const double r = a - n * TWO_PI;
    const double q = r * 0.25, q2 = q * q;
    const double sq = q * (1.0 + q2 * (-1.0 / 6 + q2 * (1.0 / 120 + q2 * (-1.0 / 5040 + q2 * (1.0 / 362880 + q2 * (-1.0 / 39916800 + q2 * (1.0 / 6227020800.0)))))));
    const double cq = 1.0 + q2 * (-0.5 + q2 * (1.0 / 24 + q2 * (-1.0 / 720 + q2 * (1.0 / 40320 + q2 * (-1.0 / 3628800 + q2 * (1.0 / 479001600.0 + q2 * (-1.0 / 87178291200.0)))))));
    const double s2 = 2 * sq * cq, c2 = 1 - 2 * sq * sq;
    s = 2 * s2 * c2; c = 1 - 2 * s2 * s2;
}
__device__ __forceinline__ void convert_layer_weights(const PArgs& a, LAS unsigned char* lds, int l, int vcu, int G, int sel) {
    unsigned char* ws = a.ws();
    int tid_ = threadIdx.x; asm volatile("" : "+v"(tid_)); const int tid = tid_, lane = tid & 63, wave = __builtin_amdgcn_readfirstlane(tid >> 6);
    const int gw = vcu * NWAVES + wave, NGW = G * NWAVES;
    const size_t gt = (size_t)vcu * NTHR + tid, NGT = (size_t)G * NTHR;
    LAS float* scr = (LAS float*)(lds + wave * 16384);
    constexpr int I_A = 16 * 62, I_B = 16 * 32, I_C = 32 * 16 * 16, I_E = 32 * 8 * 32, PER_L = I_A + I_B + 2 * I_C + I_E;
    const int it_lo = (sel & 1) ? 0 : I_A + I_B, it_hi = (sel & 2) ? PER_L : I_A + I_B;
    for (int it = it_lo + gw; it < it_hi; it += NGW) {
        int r = it;
        if (r < I_A) { const int kb = r / 62, nb = r % 62; transpose_item(a.in(I_WIN) + (size_t)l * DM * INW, INW, 64 * kb, 32 * nb, (bf16_t*)(ws + WS_WIN + (size_t)l * 4 * MiB), DM, 32 * nb, scr, lane); continue; } r -= I_A;
        if (r < I_B) { const int kb = r / 32, nb = r % 32; transpose_item(a.in(I_WO) + (size_t)l * DM * DM, DM, 64 * kb, 32 * nb, (bf16_t*)(ws + WS_WO + (size_t)l * 2 * MiB), DM, 32 * nb, scr, lane); continue; } r -= I_B;
        if (r < 2 * I_C) { const int up = r >= I_C; if (up) r -= I_C; const int e = r / 256, rr = r % 256, kb = rr / 16, nb = rr % 16; const int n0 = 32 * nb;
            transpose_item(a.in(up ? I_EU : I_EG) + ((size_t)l * NEXP + e) * DM * EH, EH, 64 * kb, n0, (bf16_t*)(ws + WS_WGU) + (size_t)e * 1024 * DM, DM, 256 * (n0 >> 7) + (n0 & 127) + (up ? 128 : 0), scr, lane); continue; } r -= 2 * I_C;
        { const int e = r / 256, rr = r % 256, kb = rr / 32, nb = rr % 32;
            transpose_item(a.in(I_ED) + ((size_t)l * NEXP + e) * EH * DM, DM, 64 * kb, 32 * nb, (bf16_t*)(ws + WS_WD) + (size_t)e * DM * EH, EH, 32 * nb, scr, lane); }
    }
    if (sel & 1) for (size_t i = gt; i < (size_t)64 * DM / 8; i += NGT) *(GAS u32x4*)((bf16_t*)(ws + WS_WIN + (size_t)l * 4 * MiB) + (size_t)INW * DM + i * 8) = (u32x4){0u, 0u, 0u, 0u};
}
__device__ __forceinline__ void phase_prologue(const PArgs& a, LAS unsigned char* lds, int vcu, int G) {
    unsigned char* ws = a.ws();
    int tid_ = threadIdx.x; asm volatile("" : "+v"(tid_)); const int tid = tid_, lane = tid & 63, wave = __builtin_amdgcn_readfirstlane(tid >> 6);
    const int gw = vcu * NWAVES + wave, NGW = G * NWAVES;
    const size_t gt = (size_t)vcu * NTHR + tid, NGT = (size_t)G * NTHR;
    LAS float* scr = (LAS float*)(lds + wave * 16384);
    convert_layer_weights(a, lds, 0, vcu, G, 3);
#pragma unroll 1
    for (int l = 1; l < DEPTH; ++l) convert_layer_weights(a, lds, l, vcu, G, 1);
    for (size_t i = gt; i < (size_t)NTOK * DM / 8; i += NGT) { const f32x4 v0 = *(const GAS f32x4*)(a.in(I_X) + i * 8), v1 = *(const GAS f32x4*)(a.in(I_X) + i * 8 + 4);
        u32x4 o; o.x = cvtpk(v0[0], v0[1]); o.y = cvtpk(v0[2], v0[3]); o.z = cvtpk(v1[0], v1[1]); o.w = cvtpk(v1[2], v1[3]);
        *(GAS u32x4*)((bf16_t*)(ws + WS_XN) + i * 8) = o; }
    unsigned char* sm = ws + WS_SMALL;
    for (size_t i = gt; i < 64 * 16; i += NGT) { const int pos = (int)(i >> 4), f = (int)(i & 15); double inv = 1.0; for (int k = 0; k < f; ++k) inv *= 0.56234132519034908;
        double s, c; sincos_d((double)pos * inv, s, c); float* R = (float*)(sm + SM_ROPE) + pos * 32; R[f] = (float)c; R[16 + f] = (float)s; }
    for (size_t i = gt; i < (size_t)DEPTH * 4 * 64 * 64; i += NGT) { const int k = (int)(i & 63), n = (int)((i >> 6) & 63); const size_t lg = i >> 12;
        ((bf16_t*)(sm + SM_PWT))[i] = (bf16_t)(cvtpk(a.in(I_POOLW)[(lg * 64 + k) * 64 + n], 0.f) & 0xffffu); }
    for (size_t i = gt; i < (size_t)DEPTH * 2 * 256 * 32; i += NGT) { const int k = (int)(i & 31), n = (int)((i >> 5) & 255); const size_t ld = i >> 13;
        ((bf16_t*)(sm + SM_WUPT))[i] = (bf16_t)(cvtpk(a.in(I_WUP)[(ld * 32 + k) * 256 + n], 0.f) & 0xffffu);
        ((bf16_t*)(sm + SM_AUPT))[i] = (bf16_t)(cvtpk(a.in(I_AUP)[(ld * 32 + k) * 256 + n], 0.f) & 0xffffu); }
    for (size_t i = gt; i < (size_t)DEPTH * 256 * 64; i += NGT) { const int k = (int)(i & 63), n = (int)((i >> 6) & 255); const size_t l = i >> 14;
        ((bf16_t*)(sm + SM_GUPT))[i] = (bf16_t)(cvtpk(a.in(I_GUP)[(l * 64 + k) * 256 + n], 0.f) & 0xffffu); }
    for (size_t i = gt; i < (size_t)DEPTH * 48 * 1024; i += NGT) { const int k = (int)(i & 1023); const int c = (int)((i >> 10) % 48); const size_t l = i / (48 * 1024);
        const float w = (c < 32 ? ((const GAS float*)a.in(I_RE))[(l * DM + k) * 32 + c] : (c < 36 ? ((const GAS float*)a.in(I_RG))[(l * DM + k) * 4 + (c - 32)] : 0.f)) * ((const GAS float*)a.in(I_LN1G))[l * DM + k];
        const unsigned hi_ = cvtpk(w, 0.f) & 0xffffu; const float lo_ = w - __uint_as_float(hi_ << 16);
        bf16_t* RWB = (bf16_t*)(ws + WS_RWB) + l * 2 * 48 * 1024; RWB[c * 1024 + k] = (bf16_t)hi_; RWB[48 * 1024 + c * 1024 + k] = (bf16_t)(cvtpk(lo_, 0.f) & 0xffffu); }
    for (int it = gw; it < DEPTH * 48; it += NGW) { const int l = it / 48, c = it % 48; float sb_ = 0.f;
        if (c < 36) for (int k = lane; k < DM; k += 64) sb_ += ((const GAS float*)a.in(I_LN1B))[l * DM + k] * (c < 32 ? ((const GAS float*)a.in(I_RE))[((size_t)l * DM + k) * 32 + c] : ((const GAS float*)a.in(I_RG))[((size_t)l * DM + k) * 4 + (c - 32)]);
        sb_ = wave_sum(sb_); if (lane == 0) ((GAS float*)(ws + WS_RB))[it] = sb_; }
}

constexpr size_t REC_BYTES = 13568, REC_AOP = 0  , REC_AY = 5120  , REC_AS = 7168  , REC_GC = 11264  , REC_VT = 11520  ;
__device__ __forceinline__ int permp(int x) { return (x & 3) | ((x & 4) << 1) | ((x & 8) >> 1); }
__device__ __forceinline__ bf16x8 pack_frag(const float (&x)[8]) { u32x4 o; o.x = cvtpk(x[0], x[1]); o.y = cvtpk(x[2], x[3]); o.z = cvtpk(x[4], x[5]); o.w = cvtpk(x[6], x[7]); return __builtin_bit_cast(bf16x8, o); }
__device__ __forceinline__ void swap32(float a, float b, float& lo, float& hi) {
    auto rr = __builtin_amdgcn_permlane32_swap(__float_as_uint(a), __float_as_uint(b), false, false); lo = __uint_as_float(rr[0]); hi = __uint_as_float(rr[1]); }

__device__ __forceinline__ void scan_pre_item(const PArgs& a, LAS bf16_t* X, int bh, int dir, int c, int lane, int var = 0) {
    unsigned char* ws0 = a.ws_; asm volatile("" : "+s"(ws0)); unsigned char* ws = (unsigned char*)(GAS unsigned char*)ws0;
    asm volatile("" : "+v"(lane));
    const int l31 = lane & 31, hi = lane >> 5;
    {
        const int item = (bh * 2 + dir) * 128 + c;
        const size_t hb = (size_t)bh * SEQ * 64 + lane;
        const GAS unsigned short* gW = (const GAS unsigned short*)(ws + (dir ? WS_WH1 : WS_WH0)) + hb; const GAS bf16_t* gV = (const GAS bf16_t*)(ws + WS_V) + hb;
        const GAS unsigned char* gFC = (const GAS unsigned char*)(ws + (dir ? WS_FC1 : WS_FC0)) + ((size_t)bh * SEQ * 32 + (lane >> 1)) * 16;
        unsigned char* rec = ws + WS_REC + (size_t)item * REC_BYTES;
        float ah[16], bhh[16], khh[16], rh[16]; unsigned vv2[8] = {0u, 0u, 0u, 0u, 0u, 0u, 0u, 0u};
        float g = 1.f;
        {
            u32x4 ck[16]; unsigned short wr_[16], vr[16];
#pragma unroll
            for (int t = 0; t < 16; ++t) { const int tt = dir ? SEQ - 1 - (16 * c + t) : 16 * c + t; const size_t o = (size_t)tt * 64;
                ck[t] = *(const GAS u32x4*)(gFC + (size_t)tt * 512); wr_[t] = gW[o]; vr[t] = gV[o]; }
            asm volatile("" ::: "memory");
            const int sh = (lane & 1) * 16;
#pragma unroll
            for (int t = 0; t < 16; ++t) {
                const float w = (float)__builtin_bit_cast(_Float16, wr_[t]), b = __uint_as_float((ck[t].x >> sh) << 16), kh = __uint_as_float((ck[t].y >> sh) << 16), kk = __uint_as_float((ck[t].z >> sh) << 16), r = __uint_as_float((ck[t].w >> sh) << 16);
                vv2[t >> 1] |= (unsigned)vr[t] << (16 * (t & 1));
                ah[t] = g * kk; g *= w; const float ig = __builtin_amdgcn_rcpf(g); bhh[t] = b * ig; khh[t] = kh * ig; rh[t] = g * r; }
        }
        const float gC = g;
#pragma unroll
        for (int t = 0; t < 16; ++t) { X[(0 * 16 + t) * 64 + lane] = (bf16_t)(cvtpk(ah[t], 0.f) & 0xffffu); X[(1 * 16 + t) * 64 + lane] = (bf16_t)(cvtpk(bhh[t], 0.f) & 0xffffu);
            X[(2 * 16 + t) * 64 + lane] = (bf16_t)(cvtpk(khh[t], 0.f) & 0xffffu); X[(3 * 16 + t) * 64 + lane] = (bf16_t)(cvtpk(rh[t], 0.f) & 0xffffu); }
        f32x16 Nacc = f32x16{};
        { const LAS bf16_t* pa = X + ((l31 < 16 ? 1 : 2) * 16 + (l31 & 15)) * 64 + 8 * hi; const LAS bf16_t* pb = X + ((l31 < 16 ? 0 : 3) * 16 + (l31 & 15)) * 64 + 8 * hi;
#pragma unroll
          for (int ks = 0; ks < 4; ++ks) Nacc = __builtin_amdgcn_mfma_f32_32x32x16_bf16(*(const LAS bf16x8*)(pa + 16 * ks), *(const LAS bf16x8*)(pb + 16 * ks), Nacc, 0, 0, 0); }
        float NB[16], NK[16];
        { const int lim = (l31 & 15) + (l31 >> 4);
#pragma unroll
          for (int r = 0; r < 16; ++r) { float lo_, oth; swap32(Nacc[r], Nacc[r], lo_, oth);
              const int r7 = r & 7, s_own = (r7 & 3) + 8 * (r7 >> 2), s_oth = s_own + 4;
              const float vo = (s_own < lim) ? Nacc[r] : 0.f, vt = (s_oth < lim) ? oth : 0.f;
              if (r < 8) { NB[s_own] = vo; NB[s_oth] = vt; } else { NK[s_own] = vo; NK[s_oth] = vt; } } }
        float Tc[16], Mc[16];
#pragma unroll
        for (int s_ = 0; s_ < 16; ++s_) { Tc[s_] = (s_ == lane) ? 1.f : 0.f; Mc[s_] = 0.f; }
        if (var < 2) {
#pragma unroll
        for (int p = 0; p < 15; ++p)
#pragma unroll
            for (int s_ = 0; s_ <= p; ++s_) { const float tb_ = __int_as_float(__builtin_amdgcn_readlane(__float_as_int(Tc[s_]), p)); Tc[s_] -= tb_ * NB[p]; }
#pragma unroll
        for (int p = 1; p < 16; ++p)
#pragma unroll
            for (int s_ = 0; s_ < p; ++s_) { const float nb_ = __int_as_float(__builtin_amdgcn_readlane(__float_as_int(NK[s_]), p)); Mc[s_] += nb_ * Tc[p]; }
        }
        f32x16 Ap0, Ap1;
        { float ta[8], f0[8], f1[8];
#pragma unroll
          for (int jj = 0; jj < 8; ++jj) { float lo_, hi_; swap32(Tc[jj], Tc[8 + jj], lo_, hi_); ta[jj] = lo_; swap32(ah[jj], ah[8 + jj], f0[jj], f1[jj]); }
          const bf16x8 TA = pack_frag(ta);
          Ap0 = __builtin_amdgcn_mfma_f32_32x32x16_bf16(TA, pack_frag(f0), f32x16{}, 0, 0, 0); Ap1 = __builtin_amdgcn_mfma_f32_32x32x16_bf16(TA, pack_frag(f1), f32x16{}, 0, 0, 0); }
        if (var == 0) {
#define FRAG_OFF(m, ks, p) ((ks) * 1024 + ((m) + 32 * ((p) >> 3)) * 16 + ((p) & 7) * 2)
        { LAS unsigned char* AL = (LAS unsigned char*)X;
          { const int ksl = l31 >> 4, pj = permp(l31 & 15);
#pragma unroll
            for (int r = 0; r < 8; ++r) { const int t = (r & 3) + 8 * (r >> 2) + 4 * hi;
                *(LAS bf16_t*)(AL + FRAG_OFF(t, ksl, pj)) = (bf16_t)(cvtpk(Ap0[r], 0.f) & 0xffffu); *(LAS bf16_t*)(AL + FRAG_OFF(t, 2 + ksl, pj)) = (bf16_t)(cvtpk(Ap1[r], 0.f) & 0xffffu); } }
          { const int ksj = lane >> 4, pj = permp(lane & 15);
#pragma unroll
            for (int t = 0; t < 16; ++t) *(LAS bf16_t*)(AL + FRAG_OFF(16 + t, ksj, pj)) = (bf16_t)(cvtpk(rh[t], 0.f) & 0xffffu); }
          if (lane < 16) { float m0[8], m1[8];
#pragma unroll
              for (int jj = 0; jj < 8; ++jj) { m0[jj] = Mc[jj]; m1[jj] = Mc[8 + jj]; }
              *(LAS bf16x8*)(AL + 4096 + lane * 16) = pack_frag(m0); *(LAS bf16x8*)(AL + 4096 + (lane + 32) * 16) = pack_frag(m1);
              *(LAS u32x4*)(AL + 4096 + (16 + lane) * 16) = (u32x4){0u, 0u, 0u, 0u}; *(LAS u32x4*)(AL + 4096 + (48 + lane) * 16) = (u32x4){0u, 0u, 0u, 0u}; }
          asm volatile("s_waitcnt lgkmcnt(0)" ::: "memory");
#pragma unroll
          for (int k = 0; k < 5; ++k) { const u32x4 v = *(const LAS u32x4*)(AL + k * 1024 + lane * 16); *(GAS u32x4*)(rec + REC_AOP + k * 1024 + lane * 16) = v; }
          asm volatile("s_waitcnt lgkmcnt(0)" ::: "memory"); }
        if (lane >= 16 && lane < 32) { unsigned char* AY = rec + REC_AY; const int t = lane - 16;
            float y0[8], y1[8], y2[8], y3[8];
#pragma unroll
            for (int jj = 0; jj < 8; ++jj) { y0[jj] = -NB[permp(jj)]; y1[jj] = -NB[permp(8 + jj)]; y2[jj] = NK[jj]; y3[jj] = NK[8 + jj]; }
            *(GAS bf16x8*)(AY + t * 16) = pack_frag(y0); *(GAS bf16x8*)(AY + (t + 32) * 16) = pack_frag(y1); *(GAS bf16x8*)(AY + 1024 + t * 16) = pack_frag(y2); *(GAS bf16x8*)(AY + 1024 + (t + 32) * 16) = pack_frag(y3);
            const u32x4 z = {0u, 0u, 0u, 0u};
            *(GAS u32x4*)(AY + (16 + t) * 16) = z; *(GAS u32x4*)(AY + (48 + t) * 16) = z; *(GAS u32x4*)(AY + 1024 + (16 + t) * 16) = z; *(GAS u32x4*)(AY + 1024 + (48 + t) * 16) = z; }
        { unsigned char* AS = rec + REC_AS + (lane >> 5) * 2048; const int jl = lane & 31;
            float s0[8], s1[8], s2[8], s3[8];
#pragma unroll
            for (int jj = 0; jj < 8; ++jj) { s0[jj] = -bhh[permp(jj)] * gC; s1[jj] = -bhh[permp(8 + jj)] * gC; s2[jj] = khh[jj] * gC; s3[jj] = khh[8 + jj] * gC; }
            *(GAS bf16x8*)(AS + jl * 16) = pack_frag(s0); *(GAS bf16x8*)(AS + (jl + 32) * 16) = pack_frag(s1); *(GAS bf16x8*)(AS + 1024 + jl * 16) = pack_frag(s2); *(GAS bf16x8*)(AS + 1024 + (jl + 32) * 16) = pack_frag(s3); }
        { const int jl = lane & 31; ((GAS float*)(rec + REC_GC))[(lane >> 5) * 32 + ((jl >> 2) & 1) * 16 + (jl & 3) + 4 * (jl >> 3)] = gC; }
        { unsigned char* VT = rec + REC_VT + (lane >> 5) * 1024; const int il = lane & 31;
            *(GAS u32x4*)(VT + il * 16) = (u32x4){vv2[0], vv2[1], vv2[2], vv2[3]};
            *(GAS u32x4*)(VT + (il + 32) * 16) = (u32x4){vv2[4], vv2[5], vv2[6], vv2[7]}; }
        } else { asm volatile("" :: "v"(Ap0[0]), "v"(Ap1[0]), "v"(Mc[0]), "v"(NB[1]), "v"(NK[1]), "v"(gC), "v"(vv2[0])); }
#undef FRAG_OFF
    }
}

constexpr int FT_STRIDE = 968, DT_STRIDE = 264, DT_OFF = 64 * FT_STRIDE * 2;
static_assert(DT_OFF + 64 * DT_STRIDE * 2 <= LDSCTL_OFF, "prep LDS");
__device__ __forceinline__ void unpack8(const u32x4 w, float (&x)[8]) { x[0] = bflo(w.x); x[1] = bfhi(w.x); x[2] = bflo(w.y); x[3] = bfhi(w.y); x[4] = bflo(w.z); x[5] = bfhi(w.z); x[6] = bflo(w.w); x[7] = bfhi(w.w); }
__device__ __forceinline__ u32x4 pack8(const float (&x)[8]) { u32x4 o; o.x = cvtpk(x[0], x[1]); o.y = cvtpk(x[2], x[3]); o.z = cvtpk(x[4], x[5]); o.w = cvtpk(x[6], x[7]); return o; }
__device__ __forceinline__ void unpack4(const u32x2 w, float (&x)[4]) { x[0] = bflo(w.x); x[1] = bfhi(w.x); x[2] = bflo(w.y); x[3] = bfhi(w.y); }

__device__ __forceinline__ void phase_prep(const PArgs& a_in, LAS unsigned char* lds, int l, int dry, int i0, int ihi, int istep, const unsigned* pcnt) {
    int tid_ = threadIdx.x; asm volatile("" : "+v"(tid_)); const int tid = tid_, lane = tid & 63, wave = __builtin_amdgcn_readfirstlane(tid >> 6), l31 = lane & 31, hi = lane >> 5;
    LAS bf16_t* Ft = (LAS bf16_t*)lds; LAS bf16_t* Dt = (LAS bf16_t*)(lds + DT_OFF);
    for (int item = i0; item < (dry >= 5 ? 0 : ihi); item += istep) {
        const int tb = item * 64, t0 = tb & (SEQ - 1), bidx = tb / SEQ;
        if (pcnt) { const int pm = item >> 2, q = item & 3; unsigned* tmo = (unsigned*)(a_in.ws() + WS_CTL) + 8;
            wait_count(pcnt + 16 * pm, 64u, tmo);
            if (q == 0 && t0 > 0) wait_count(pcnt + 16 * (pm - 1), 64u, tmo);
            if (q == 3 && t0 + 64 < SEQ) wait_count(pcnt + 16 * (pm + 1), 64u, tmo); }
        PArgs a = a_in; asm volatile("" : "+s"(a.kp), "+s"(a.ws_));
        unsigned char* ws = a.ws(); unsigned char* sm = ws + WS_SMALL; bf16_t* PROJ = (bf16_t*)(ws + WS_PROJ); bf16_t* MIX = (bf16_t*)(ws + WS_MIX); const float* ROPE = (const float*)(sm + SM_ROPE);
        int tv = tid; asm volatile("" : "+v"(tv));
        {
            u32x4 raw[10];
#pragma unroll
            for (int it = 0; it < 10; ++it) { const int idx = tv + NTHR * it, chunk = idx & 7, hv = idx >> 3, tok = hv / 10, head = hv - tok * 10;
                const int col = head < 8 ? C_Q + head * 64 : C_K + (head - 8) * 64;
                raw[it] = *(const GAS u32x4*)(PROJ + (size_t)(tb + tok) * INP + col + chunk * 8); }
#pragma unroll
            for (int it = 0; it < 10; ++it) { const int idx = tv + NTHR * it, chunk = idx & 7, hv = idx >> 3, tok = hv / 10, head = hv - tok * 10;
                const int col = head < 8 ? C_Q + head * 64 : C_K + (head - 8) * 64;
                bf16_t* p = PROJ + (size_t)(tb + tok) * INP + col + chunk * 8;
                float x[8]; unpack8(raw[it], x);
                float ss = 0.f;
#pragma unroll
                for (int j = 0; j < 8; ++j) ss += x[j] * x[j];
                ss += __shfl_xor(ss, 1); ss += __shfl_xor(ss, 2); ss += __shfl_xor(ss, 4);
                const float rs = rsqrtf(ss * (1.f / 64.f) + QK_EPS);
                const GAS float* gw = (const GAS float*)(a.in(head < 8 ? I_QN : I_KN) + l * 64 + chunk * 8);
                const int t = t0 + tok, pos = chunk < 4 ? (t >> 6) : (t & 63);
                const GAS float* ct = (const GAS float*)(ROPE + pos * 32 + (chunk & 1) * 8);
                const float sgn = (chunk & 2) ? 1.f : -1.f, qs = head < 8 ? QSCALE : 1.f;
                float y[8], o[8];
#pragma unroll
                for (int j = 0; j < 8; ++j) y[j] = x[j] * rs * gw[j];
#pragma unroll
                for (int j = 0; j < 8; ++j) { const float yp = __shfl_xor(y[j], 2); o[j] = (y[j] * ct[j] + sgn * yp * ct[16 + j]) * qs; }
                if (!dry) *(GAS u32x4*)p = pack8(o); }
        }
        asm volatile("" ::: "memory");
        if (tv < 480) {
            const int ch8 = tv % 120, tg = tv / 120, c = ch8 * 8;
            float mp[8], mn[8];
#pragma unroll
            for (int j = 0; j < 8; ++j) { mp[j] = ((const GAS float*)a.in(I_MUP))[l * 960 + c + j]; mn[j] = ((const GAS float*)a.in(I_MUN))[l * 960 + c + j]; }
            const int mode = (c >= 768 && c < 832) ? 1 : (c >= 896 ? 2 : 0);
#pragma unroll
            for (int hf = 0; hf < 2; ++hf) {
                asm volatile("" ::: "memory");
                const int tk0 = tg * 16 + hf * 8;
                u32x4 rw[10];
#pragma unroll
                for (int r = 0; r < 10; ++r) { const int t = t0 + tk0 - 1 + r;
                    rw[r] = (t >= 0 && t < SEQ) ? *(const GAS u32x4*)(PROJ + (size_t)(tb + tk0 - 1 + r) * INP + C_RW + c) : (u32x4){0u, 0u, 0u, 0u}; }
#pragma unroll
                for (int k = 0; k < 8; ++k) { float pp[8], p[8], pn[8], f[8]; unpack8(rw[k], pp); unpack8(rw[k + 1], p); unpack8(rw[k + 2], pn);
#pragma unroll
                    for (int j = 0; j < 8; ++j) f[j] = p[j] + mp[j] * (pp[j] - p[j]) + mn[j] * (pn[j] - p[j]);
                    if (mode == 1) {
#pragma unroll
                        for (int j = 0; j < 8; ++j) f[j] = 1.f - 2.f * __builtin_amdgcn_rcpf(__expf(2.f * f[j]) + 1.f);
                    } else if (mode == 2) {
#pragma unroll
                        for (int j = 0; j < 8; ++j) f[j] = sigmoidf_(f[j]);
                    }
                    *(LAS u32x4*)(Ft + (tk0 + k) * FT_STRIDE + c) = pack8(f); }
            }
        }
        asm volatile("" ::: "memory");
#pragma unroll 1
        for (int it = 0; it < 4; ++it) {
            asm volatile("" ::: "memory");
            const int idx = tv + NTHR * it, tok = idx >> 5, ch8 = idx & 31, g = ch8 >> 3, w = 2 << g, t = t0 + tok;
            const bf16_t* base = PROJ + (size_t)(bidx * SEQ) * INP + ch8 * 8;
            u32x4 rw[16];
#pragma unroll
            for (int i = 0; i < 16; ++i) { const int r = t - (w >> 1) + i; rw[i] = (i < w && r >= 0 && r < SEQ) ? *(const GAS u32x4*)(base + (size_t)r * INP) : (u32x4){0u, 0u, 0u, 0u}; }
            const u32x4 ur = *(const GAS u32x4*)(base + (size_t)t * INP);
            float acc[8] = {0.f, 0.f, 0.f, 0.f, 0.f, 0.f, 0.f, 0.f};
#pragma unroll
            for (int i = 0; i < 16; ++i) { float v[8]; unpack8(rw[i], v);
#pragma unroll
                for (int j = 0; j < 8; ++j) acc[j] += v[j]; }
            const int lo = max(t - (w >> 1), 0), hiw = min(t + (w >> 1), SEQ);
            float u[8]; unpack8(ur, u);
            const float inv = 1.f / (float)(hiw - lo);
            float d[8];
#pragma unroll
            for (int j = 0; j < 8; ++j) d[j] = acc[j] * inv - u[j];
            *(LAS u32x4*)(Dt + tok * DT_STRIDE + ch8 * 8) = pack8(d);
        }
        __syncthreads();
        if (dry != 2) {
        const int th = wave & 1, hd = wave >> 1, tokl = 32 * th + l31;
        const int ce = 64 * hd + 2 * l31;
#define TOKR(r) (32 * th + ((r) & 3) + 8 * ((r) >> 2) + 4 * hi)
        {
            const bf16_t* PWT = (const bf16_t*)(sm + SM_PWT) + (size_t)(l * 4 + hd) * 4096;
            f32x16 pe = f32x16{}, po = f32x16{};
#pragma unroll
            for (int s = 0; s < 4; ++s) { const bf16x8 A = *(const LAS bf16x8*)(Dt + tokl * DT_STRIDE + 64 * hd + 16 * s + 8 * hi);
                pe = __builtin_amdgcn_mfma_f32_32x32x16_bf16(A, *(const GAS bf16x8*)(PWT + (2 * l31) * 64 + 16 * s + 8 * hi), pe, 0, 0, 0);
                po = __builtin_amdgcn_mfma_f32_32x32x16_bf16(A, *(const GAS bf16x8*)(PWT + (2 * l31 + 1) * 64 + 16 * s + 8 * hi), po, 0, 0, 0); }
            const f32x2 sc = *(const GAS f32x2*)(a.in(I_POOLS) + l * 256 + ce);
#pragma unroll
            for (int r = 0; r < 16; ++r) *(GAS unsigned*)(MIX + (size_t)(tb + TOKR(r)) * DM + ce) = cvtpk(pe[r] * sc[0], po[r] * sc[1]);
        }
        {
            const LAS bf16_t* Frow = Ft + tokl * FT_STRIDE;
            const int bh = bidx * 4 + hd; const size_t hbase = ((size_t)bh * SEQ + t0) * 64 + 2 * l31;
            const f32x2 kkw = *(const GAS f32x2*)(a.in(I_KK) + l * 256 + ce), kaw = *(const GAS f32x2*)(a.in(I_KA) + l * 256 + ce), rkw = *(const GAS f32x2*)(a.in(I_RK) + l * 256 + ce);
            const bf16_t* WUPT = (const bf16_t*)(sm + SM_WUPT) + (size_t)l * 2 * 256 * 32; const bf16_t* AUPT = (const bf16_t*)(sm + SM_AUPT) + (size_t)l * 2 * 256 * 32;
            const bf16_t* GUPT = (const bf16_t*)(sm + SM_GUPT) + (size_t)l * 256 * 64;
            const int ne = ce, no = ce + 1;
            unsigned kp[16];
            float invn[16];
#pragma unroll
            for (int r = 0; r < 16; ++r) { kp[r] = *(const LAS unsigned*)(Ft + TOKR(r) * FT_STRIDE + 256 + ce);
                const float ve = bflo(kp[r]) * kkw[0], vo = bfhi(kp[r]) * kkw[1]; float q = ve * ve + vo * vo;
                q = red16(q); q += __shfl_xor(q, 16); invn[r] = 1.f / fmaxf(sqrtf(q), 1e-12f); }
            asm volatile("" ::: "memory"); __builtin_amdgcn_sched_barrier(0);
            {
                f32x16 d0e = f32x16{}, d0o = f32x16{}, d1e = f32x16{}, d1o = f32x16{};
#pragma unroll
                for (int s = 0; s < 2; ++s) { const int ko = 16 * s + 8 * hi; const bf16x8 A0 = *(const LAS bf16x8*)(Frow + 768 + ko), A1 = *(const LAS bf16x8*)(Frow + 800 + ko);
                    d0e = __builtin_amdgcn_mfma_f32_32x32x16_bf16(A0, *(const GAS bf16x8*)(WUPT + (0 * 256 + ne) * 32 + ko), d0e, 0, 0, 0);
                    d0o = __builtin_amdgcn_mfma_f32_32x32x16_bf16(A0, *(const GAS bf16x8*)(WUPT + (0 * 256 + no) * 32 + ko), d0o, 0, 0, 0);
                    d1e = __builtin_amdgcn_mfma_f32_32x32x16_bf16(A1, *(const GAS bf16x8*)(WUPT + (1 * 256 + ne) * 32 + ko), d1e, 0, 0, 0);
                    d1o = __builtin_amdgcn_mfma_f32_32x32x16_bf16(A1, *(const GAS bf16x8*)(WUPT + (1 * 256 + no) * 32 + ko), d1o, 0, 0, 0); }
                const f32x2 w00 = *(const GAS f32x2*)(a.in(I_W0) + (l * 2 + 0) * 256 + ce), w01 = *(const GAS f32x2*)(a.in(I_W0) + (l * 2 + 1) * 256 + ce);
#pragma unroll
                for (int r = 0; r < 16; ++r) { const size_t o = hbase + (size_t)TOKR(r) * 64;
                    const f32x2 x0 = {__expf(-0.6065306597126334f * sigmoidf_(w00[0] + d0e[r])), __expf(-0.6065306597126334f * sigmoidf_(w00[1] + d0o[r]))};
                    const f32x2 x1 = {__expf(-0.6065306597126334f * sigmoidf_(w01[0] + d1e[r])), __expf(-0.6065306597126334f * sigmoidf_(w01[1] + d1o[r]))};
                    typedef _Float16 h2_t __attribute__((ext_vector_type(2)));
                    const unsigned p0 = __builtin_bit_cast(unsigned, (h2_t){(_Float16)x0[0], (_Float16)x0[1]}), p1 = __builtin_bit_cast(unsigned, (h2_t){(_Float16)x1[0], (_Float16)x1[1]});
                    if (dry != 3) { *(GAS unsigned*)((unsigned short*)(ws + WS_WH0) + o) = p0; *(GAS unsigned*)((unsigned short*)(ws + WS_WH1) + o) = p1; } else asm volatile("" :: "v"(p0), "v"(p1)); }
            }
            asm volatile("" ::: "memory"); __builtin_amdgcn_sched_barrier(0);
            {
                f32x16 a0e = f32x16{}, a0o = f32x16{}, a1e = f32x16{}, a1o = f32x16{};
#pragma unroll
                for (int s = 0; s < 2; ++s) { const int ko = 16 * s + 8 * hi; const bf16x8 A0 = *(const LAS bf16x8*)(Frow + 832 + ko), A1 = *(const LAS bf16x8*)(Frow + 864 + ko);
                    a0e = __builtin_amdgcn_mfma_f32_32x32x16_bf16(A0, *(const GAS bf16x8*)(AUPT + (0 * 256 + ne) * 32 + ko), a0e, 0, 0, 0);
                    a0o = __builtin_amdgcn_mfma_f32_32x32x16_bf16(A0, *(const GAS bf16x8*)(AUPT + (0 * 256 + no) * 32 + ko), a0o, 0, 0, 0);
                    a1e = __builtin_amdgcn_mfma_f32_32x32x16_bf16(A1, *(const GAS bf16x8*)(AUPT + (1 * 256 + ne) * 32 + ko), a1e, 0, 0, 0);
                    a1o = __builtin_amdgcn_mfma_f32_32x32x16_bf16(A1, *(const GAS bf16x8*)(AUPT + (1 * 256 + no) * 32 + ko), a1o, 0, 0, 0); }
                const f32x2 b00 = *(const GAS f32x2*)(a.in(I_A0) + (l * 2 + 0) * 256 + ce), b01 = *(const GAS f32x2*)(a.in(I_A0) + (l * 2 + 1) * 256 + ce);
                GAS float* bsp = (GAS float*)(ws + WS_BON) + (size_t)bh * SEQ + t0 + 32 * th + 4 * hi; float bsacc = 0.f;
#define ST2(base, lo_, hi_) do { const unsigned _o = cvtpk(lo_, hi_); if (dry != 3) *(GAS unsigned*)((bf16_t*)(ws + (base)) + o) = _o; else asm volatile("" :: "v"(_o)); } while (0)
#pragma unroll
                for (int r = 0; r < 16; ++r) { const size_t o = hbase + (size_t)TOKR(r) * 64;
                    const unsigned rp = *(const LAS unsigned*)(Ft + TOKR(r) * FT_STRIDE + ce);
                    const float ke = bflo(kp[r]), ko_ = bfhi(kp[r]), re = bflo(rp), ro = bfhi(rp);
                    const float s0e = sigmoidf_(b00[0] + a0e[r]), s0o = sigmoidf_(b00[1] + a0o[r]), s1e = sigmoidf_(b01[0] + a1e[r]), s1o = sigmoidf_(b01[1] + a1o[r]);
                    const float kke = ke * kkw[0] * invn[r], kko = ko_ * kkw[1] * invn[r];
                    const float h0e = ke * (1.f + (s0e - 1.f) * kaw[0]), h0o = ko_ * (1.f + (s0o - 1.f) * kaw[1]), h1e = ke * (1.f + (s1e - 1.f) * kaw[0]), h1o = ko_ * (1.f + (s1o - 1.f) * kaw[1]);
                    float bs = re * (h0e + h1e) * rkw[0] + ro * (h0o + h1o) * rkw[1];
                    bs = red16(bs); bs += __shfl_xor(bs, 16);
                    const unsigned vp = *(const LAS unsigned*)(Ft + TOKR(r) * FT_STRIDE + 512 + ce);
                    if (dry != 3) *(GAS unsigned*)((bf16_t*)(ws + WS_V) + o) = vp; else asm volatile("" :: "v"(vp));
                    bsacc = (l31 == r) ? bs : bsacc;
                    { const unsigned kkp = cvtpk(kke, kko);
                      const u32x4 c0 = {cvtpk(kke * s0e, kko * s0o), cvtpk(h0e, h0o), kkp, rp}, c1 = {cvtpk(kke * s1e, kko * s1o), cvtpk(h1e, h1o), kkp, rp};
                      if (dry != 3) { *(GAS u32x4*)((unsigned char*)(ws + WS_FC0) + 8 * o) = c0; *(GAS u32x4*)((unsigned char*)(ws + WS_FC1) + 8 * o) = c1; } else asm volatile("" :: "v"(c0), "v"(c1)); } }
                if (l31 < 16) bsp[(l31 & 3) + 8 * (l31 >> 2)] = bsacc;
            }
            asm volatile("" ::: "memory"); __builtin_amdgcn_sched_barrier(0);
            {
                f32x16 ge = f32x16{}, go = f32x16{};
#pragma unroll
                for (int s = 0; s < 4; ++s) { const int ko = 16 * s + 8 * hi; const bf16x8 A0 = *(const LAS bf16x8*)(Frow + 896 + ko);
                    ge = __builtin_amdgcn_mfma_f32_32x32x16_bf16(A0, *(const GAS bf16x8*)(GUPT + ne * 64 + ko), ge, 0, 0, 0);
                    go = __builtin_amdgcn_mfma_f32_32x32x16_bf16(A0, *(const GAS bf16x8*)(GUPT + no * 64 + ko), go, 0, 0, 0); }
#pragma unroll
                for (int r = 0; r < 16; ++r) { const size_t o = hbase + (size_t)TOKR(r) * 64;
                    ST2(WS_G, ge[r], go[r]); }
#undef ST2
            }
        }
#undef TOKR
        }
        __syncthreads();
    }
    asm volatile("s_waitcnt vmcnt(0)" ::: "memory");
    __syncthreads();
    if (dry != 2 && dry != 4) {
#pragma unroll 1
        for (int item = i0; item < ihi; item += istep) {
            const int tb = item * 64, t0 = tb & (SEQ - 1), bidx = tb / SEQ;
#pragma unroll 1
            for (int q4 = 0; q4 < 4; ++q4) { const int itx = wave * 4 + q4, hd2 = itx & 3, qb = (itx >> 2) & 3, dir = itx >> 4;
                const int c0 = (t0 >> 4) + qb;
                int lz = lane; asm volatile("" : "+v"(lz));
                scan_pre_item(a_in, (LAS bf16_t*)(lds + wave * 8192), bidx * 4 + hd2, dir, dir ? 127 - c0 : c0, lz, dry >= 5 ? dry - 5 : 0); }
        }
    }
    __syncthreads();
}

typedef _Float16 h16x8 __attribute__((ext_vector_type(8)));
typedef _Float16 h16x4 __attribute__((ext_vector_type(4)));
constexpr int SC_CHUNK = 16, SC_NCH = SEQ / SC_CHUNK, SC_STEPB = 768  , SC_BUFB = SC_CHUNK * SC_STEPB, SC_YOFF = 2 * SC_BUFB, SC_YB = SC_CHUNK * 512 * 4;
static_assert(SC_YOFF + 2 * SC_YB <= LDSCTL_OFF, "scan LDS");
__device__ __forceinline__ float fmix_lo(float a, unsigned pk, float c) { float d; asm("v_fma_mix_f32 %0, %1, %2, %3 op_sel:[0,0,0] op_sel_hi:[0,1,0]" : "=v"(d) : "v"(a), "v"(pk), "v"(c)); return d; }
__device__ __forceinline__ float fmix_hi(float a, unsigned pk, float c) { float d; asm("v_fma_mix_f32 %0, %1, %2, %3 op_sel:[0,1,0] op_sel_hi:[0,1,0]" : "=v"(d) : "v"(a), "v"(pk), "v"(c)); return d; }
__device__ __forceinline__ float fmixn_lo(float a, unsigned pk, float c) { float d; asm("v_fma_mix_f32 %0, -%1, %2, %3 op_sel:[0,0,0] op_sel_hi:[0,1,0]" : "=v"(d) : "v"(a), "v"(pk), "v"(c)); return d; }
__device__ __forceinline__ float fmixn_hi(float a, unsigned pk, float c) { float d; asm("v_fma_mix_f32 %0, -%1, %2, %3 op_sel:[0,1,0] op_sel_hi:[0,1,0]" : "=v"(d) : "v"(a), "v"(pk), "v"(c)); return d; }
__device__ __forceinline__ unsigned h2pack(float lo, float hi) { typedef _Float16 h2 __attribute__((ext_vector_type(2))); h2 v = {(_Float16)lo, (_Float16)hi}; return __builtin_bit_cast(unsigned, v); }
struct ScOp { u32x4 q0, q1; u32x2 q2; unsigned short v; };
template <int DIR, int VAR>
__device__ __forceinline__ void scan_item(const PArgs& a, LAS unsigned char* lds, int bh, int half, int dummy) {
    unsigned char* ws = a.ws();
    int tid_ = threadIdx.x; asm volatile("" : "+v"(tid_)); const int tid = tid_, lane = tid & 63, wave = __builtin_amdgcn_readfirstlane(tid >> 6), c4 = lane & 15;
    const int irow = 32 * half + 4 * wave + (lane >> 4);
    const size_t hb = (size_t)bh * SEQ * 64;
    const bf16_t* gKK = (const bf16_t*)(ws + WS_KK) + hb; const bf16_t* gB = (const bf16_t*)(ws + WS_B + (size_t)DIR * 16 * MiB) + hb;
    const bf16_t* gKH = (const bf16_t*)(ws + WS_KH + (size_t)DIR * 16 * MiB) + hb; const bf16_t* gR = (const bf16_t*)(ws + WS_R) + hb; const bf16_t* gV = (const bf16_t*)(ws + WS_V) + hb;
    const float* gW = (const float*)(ws + WS_W + (size_t)DIR * 32 * MiB) + hb;
    float* gY = (float*)(ws + (dummy ? 950 * MiB : WS_WKV) + (size_t)DIR * 32 * MiB) + hb;
    const int sst = tid >> 4, sq = tid & 15; const size_t so = (size_t)sst * 64 + sq * 4; const int sd = sst * SC_STEPB + sq * 16;
    const int vt = tid - 256; const size_t vo = (size_t)(vt >> 3) * 64 + (vt & 7) * 8; const int vd = (vt >> 3) * SC_STEPB + 640 + (vt & 7) * 16;
    u32x2 rkk = {}, rb = {}, rkh = {}, rr = {}; f32x4 rw = {}; u32x4 rv = {};
#define SC_T0(cidx) (DIR ? SEQ - SC_CHUNK * ((cidx) + 1) : SC_CHUNK * (cidx))
#define SC_LOAD(cidx) do { const size_t _o = (size_t)SC_T0(cidx) * 64; \
        if (tid < 256) { rkk = *(const GAS u32x2*)(gKK + _o + so); rb = *(const GAS u32x2*)(gB + _o + so); rkh = *(const GAS u32x2*)(gKH + _o + so); rr = *(const GAS u32x2*)(gR + _o + so); rw = *(const GAS f32x4*)(gW + _o + so); } \
        else if (tid < 384) rv = *(const GAS u32x4*)(gV + _o + vo); } while (0)
#define SC_H4(vv) (u32x2){h2pack(bflo((vv)[0]), bfhi((vv)[0])), h2pack(bflo((vv)[1]), bfhi((vv)[1]))}
#define SC_STORE(bufb) do { if (tid < 256) { const u32x2 _a = SC_H4(rkk), _b = SC_H4(rb), _c = SC_H4(rkh), _d = SC_H4(rr); \
            *(LAS u32x4*)(lds + (bufb) + sd) = (u32x4){_a.x, _a.y, _b.x, _b.y}; *(LAS u32x4*)(lds + (bufb) + sd + 256) = (u32x4){_c.x, _c.y, _d.x, _d.y}; \
            *(LAS u32x2*)(lds + (bufb) + sst * SC_STEPB + 512 + sq * 8) = (u32x2){h2pack(rw[0], rw[1]), h2pack(rw[2], rw[3])}; } \
        else if (tid < 384) { *(LAS u32x4*)(lds + (bufb) + vd) = (u32x4){h2pack(bflo(rv.x), bfhi(rv.x)), h2pack(bflo(rv.y), bfhi(rv.y)), h2pack(bflo(rv.z), bfhi(rv.z)), h2pack(bflo(rv.w), bfhi(rv.w))}; } } while (0)
#define SC_RD(op, p) do { (op).q0 = *(const LAS u32x4*)((p) + 16 * c4); (op).q1 = *(const LAS u32x4*)((p) + 256 + 16 * c4); (op).q2 = *(const LAS u32x2*)((p) + 512 + 8 * c4); \
        (op).v = *(const LAS unsigned short*)((p) + 640 + 2 * irow); } while (0)
    const int fl_step = tid >> 5, fl_row = tid & 31;
#define SC_FLUSH(ybufb, t0) do { const LAS float* _q = (const LAS float*)(lds + (ybufb)) + fl_step * 512 + fl_row * 16; f32x4 _s = {0.f, 0.f, 0.f, 0.f}; \
        _Pragma("unroll") for (int _k = 0; _k < 4; ++_k) { const int _c = (_k + (tid >> 2)) & 3; _s += *(const LAS f32x4*)(_q + 4 * _c); } \
        ((GAS float*)gY)[(size_t)((t0) + fl_step) * 64 + 32 * half + fl_row] = (_s[0] + _s[1]) + (_s[2] + _s[3]); } while (0)
    SC_LOAD(0); SC_STORE(0);
    __syncthreads();
    float S0 = 0.f, S1 = 0.f, S2 = 0.f, S3 = 0.f;
#pragma unroll 1
    for (int cidx = 0; cidx < SC_NCH; ++cidx) {
        const int cb = cidx & 1;
        if (cidx + 1 < SC_NCH && VAR != 4) SC_LOAD(cidx + 1);
        if (cidx > 0 && VAR != 4 && VAR != 3) SC_FLUSH(SC_YOFF + (cb ^ 1) * SC_YB, SC_T0(cidx - 1));
        const LAS unsigned char* buf = lds + cb * SC_BUFB;
        LAS float* yb = (LAS float*)(lds + SC_YOFF + cb * SC_YB) + tid;
        ScOp cur, nxt;
        SC_RD(nxt, buf + (DIR ? SC_CHUNK - 1 : 0) * SC_STEPB);
#pragma unroll
        for (int jj = 0; jj < SC_CHUNK; ++jj) {
            const int s = DIR ? SC_CHUNK - 1 - jj : jj;
            cur = nxt;
            if (jj + 1 < SC_CHUNK && VAR != 2) { SC_RD(nxt, buf + (DIR ? s - 1 : s + 1) * SC_STEPB); }
            __builtin_amdgcn_sched_barrier(0);
            const float dot = fmix_hi(S1, cur.q0.x, fmix_lo(S0, cur.q0.x, 0.f)) + fmix_hi(S3, cur.q0.y, fmix_lo(S2, cur.q0.y, 0.f));
            const float vi = (float)__builtin_bit_cast(_Float16, cur.v);
            const float u0 = fmix_lo(S0, cur.q2.x, fmix_lo(vi, cur.q1.x, 0.f)), u1 = fmix_hi(S1, cur.q2.x, fmix_hi(vi, cur.q1.x, 0.f));
            const float u2 = fmix_lo(S2, cur.q2.y, fmix_lo(vi, cur.q1.y, 0.f)), u3 = fmix_hi(S3, cur.q2.y, fmix_hi(vi, cur.q1.y, 0.f));
            const float sk = VAR == 1 ? dot : red16(dot);
            S0 = fmixn_lo(sk, cur.q0.z, u0); S1 = fmixn_hi(sk, cur.q0.z, u1); S2 = fmixn_lo(sk, cur.q0.w, u2); S3 = fmixn_hi(sk, cur.q0.w, u3);
            { const float yv = fmix_hi(S1, cur.q1.z, fmix_lo(S0, cur.q1.z, 0.f)) + fmix_hi(S3, cur.q1.w, fmix_lo(S2, cur.q1.w, 0.f)); if (VAR == 3) { if (jj == SC_CHUNK - 1) yb[s * 512] = yv; else asm volatile("" :: "v"(yv)); } else yb[s * 512] = yv; }
        }
        if (cidx + 1 < SC_NCH && VAR != 4) SC_STORE((cb ^ 1) * SC_BUFB);
        if (VAR != 5) __syncthreads();
    }
    SC_FLUSH(SC_YOFF + ((SC_NCH & 1) ^ 1) * SC_YB, SC_T0(SC_NCH - 1));
    __syncthreads();
#undef SC_T0
#undef SC_LOAD
#undef SC_H4
#undef SC_STORE
#undef SC_RD
#undef SC_FLUSH
}
#ifndef PROBE_SCANVAR
#define PROBE_SCANVAR 0
#endif
__device__ __forceinline__ void phase_scan(const PArgs& a, LAS unsigned char* lds, int dummy) {
    for (int item = blockIdx.x; item < 256; item += gridDim.x) {
        const int half = item & 1, dir = (item >> 1) & 1, bh = item >> 2;
        if (dummy) { if (dir) scan_item<1, PROBE_SCANVAR>(a, lds, bh, half, 1); else scan_item<0, PROBE_SCANVAR>(a, lds, bh, half, 1); }
        else { if (dir) scan_item<1, 0>(a, lds, bh, half, 0); else scan_item<0, 0>(a, lds, bh, half, 0); }
    }
}

constexpr int RING_D = 4, RING_FLAGS = 2 * RING_D * 13568;
__device__ __forceinline__ void scan_serial_wave(const PArgs& a, int bh, int dir, int it, int lane, LAS unsigned char* ring, volatile LAS int* flg) {
    unsigned char* ws = a.ws();
    const int l31 = lane & 31, hi = lane >> 5;
    GAS float* gY = (GAS float*)(ws + WS_WKV + (size_t)dir * 32 * MiB) + (size_t)bh * SEQ * 64 + 32 * it + l31;
    f32x16 ST0 = f32x16{}, ST1 = f32x16{};
#define SS_ISSUE(P, cc) do { { unsigned _sp = 0; while (flg[0] <= (cc) && ++_sp < 2000000u) __builtin_amdgcn_s_sleep(1); } asm volatile("" ::: "memory"); \
        const LAS unsigned char* _r = ring + ((cc) & (RING_D - 1)) * 13568 + lane * 16; \
        _Pragma("unroll") for (int _k = 0; _k < 5; ++_k) P##aop[_k] = *(const LAS bf16x8*)(_r + REC_AOP + _k * 1024); \
        P##vt = *(const LAS bf16x8*)(_r + REC_VT + it * 1024); \
        _Pragma("unroll") for (int _k = 0; _k < 2; ++_k) P##ay[_k] = *(const LAS bf16x8*)(_r + REC_AY + _k * 1024); \
        _Pragma("unroll") for (int _k = 0; _k < 4; ++_k) P##as[_k] = *(const LAS bf16x8*)(_r + REC_AS + _k * 1024); \
        __builtin_amdgcn_sched_barrier(0); } while (0)
#define SS_RELEASE(cc) do { asm volatile("s_waitcnt lgkmcnt(0)" ::: "memory"); __builtin_amdgcn_sched_barrier(0); \
        if (lane == 0) __hip_atomic_fetch_add((LAS int*)&flg[4 + ((cc) & (RING_D - 1))], 1, __ATOMIC_RELAXED, __HIP_MEMORY_SCOPE_WORKGROUP); } while (0)
#define SS_BODY(P, cc) do { \
        f32x4 gc_[8]; { const LAS unsigned char* _g = ring + ((cc) & (RING_D - 1)) * 13568 + REC_GC + hi * 64; \
          _Pragma("unroll") for (int _k = 0; _k < 8; ++_k) gc_[_k] = *(const LAS f32x4*)(_g + ((_k >> 2) * 32 + (_k & 3) * 4) * 4); } \
        f32x16 UQ = f32x16{}; \
        { float f[8]; \
          _Pragma("unroll") for (int s_ = 0; s_ < 2; ++s_) { _Pragma("unroll") for (int jj = 0; jj < 8; ++jj) f[jj] = ST0[8 * s_ + jj]; \
            UQ = __builtin_amdgcn_mfma_f32_32x32x16_bf16(P##aop[s_], pack_frag(f), UQ, 0, 0, 0); } \
          _Pragma("unroll") for (int s_ = 0; s_ < 2; ++s_) { _Pragma("unroll") for (int jj = 0; jj < 8; ++jj) f[jj] = ST1[8 * s_ + jj]; \
            UQ = __builtin_amdgcn_mfma_f32_32x32x16_bf16(P##aop[2 + s_], pack_frag(f), UQ, 0, 0, 0); } } \
        UQ = __builtin_amdgcn_mfma_f32_32x32x16_bf16(P##aop[4], P##vt, UQ, 0, 0, 0); \
        bf16x8 Uf; { float f[8]; _Pragma("unroll") for (int jj = 0; jj < 8; ++jj) f[jj] = UQ[jj]; Uf = pack_frag(f); } \
        f32x16 Y = f32x16{}; \
        _Pragma("unroll") for (int r = 0; r < 8; ++r) Y[r] = UQ[8 + r]; \
        Y = __builtin_amdgcn_mfma_f32_32x32x16_bf16(P##ay[0], Uf, Y, 0, 0, 0); \
        Y = __builtin_amdgcn_mfma_f32_32x32x16_bf16(P##ay[1], P##vt, Y, 0, 0, 0); \
        _Pragma("unroll") for (int q = 0; q < 4; ++q) _Pragma("unroll") for (int e = 0; e < 4; ++e) { ST0[4 * q + e] *= gc_[q][e]; ST1[4 * q + e] *= gc_[4 + q][e]; } \
        ST0 = __builtin_amdgcn_mfma_f32_32x32x16_bf16(P##as[0], Uf, ST0, 0, 0, 0); ST0 = __builtin_amdgcn_mfma_f32_32x32x16_bf16(P##as[1], P##vt, ST0, 0, 0, 0); \
        ST1 = __builtin_amdgcn_mfma_f32_32x32x16_bf16(P##as[2], Uf, ST1, 0, 0, 0); ST1 = __builtin_amdgcn_mfma_f32_32x32x16_bf16(P##as[3], P##vt, ST1, 0, 0, 0); \
        _Pragma("unroll") for (int r = 0; r < 8; ++r) { const int t = 16 * (cc) + (r & 3) + 8 * (r >> 2) + 4 * hi; const int tt = dir ? SEQ - 1 - t : t; gY[(size_t)tt * 64] = Y[r]; } } while (0)
    bf16x8 A_aop[5], A_vt, A_ay[2], A_as[4];
    bf16x8 B_aop[5], B_vt, B_ay[2], B_as[4];
    SS_ISSUE(A_, 0);
#pragma unroll 1
    for (int c = 0; c < 128; c += 2) {
        SS_ISSUE(B_, c + 1);
        SS_BODY(A_, c);
        SS_RELEASE(c);
        if (c + 2 < 128) SS_ISSUE(A_, c + 2);
        SS_BODY(B_, c + 1);
        SS_RELEASE(c + 1);
    }
#undef SS_ISSUE
#undef SS_RELEASE
#undef SS_BODY

}

__device__ __forceinline__ void glds4(const void* gsrc, unsigned lds_dst) { unsigned keep;
    asm volatile("s_mov_b32 %0, m0\n\ts_mov_b32 m0, %2\n\ts_nop 0\n\tglobal_load_lds_dword %1, off\n\ts_mov_b32 m0, %0" : "=&s"(keep) : "v"(gsrc), "s"(lds_dst) : "memory"); }
__device__ __forceinline__ void scan_loader_wave(const PArgs& a, int bh, int dir, int lane, LAS unsigned char* ring, volatile LAS int* flg) {
    unsigned char* ws = a.ws();
    const unsigned char* rec0 = ws + WS_REC + (size_t)((bh * 2 + dir) * 128) * REC_BYTES;
    const unsigned ring0 = (unsigned)(uintptr_t)ring;
#pragma unroll 1
    for (int c = 0; c < 128; ++c) {
        const int slot = c & (RING_D - 1);
        if (c >= RING_D) { unsigned sp = 0; while (flg[4 + slot] < 2 * (c / RING_D) && ++sp < 2000000u) __builtin_amdgcn_s_sleep(1); }
        asm volatile("" ::: "memory");
        const unsigned char* r = rec0 + (size_t)c * REC_BYTES; const unsigned dst = (unsigned)__builtin_amdgcn_readfirstlane(ring0 + slot * 13568);
#pragma unroll
        for (int k = 0; k < 13; ++k) { const int off = k < 5 ? REC_AOP + k * 1024 : k < 7 ? REC_AY + (k - 5) * 1024 : k < 11 ? REC_AS + (k - 7) * 1024 : REC_VT + (k - 11) * 1024;
            attn_body::glds16(r + off + lane * 16, dst + off); }
        glds4(r + REC_GC + lane * 4, dst + REC_GC);
        asm volatile("s_waitcnt vmcnt(14)" ::: "memory");
        if (lane == 0) flg[0] = c;
    }
    asm volatile("s_waitcnt vmcnt(0)" ::: "memory");
    if (lane == 0) flg[0] = 128;
}

constexpr int AQ_LDS = 100000;
__device__ __forceinline__ void rwkv_post(const PArgs& a, int l, int hv0, int nhv, int wave, int lane) {
    unsigned char* ws = a.ws();
    const int sub = lane >> 4, c4 = lane & 15;
    bf16_t* MIX = (bf16_t*)(ws + WS_MIX);
    for (int it = wave; it < nhv / 4; it += NWAVES) {
        const size_t hv = (size_t)hv0 + (size_t)it * 4 + sub; const size_t o = hv * 64 + 4 * c4;
        const f32x4 f = *(const GAS f32x4*)((const float*)(ws + WS_WKV) + o), bk = *(const GAS f32x4*)((const float*)(ws + WS_WKV + 32 * MiB) + o);
        float g4[4], bo[4]; unpack4(*(const GAS u32x2*)((const bf16_t*)(ws + WS_G) + o), g4); unpack4(*(const GAS u32x2*)((const bf16_t*)(ws + WS_V) + o), bo);
        { const float bs = ((const GAS float*)(ws + WS_BON))[hv];
#pragma unroll
          for (int e = 0; e < 4; ++e) bo[e] *= bs; }
        const f32x4 x = f + bk;
        const float mean = red16((x[0] + x[1]) + (x[2] + x[3])) * (1.f / 64.f);
        const f32x4 d = x - mean;
        const float var = red16((d[0] * d[0] + d[1] * d[1]) + (d[2] * d[2] + d[3] * d[3])) * (1.f / 64.f);
        const float rs = rsqrtf(var + GN_EPS);
        const int bh = (int)(hv / SEQ), t = (int)(hv % SEQ), bb = bh >> 2, hh = bh & 3, c = 64 * hh + 4 * c4;
        const f32x4 gg = *(const GAS f32x4*)(a.in(I_GNG) + l * 256 + c), gb = *(const GAS f32x4*)(a.in(I_GNB) + l * 256 + c);
        float y[4];
#pragma unroll
        for (int e = 0; e < 4; ++e) y[e] = (d[e] * rs * gg[e] + gb[e] + bo[e]) * g4[e];
        u32x2 ov; ov.x = cvtpk(y[0], y[1]); ov.y = cvtpk(y[2], y[3]);
        *(GAS u32x2*)(MIX + ((size_t)bb * SEQ + t) * DM + 256 + c) = ov;
    }
}
__device__ __forceinline__ void phase_attn_post(const PArgs& a, unsigned char* lds_generic, int l, int bx) {
    unsigned char* ws = a.ws();
    int tid_ = threadIdx.x; asm volatile("" : "+v"(tid_)); const int tid = tid_, lane = tid & 63, wave = __builtin_amdgcn_readfirstlane(tid >> 6);
    if (bx < 64) {
        LAS unsigned char* L = (LAS unsigned char*)lds_generic; volatile LAS int* flags = (volatile LAS int*)(L + RING_FLAGS);
        if (tid < 16) flags[tid] = 0;
        __syncthreads();
        if (wave < 4) scan_serial_wave(a, bx, wave >> 1, wave & 1, lane, L + (wave >> 1) * RING_D * 13568, flags + (wave >> 1) * 8);
        else if (wave < 6) scan_loader_wave(a, bx, wave - 4, lane, L + (wave - 4) * RING_D * 13568, flags + (wave - 4) * 8);
        asm volatile("s_waitcnt vmcnt(0)" ::: "memory");
        __syncthreads();
        rwkv_post(a, l, bx * SEQ, SEQ, wave, lane);
    }
    const attn_body::bf16* PROJ = (const attn_body::bf16*)(ws + WS_PROJ); attn_body::bf16* MIXO = (attn_body::bf16*)(ws + WS_MIX) + 512;
    unsigned* qhead = (unsigned*)(ws + WS_CTL) + CW_AQ + l * 64;
    volatile LAS unsigned* slot = (volatile LAS unsigned*)((LAS unsigned char*)lds_generic + AQ_LDS);
    for (;;) {
        if (tid == 0) *slot = __hip_atomic_fetch_add(qhead, 1u, __ATOMIC_RELAXED, __HIP_MEMORY_SCOPE_AGENT);
        __syncthreads();
        const int uidx = (int)__builtin_amdgcn_readfirstlane(*slot);
        __syncthreads();
        if (uidx >= 1024) break;
        const int grp = uidx >> 5, u = uidx & 31, b = grp >> 1, kvh = grp & 1, h = kvh * 4 + (u >> 3), qb = u & 7;
        attn_body::attn_unit<8>(b, h, kvh, qb, PROJ + C_Q, PROJ + C_K, PROJ + C_V, MIXO, (char*)lds_generic);
    }
}

constexpr int RT_LOG = 0, RT_INFO = 8 * 16 * 48 * 4;
__device__ __forceinline__ void phase_ln1_router(const PArgs& a, LAS unsigned char* lds, int l, int dry, int grank, const unsigned* pcnt) {
    unsigned char* ws = a.ws();
    int tid_ = threadIdx.x; asm volatile("" : "+v"(tid_)); const int tid = tid_, lane = tid & 63, wave = __builtin_amdgcn_readfirstlane(tid >> 6);
    const float* Z = (const float*)(ws + WS_Z); bf16_t* XN = (bf16_t*)(ws + WS_XN); float* STAT = (float*)(ws + WS_STAT);
    LAS float* LOGT = (LAS float*)(lds + RT_LOG) + wave * 16 * 48;
    LAS int* inf_e = (LAS int*)(lds + RT_INFO); LAS int* inf_r = inf_e + 256; LAS float* inf_g = (LAS float*)(inf_r + 256); LAS int* lcnt = (LAS int*)(inf_g + 256); LAS int* lbase = lcnt + 32;
    if (tid < 32) lcnt[tid] = 0;
    __syncthreads();
    unsigned* gcnt = (unsigned*)(ws + WS_CTL) + CW_CNT + l * 64;
    GAS int* list = (GAS int*)(ws + WS_LIST); GAS float* gate = (GAS float*)(ws + WS_GLIST);
    const bf16_t* RWH = (const bf16_t*)(ws + WS_RWB) + (size_t)l * 2 * 48 * 1024; const bf16_t* RWL = RWH + 48 * 1024;
    const float* lng = a.in(I_LN1G) + l * DM; const float* lnb = a.in(I_LN1B) + l * DM;
    for (int chunk = grank; chunk < NTOK / 128; chunk += gridDim.x) {
        const int tb = chunk * 128, tw = tb + wave * 16;
        if (pcnt) wait_count(pcnt + 16 * (chunk >> 1), 32u, (unsigned*)(ws + WS_CTL) + 8);
        float mymean = 0.f, myrstd = 0.f;
        { f32x4 lg[4], lb[4];
#pragma unroll
          for (int j = 0; j < 4; ++j) { lg[j] = *(const GAS f32x4*)(lng + 4 * lane + 256 * j); lb[j] = *(const GAS f32x4*)(lnb + 4 * lane + 256 * j); }
#pragma unroll 1
          for (int rd = 0; rd < 4; ++rd) {
            f32x4 x[4][4];
#pragma unroll
            for (int tk = 0; tk < 4; ++tk)
#pragma unroll
                for (int j = 0; j < 4; ++j) x[tk][j] = *(const GAS f32x4*)(Z + (size_t)(tw + rd * 4 + tk) * DM + 4 * lane + 256 * j);
#pragma unroll
            for (int tk = 0; tk < 4; ++tk) { const int tl = rd * 4 + tk; float s = 0.f;
#pragma unroll
                for (int j = 0; j < 4; ++j) s += (x[tk][j][0] + x[tk][j][1]) + (x[tk][j][2] + x[tk][j][3]);
                const float mean = wave_sum(s) * (1.f / DM); float s2 = 0.f;
#pragma unroll
                for (int j = 0; j < 4; ++j) { x[tk][j] = x[tk][j] - mean; s2 += (x[tk][j][0] * x[tk][j][0] + x[tk][j][1] * x[tk][j][1]) + (x[tk][j][2] * x[tk][j][2] + x[tk][j][3] * x[tk][j][3]); }
                const float rstd = rsqrtf(wave_sum(s2) * (1.f / DM) + LN_EPS);
                if ((lane & 15) == tl) { mymean = mean; myrstd = rstd; }
                if (lane == 0 && !dry) *(GAS f32x2*)(STAT + 2 * (size_t)(tw + tl)) = (f32x2){mean, rstd};
                bf16_t* xr = XN + (size_t)(tw + tl) * DM;
#pragma unroll
                for (int j = 0; j < 4; ++j) { const f32x4 v = x[tk][j] * rstd * lg[j] + lb[j];
                    u32x2 o; o.x = cvtpk(v[0], v[1]); o.y = cvtpk(v[2], v[3]); if (!dry) *(GAS u32x2*)(xr + 4 * lane + 256 * j) = o; } }
          } }
        { const int tk = lane & 15, kg = lane >> 4;
          const float* zr = Z + (size_t)(tw + tk) * DM + 8 * kg;
          f32x4 acc[3] = {f32x4{0.f, 0.f, 0.f, 0.f}, f32x4{0.f, 0.f, 0.f, 0.f}, f32x4{0.f, 0.f, 0.f, 0.f}};
#pragma unroll 4
          for (int s_ = 0; s_ < 32; ++s_) {
              const f32x4 z0 = *(const GAS f32x4*)(zr + 32 * s_), z1 = *(const GAS f32x4*)(zr + 32 * s_ + 4);
              float xv[8], xl[8];
#pragma unroll
              for (int e = 0; e < 4; ++e) { xv[e] = (z0[e] - mymean) * myrstd; xv[4 + e] = (z1[e] - mymean) * myrstd; }
              u32x4 ph; ph.x = cvtpk(xv[0], xv[1]); ph.y = cvtpk(xv[2], xv[3]); ph.z = cvtpk(xv[4], xv[5]); ph.w = cvtpk(xv[6], xv[7]);
              xl[0] = xv[0] - bflo(ph.x); xl[1] = xv[1] - bfhi(ph.x); xl[2] = xv[2] - bflo(ph.y); xl[3] = xv[3] - bfhi(ph.y);
              xl[4] = xv[4] - bflo(ph.z); xl[5] = xv[5] - bfhi(ph.z); xl[6] = xv[6] - bflo(ph.w); xl[7] = xv[7] - bfhi(ph.w);
              const bf16x8 Ah = __builtin_bit_cast(bf16x8, ph), Al = pack_frag(xl);
#pragma unroll
              for (int nb = 0; nb < 3; ++nb) { const size_t wo = (size_t)(16 * nb + tk) * 1024 + 32 * s_ + 8 * kg;
                  const bf16x8 Bh = *(const GAS bf16x8*)(RWH + wo), Bl = *(const GAS bf16x8*)(RWL + wo);
                  acc[nb] = __builtin_amdgcn_mfma_f32_16x16x32_bf16(Ah, Bh, acc[nb], 0, 0, 0);
                  acc[nb] = __builtin_amdgcn_mfma_f32_16x16x32_bf16(Ah, Bl, acc[nb], 0, 0, 0);
                  acc[nb] = __builtin_amdgcn_mfma_f32_16x16x32_bf16(Al, Bh, acc[nb], 0, 0, 0); } }
#pragma unroll
          for (int nb = 0; nb < 3; ++nb)
#pragma unroll
              for (int r = 0; r < 4; ++r) LOGT[(4 * kg + r) * 48 + 16 * nb + tk] = acc[nb][r]; }
        asm volatile("s_waitcnt lgkmcnt(0)" ::: "memory");
        if (lane < 16) {
            const LAS float* lt = LOGT + lane * 48;
            float gl[4];
#pragma unroll
            for (int g = 0; g < 4; ++g) gl[g] = lt[32 + g] + ((const GAS float*)a.in(I_RGB))[l * 4 + g] + ((const GAS float*)(ws + WS_RB))[l * 48 + 32 + g];
            int grp = 0; float gm = gl[0];
#pragma unroll
            for (int g = 1; g < 4; ++g) if (gl[g] > gm) { gm = gl[g]; grp = g; }
            float den = 0.f;
#pragma unroll
            for (int g = 0; g < 4; ++g) den += __expf(gl[g] - gm);
            const float gwt = 1.f / den;
            float el[8];
#pragma unroll
            for (int j = 0; j < 8; ++j) el[j] = lt[grp * 8 + j] + ((const GAS float*)a.in(I_REB))[l * 32 + grp * 8 + j] + ((const GAS float*)(ws + WS_RB))[l * 48 + grp * 8 + j];
            int i1 = 0; float v1 = el[0];
#pragma unroll
            for (int j = 1; j < 8; ++j) if (el[j] > v1) { v1 = el[j]; i1 = j; }
            int i2 = -1; float v2 = -INFINITY;
#pragma unroll
            for (int j = 0; j < 8; ++j) if (j != i1 && el[j] > v2) { v2 = el[j]; i2 = j; }
            const float e2 = __expf(v2 - v1), g1 = gwt / (1.f + e2), g2 = gwt * e2 / (1.f + e2);
            const int p = (wave * 16 + lane) * 2, ea = grp * 8 + i1, eb = grp * 8 + i2;
            inf_e[p] = ea; inf_g[p] = g1; inf_r[p] = atomicAdd((int*)&lcnt[ea], 1);
            inf_e[p + 1] = eb; inf_g[p + 1] = g2; inf_r[p + 1] = atomicAdd((int*)&lcnt[eb], 1);
        }
        __syncthreads();
        if (tid < 32) { const int n = lcnt[tid]; lbase[tid] = (n && !dry) ? (int)atomicAdd(gcnt + tid, (unsigned)n) : 0; lcnt[tid] = 0; }
        __syncthreads();
        if (tid < 256 && !dry) { const int e = inf_e[tid], pos = lbase[e] + inf_r[tid], pair = tb * 2 + tid;
            list[e * LISTCAP + pos] = pair; gate[e * LISTCAP + pos] = inf_g[tid]; }
        __syncthreads();
    }
}

__device__ __forceinline__ int moe_build_tab(const PArgs& a, LAS unsigned char* lds, int l) {
    LAS int* tab = (LAS int*)(lds + MOE_TAB_OFF);
    const unsigned* gcnt = (const unsigned*)(a.ws() + WS_CTL) + CW_CNT + l * 64;
    int tid_ = threadIdx.x; asm volatile("" : "+v"(tid_)); const int tid = tid_;
    if (tid < 64) {
        const int cnt = tid < 32 ? (int)__hip_atomic_load(gcnt + (tid & 31), __ATOMIC_RELAXED, __HIP_MEMORY_SCOPE_AGENT) : 0;
        const int nt = (cnt + 255) >> 8; int inc = nt;
#pragma unroll
        for (int d = 1; d < 32; d <<= 1) { const int o = __shfl_up(inc, d); if (tid >= d) inc += o; }
        const int ts = inc - nt;
        if (tid < 32) { tab[64 + tid] = cnt; tab[tid] = ts; for (int k = 0; k < nt; ++k) tab[128 + ts + k] = tid; if (tid == 31) tab[32] = inc; } }
    __syncthreads();
    return tab[32];
}

__device__ __forceinline__ void phase_ln2(const PArgs& a, int l, int grank, int G, int dry, unsigned* pcnt) {
    unsigned char* ws = a.ws();
    int tid_ = threadIdx.x; asm volatile("" : "+v"(tid_)); const int tid = tid_, lane = tid & 63, wave = __builtin_amdgcn_readfirstlane(tid >> 6);
    float* X = a.out(); bf16_t* XN = (bf16_t*)(ws + WS_XN); const bf16_t* Y = (const bf16_t*)(ws + WS_Y);
    const bool last = (l + 1 == DEPTH);
    f32x4 lg[4], lb[4];
#pragma unroll
    for (int j = 0; j < 4; ++j) { lg[j] = *(const GAS f32x4*)(a.in(I_LN2G) + l * DM + 4 * lane + 256 * j); lb[j] = *(const GAS f32x4*)(a.in(I_LN2B) + l * DM + 4 * lane + 256 * j); }
    for (int chunk = grank; chunk < NTOK / 128; chunk += G) {
    for (int ti = 0; ti < 16; ti += 2) {
        f32x4 x[2][4]; float s[2] = {0.f, 0.f};
#pragma unroll
        for (int u = 0; u < 2; ++u) { const int tok = chunk * 128 + wave + 8 * (ti + u);
            const bf16_t* xr = XN + (size_t)tok * DM; const bf16_t* y0 = Y + (size_t)(2 * tok) * DM; const bf16_t* y1 = y0 + DM;
#pragma unroll
            for (int j = 0; j < 4; ++j) { float xv[4], ya[4], yb[4]; unpack4(*(const GAS u32x2*)(xr + 4 * lane + 256 * j), xv);
                unpack4(*(const GAS u32x2*)(y0 + 4 * lane + 256 * j), ya); unpack4(*(const GAS u32x2*)(y1 + 4 * lane + 256 * j), yb);
#pragma unroll
                for (int e = 0; e < 4; ++e) x[u][j][e] = ALPHA * xv[e] + (ya[e] + yb[e]);
                s[u] += (x[u][j][0] + x[u][j][1]) + (x[u][j][2] + x[u][j][3]); } }
#pragma unroll
        for (int u = 0; u < 2; ++u) { const int tok = chunk * 128 + wave + 8 * (ti + u);
            float* row = X + (size_t)tok * DM; bf16_t* xr = XN + (size_t)tok * DM;
            const float mean = wave_sum(s[u]) * (1.f / DM); float s2 = 0.f;
#pragma unroll
            for (int j = 0; j < 4; ++j) { x[u][j] = x[u][j] - mean; s2 += (x[u][j][0] * x[u][j][0] + x[u][j][1] * x[u][j][1]) + (x[u][j][2] * x[u][j][2] + x[u][j][3] * x[u][j][3]); }
            const float rstd = rsqrtf(wave_sum(s2) * (1.f / DM) + LN_EPS);
#pragma unroll
            for (int j = 0; j < 4; ++j) { x[u][j] = x[u][j] * rstd * lg[j] + lb[j]; if (!dry) { if (last) *(GAS f32x4*)(row + 4 * lane + 256 * j) = x[u][j];
                else { u32x2 o; o.x = cvtpk(x[u][j][0], x[u][j][1]); o.y = cvtpk(x[u][j][2], x[u][j][3]); *(GAS u32x2*)(xr + 4 * lane + 256 * j) = o; } } } }
    }
        if (pcnt) { asm volatile("s_waitcnt vmcnt(0)" ::: "memory");
            if (lane == 0) __hip_atomic_fetch_add(pcnt + 16 * (chunk >> 1), 1u, __ATOMIC_RELAXED, __HIP_MEMORY_SCOPE_AGENT); }
    }
}

constexpr int NPH_L = 8, NPHASE = 1 + DEPTH * NPH_L;
__global__ void __launch_bounds__(NTHR, 2) hyb_fwd(Args args) {
    extern __shared__ __attribute__((aligned(16))) unsigned char lds_raw[];
    LAS unsigned char* lds = (LAS unsigned char*)lds_raw;
    const int tid = threadIdx.x;
    const int G = gridDim.x; const int bx = blockIdx.x; const int vcu = (G % 8 == 0) ? (bx % 8) * (G / 8) + bx / 8 : bx;
    unsigned char* ws = (unsigned char*)(GAS unsigned char*)args.ws;
    volatile LAS unsigned* st = (volatile LAS unsigned*)(lds + LDSCTL_OFF);
    if (tid < 64) st[tid] = 0u;
    __syncthreads();
    XcdBarrier bar; bar.bar = (unsigned*)(ws + WS_CTL) + CW_BAR; bar.x = 0; bar.st = st;
    if (!args.multi) bar = xcd_barrier_post((unsigned*)(ws + WS_CTL) + CW_BAR, st);
    int ph0 = args.ph_lo;
    if (ph0 == 0) {
        PArgs pa; pa.kp = (kptr_t)__builtin_amdgcn_kernarg_segment_ptr(); pa.ws_ = args.ws; pa.out_ = args.out;
        if (PHMASK & 1) phase_prologue(pa, lds, vcu, G);
        if (PROBE_DUP & 512) { cg::this_grid().sync(); phase_prologue(pa, lds, vcu, G); }
        ph0 = 1;
        if (ph0 < args.ph_hi) cg::this_grid().sync();
    }
    if (tid == 0) {
        if (args.multi) { st[2] = (unsigned)bx; st[3] = 0u; st[4] = (unsigned)G; }
        else { unsigned P = 0, n = 1;
            unsigned std_ = 1u;
            for (unsigned j = 0; j < 16; ++j) { const unsigned cj = xb_ld(bar.bar + XB_XCNT(j)); P += (j < bar.x) ? cj : 0u; n = (j == bar.x) ? cj : n; std_ &= (cj == (j < 8u ? 32u : 0u)) ? 1u : 0u; }
            st[3] = P; st[4] = n;
            st[5] = (G == 256) ? std_ : 0u; } }
    __syncthreads();
    for (int ph = ph0; ph < args.ph_hi; ++ph) {
        const int kq = (ph - 1) % NPH_L; const bool xl = !args.multi && st[5] != 0u;
        if (ph > ph0 && !(kq == 6 && !args.multi && !PROBE_KEEPBAR) && !(xl && (HANDOFF_SEAMS >> kq & 1))) {
            if (MK_ALLCG) cg::this_grid().sync(); else xcd_barrier(bar);
        }
#if PROBE_X == 5
        _Pragma("unroll 1") for (int q_ = 0; q_ < 4; ++q_) xcd_barrier(bar);
#endif
        PArgs pa; pa.kp = (kptr_t)__builtin_amdgcn_kernarg_segment_ptr(); asm volatile("" : "+s"(pa.kp)); pa.ws_ = args.ws; pa.out_ = args.out; asm volatile("" : "+s"(pa.ws_), "+s"(pa.out_));
        const int l = (ph - 1) / NPH_L, k = (ph - 1) % NPH_L;
        unsigned char* pws = pa.ws();
        const int nrep = ((PROBE_DUP >> k) & 1) ? 2 : 1;
        for (int rep = 0; rep < nrep; ++rep) {
        if (rep) xcd_barrier(bar);
        if (k == 0 && (PHMASK & 2)) {
            __syncthreads();
            pg8::XDenseOrder S; S.init_xcd(NTOK / 256, INP / 256, G, st); S.Bt = (const char*)(pws + WS_WIN + (size_t)l * 4 * MiB); S.Kb = DM * 2;
            if (l > 0 && !args.multi) { S.pcnt = (const unsigned*)(pws + WS_CTL) + CW_PAN + ((l - 1) * 4 + 1) * 2048; S.need = 16u; S.tmo = (unsigned*)(pws + WS_CTL) + 8; }
            pg8::EpiProj E{(bf16_t*)(pws + WS_PROJ), INP, (unsigned*)(pws + WS_CTL) + CW_PAN + (l * 4 + 2) * 2048};
            pg8::gemm_phase(lds, (const char*)(pws + WS_XN), DM, S, E);
        } else if (k == 1 && (PHMASK & 4)) {
#if PROBE_X == 6
            phase_prep(pa, lds, l, 4, PT_I0, PT_IHI, PT_STEP, nullptr); xcd_barrier(bar);
#endif
#if PROBE_P2
            phase_prep(pa, lds, l, PROBE_P2, PT_I0, PT_IHI, PT_STEP, nullptr); xcd_barrier(bar);
#endif
#if PROBE_X >= 8
            phase_prep(pa, lds, l, PROBE_X - 2, PT_I0, PT_IHI, PT_STEP, nullptr); xcd_barrier(bar);
#endif
            phase_prep(pa, lds, l, 0, PT_I0, PT_IHI, PT_STEP, args.multi ? nullptr : (const unsigned*)(pws + WS_CTL) + CW_PAN + (l * 4 + 2) * 2048);
#if PROBE_X == 7
            xcd_barrier(bar); phase_prep(pa, lds, l, 5, PT_I0, PT_IHI, PT_STEP, nullptr);
#endif
        } else if (k == 2 && (PHMASK & 16)) { phase_attn_post(pa, lds_raw, l, bx);
#if PROBE_X == 2
            xcd_barrier(bar); phase_attn_post(pa, lds_raw, l, bx);
#endif
        } else if (k == 3 && (PHMASK & 32)) {
            pg8::XDenseOrder S; S.init_xcd(NTOK / 256, DM / 256, G, st); S.Bt = (const char*)(pws + WS_WO + (size_t)l * 2 * MiB); S.Kb = DM * 2;
            pg8::EpiRes E{(const bf16_t*)(pws + WS_XN), (float*)(pws + WS_Z), nrep == 2 && rep == 0, (unsigned*)(pws + WS_CTL) + CW_PAN + (l * 4 + 0) * 2048};
            pg8::gemm_phase(lds, (const char*)(pws + WS_MIX), DM, S, E);
        } else if (k == 4 && (PHMASK & 64)) {
#if PROBE_X == 3
            phase_ln1_router(pa, lds, l, 1, (int)(st[2] + st[3]), nullptr); xcd_barrier(bar);
#endif
#if PROBE_X == 4
            phase_ln2(pa, l, vcu, G, 1, nullptr); xcd_barrier(bar);
#endif
            phase_ln1_router(pa, lds, l, 0, (int)(st[2] + st[3]), args.multi ? nullptr : (const unsigned*)(pws + WS_CTL) + CW_PAN + (l * 4 + 0) * 2048);
        } else if (k == 5 && (PHMASK & 128)) {
            const int T = moe_build_tab(pa, lds, l);
            pg8::MoeOrder S; S.tab = (const LAS int*)(lds + MOE_TAB_OFF); S.list = (const GAS int*)(pws + WS_LIST);
            S.wbase = (const char*)(pws + WS_WGU); S.wstride = (size_t)1024 * DM * 2; S.Kb = DM * 2; S.gather = 1;
            const bool ho = !args.multi && !PROBE_KEEPBAR;
            S.init_xcd(T, G, st);
            pg8::EpiMoe1 E{(bf16_t*)(pws + WS_H), ho ? (unsigned*)(pws + WS_CTL) + CW_MH + l * 18432 : nullptr};
            pg8::gemm_phase(lds, (const char*)(pws + WS_XN), DM, S, E);
        } else if (k == 6 && (PHMASK & 256)) {
            const int T = (!args.multi && !PROBE_KEEPBAR) ? ((const LAS int*)(lds + MOE_TAB_OFF))[32] : moe_build_tab(pa, lds, l);
            pg8::MoeOrder S; S.tab = (const LAS int*)(lds + MOE_TAB_OFF); S.list = (const GAS int*)(pws + WS_LIST);
            S.wbase = (const char*)(pws + WS_WD); S.wstride = (size_t)DM * EH * 2; S.Kb = EH * 2; S.gather = 0;
            S.init_xcd(T, G, st);
            if (!args.multi && !PROBE_KEEPBAR) { S.rank = S.nloc - 1 - S.rank;
                S.hcnt = (const unsigned*)(pws + WS_CTL) + CW_MH + l * 18432; S.tmo = (unsigned*)(pws + WS_CTL) + 8; }
            pg8::EpiMoe2 E{(bf16_t*)(pws + WS_Y), (const LAS int*)(lds + MOE_TAB_OFF), (const GAS int*)(pws + WS_LIST), (const GAS float*)(pws + WS_GLIST)};
            pg8::gemm_phase(lds, (const char*)(pws + WS_H), EH, S, E);
        } else if (k == 7 && (PHMASK & 512)) { phase_ln2(pa, l, (int)(st[2] + st[3]), G, nrep == 2 && rep == 0, (args.multi || l + 1 >= DEPTH) ? nullptr : (unsigned*)(pws + WS_CTL) + CW_PAN + (l * 4 + 1) * 2048); if (l + 1 < DEPTH) convert_layer_weights(pa, lds, l + 1, vcu, G, 2); }
        }
    }
}

extern "C" void kernel_launch(void* const* d_in, const int* in_sizes, int n_in, void* d_out, int out_size, void* d_ws, size_t ws_size, hipStream_t stream) {
    static int grid = 0;
    if (grid == 0) {
        if (n_in != 30 || out_size != NTOK * DM || ws_size < WS_END) { fprintf(stderr, "kernel_launch: unexpected shapes (n_in %d, out %d, ws %zu)\n", n_in, out_size, ws_size); grid = -1; return; }
        int dev = 0, cus = 0, per_cu = 0;
        hipGetDevice(&dev); hipDeviceGetAttribute(&cus, hipDeviceAttributeMultiprocessorCount, dev);
        if (hipFuncSetAttribute((const void*)hyb_fwd, hipFuncAttributeMaxDynamicSharedMemorySize, LDS_BYTES) != hipSuccess) { fprintf(stderr, "kernel_launch: hipFuncSetAttribute failed\n"); grid = -1; return; }
        if (hipOccupancyMaxActiveBlocksPerMultiprocessor(&per_cu, (const void*)hyb_fwd, NTHR, LDS_BYTES) != hipSuccess || per_cu < 1) { fprintf(stderr, "kernel_launch: occupancy query says %d\n", per_cu); per_cu = 1; }
        (void)hipGetLastError();
        grid = cus * 1;
        fprintf(stderr, "kernel_launch: %d CUs, occupancy %d, grid %d\n", cus, per_cu, grid);
    }
    if (grid < 0) return;
    hipMemsetAsync((char*)d_ws + WS_CTL, 0, CTL_ZERO_BYTES, stream);
    Args a{};
    for (int i = 0; i < 30; ++i) a.in[i] = (const float*)d_in[i];
    a.out = (float*)d_out; a.ws = (unsigned char*)d_ws;
#if MK_MULTI
    a.multi = 1;
    for (int ph = 0; ph < NPHASE; ++ph) { a.ph_lo = ph; a.ph_hi = ph + 1; hipLaunchKernelGGL(hyb_fwd, dim3(grid), dim3(NTHR), LDS_BYTES, stream, a); }
#else
    a.multi = 0; a.ph_lo = 0; a.ph_hi = NPHASE;
    void* kargs[] = {&a};
    hipError_t e = hipLaunchCooperativeKernel((const void*)hyb_fwd, dim3(grid), dim3(NTHR), kargs, LDS_BYTES, stream);
    if (e != hipSuccess) fprintf(stderr, "cooperative launch failed: %s (grid %d)\n", hipGetErrorString(e), grid);
#endif
}
```

```cpp
#include <hip/hip_runtime.h>
#include <hip/hip_cooperative_groups.h>
#include <hip/hip_bf16.h>
#include <cstdio>
#include <cstdint>
namespace cg = cooperative_groups;

#ifndef MK_MULTI
#define MK_MULTI 0
#endif
#ifndef PROBE_DUP
#define PROBE_DUP 0
#endif
#ifndef PROBE_PREPDRY
#define PROBE_PREPDRY 1
#endif
#ifndef PROBE_X
#define PROBE_X 0
#endif
#ifndef PHMASK
#define PHMASK 1023
#endif
#ifndef MK_ALLCG
#define MK_ALLCG 0
#endif

#define GAS __attribute__((address_space(1)))
#define LAS __attribute__((address_space(3)))
typedef unsigned short bf16_t;
typedef short bf16x8 __attribute__((ext_vector_type(8)));
typedef float f32x4 __attribute__((ext_vector_type(4)));
typedef float f32x2 __attribute__((ext_vector_type(2)));
typedef float f32x16 __attribute__((ext_vector_type(16)));
typedef unsigned u32x4 __attribute__((ext_vector_type(4)));
typedef unsigned u32x2 __attribute__((ext_vector_type(2)));
typedef __bf16 bf16x2_t __attribute__((ext_vector_type(2)));

constexpr int NB = 16, SEQ = 2048, DM = 1024, NTOK = NB * SEQ, DEPTH = 4;
constexpr int INW = 1984, INP = 2048;
constexpr int C_RW = 256, C_Q = 1216, C_K = 1728, C_V = 1856;
constexpr int NEXP = 32, EH = 512;
constexpr float ALPHA = 1.6817928305074290f;
constexpr float LN_EPS = 1e-5f, GN_EPS = 64e-5f, QK_EPS = 1e-6f;
constexpr float QSCALE = 0.125f * 1.4426950408889634f;
constexpr int NWAVES = 8, NTHR = 512;
constexpr int LDS_BYTES = 163840;
constexpr int LISTCAP = 32768;

constexpr size_t MiB = 1u << 20;
constexpr size_t WS_CTL = 0, CTL_ZERO_BYTES = 1 * MiB;
constexpr size_t WS_SMALL = 1 * MiB;
constexpr size_t WS_WGU = 10 * MiB, WS_WD = 74 * MiB;
constexpr size_t WS_WIN = 983 * MiB  , WS_WO = 999 * MiB  ;
constexpr size_t WS_REC = 106 * MiB;
constexpr size_t WS_XN = 320 * MiB, WS_MIX = 384 * MiB, WS_PROJ = 448 * MiB;
constexpr size_t WS_R = 576 * MiB, WS_V = 592 * MiB, WS_KK = 608 * MiB, WS_KH = 624 * MiB  , WS_B = 656 * MiB  ;
constexpr size_t WS_G = 688 * MiB, WS_BON = 704 * MiB, WS_W = 720 * MiB  , WS_WKV = 784 * MiB  ;
constexpr size_t WS_FC0 = 608 * MiB  , WS_FC1 = 720 * MiB  ;
constexpr size_t WS_WH0 = 672 * MiB  , WS_WH1 = 576 * MiB  ;
constexpr size_t WS_LIST = 848 * MiB  , WS_GATE = 852 * MiB  ;
constexpr size_t WS_H = 106 * MiB  , WS_Y = 180 * MiB  ;
constexpr size_t WS_Z = 853 * MiB  , WS_STAT = 981 * MiB  , WS_RWB = 982 * MiB  ;
constexpr size_t WS_RB = 981 * MiB + 512 * 1024;
constexpr size_t WS_GLIST = 1007 * MiB;
constexpr size_t WS_END = 1014 * MiB;
constexpr size_t SM_ROPE = 0;
constexpr size_t SM_PWT = 16384;
constexpr size_t SM_WUPT = SM_PWT + 131072;
constexpr size_t SM_AUPT = SM_WUPT + 131072;
constexpr size_t SM_GUPT = SM_AUPT + 131072;
constexpr size_t SM_RWT = SM_GUPT + 131072;
static_assert(SM_RWT + 589824 <= 3 * MiB, "small region");
constexpr int CW_BAR = 4096;
constexpr int CW_CNT = 16384;
#define PT_I0 ((int)((unsigned)(NTOK / 64) * st[3] / (unsigned)G + st[2]))
#define PT_IHI ((int)((unsigned)(NTOK / 64) * (st[3] + st[4]) / (unsigned)G))
#define PT_STEP ((int)st[4])
#ifndef PROBE_P2
#define PROBE_P2 0
#endif
#ifndef HANDOFF_SEAMS
#define HANDOFF_SEAMS 0x13
#endif
#ifndef PROBE_KEEPBAR
#define PROBE_KEEPBAR 0
#endif
constexpr int CW_PAN = 122880;
constexpr int CW_MH = 49152;
constexpr int CW_AQ = 20480;

__device__ __forceinline__ unsigned cvtpk(float lo, float hi) { f32x2 v = {lo, hi}; bf16x2_t b = __builtin_convertvector(v, bf16x2_t); return __builtin_bit_cast(unsigned, b); }
__device__ __forceinline__ float bflo(unsigned w) { return __uint_as_float(w << 16); }
__device__ __forceinline__ float bfhi(unsigned w) { return __uint_as_float(w & 0xffff0000u); }
__device__ __forceinline__ float sigmoidf_(float x) { return __builtin_amdgcn_rcpf(1.f + __expf(-x)); }
#define DPP_ADD(v, ctrl) ((v) + __builtin_bit_cast(float, __builtin_amdgcn_update_dpp(0, __builtin_bit_cast(int, (v)), (ctrl), 0xF, 0xF, true)))
__device__ __forceinline__ float red16(float v) {
    v = DPP_ADD(v, 0xB1); v = DPP_ADD(v, 0x4E); v = DPP_ADD(v, 0x141); v = DPP_ADD(v, 0x140); return v;
}
__device__ __forceinline__ float wave_sum(float v) { v = red16(v); v += __shfl_xor(v, 16); v += __shfl_xor(v, 32); return v; }

__device__ __forceinline__ void wait_count(const unsigned* p, unsigned need, unsigned* tmo) {
    unsigned v, sp = 0;
    for (;;) {
        asm volatile("s_load_dword %0, %1, 0x0 glc\n\ts_waitcnt lgkmcnt(0)" : "=s"(v) : "s"(p) : "memory");
        if (v >= need) break;
        if (++sp > 4000000u) { if ((threadIdx.x & 63) == 0) __hip_atomic_store(tmo, 1u, __ATOMIC_RELAXED, __HIP_MEMORY_SCOPE_AGENT); break; }
        __builtin_amdgcn_s_sleep(2); }
}
namespace pg8 {
constexpr int BM = 256, BK = 64, HALF = 128, HTB = HALF * BK * 2, STAGE_BYTES = 8 * HTB, NXCD = 8, WGM = 8;
__device__ __forceinline__ int lds_byte(int r, int c) { const int st = (r >> 4) * 2 + (c >> 5), rr = r & 15, cc = c & 31, ob = rr * 64 + cc * 2; return st * 1024 + (ob ^ (((ob >> 9) & 1) << 5)); }
__device__ __forceinline__ void stage_rc(int b, int& R, int& C) { const int st = b / 1024, sb = b % 1024, swz = sb ^ (((sb >> 9) & 1) << 5); R = (st >> 1) * 16 + swz / 64; C = (st & 1) * 32 + (swz % 64) / 2; }
__device__ __forceinline__ int perm32(int rho) { const int n = rho >> 4, i = rho & 15; return 8 * (i >> 2) + 4 * n + (i & 3); }
struct Unit { int pm, pn; };

struct OrderBase {
    int nM, nN, nwg, G, c;
    __device__ __forceinline__ void init(int nM_, int nN_, int G_, int c_) { nM = nM_; nN = nN_; nwg = nM * nN; G = G_; c = c_; }
    __device__ __forceinline__ bool next(int i, Unit& u) const {
        const long L = (long)i * G + c; if (L >= nwg) return false;
        int wgid = (int)L; { const int q = nwg / NXCD, r = nwg % NXCD, xcd = wgid % NXCD, off = wgid / NXCD; wgid = (xcd < r ? xcd * (q + 1) : r * (q + 1) + (xcd - r) * q) + off; }
        const int nig = WGM * nN, gid = wgid / nig, fm = gid * WGM, gsz = (nM - fm) < WGM ? (nM - fm) : WGM;
        u.pm = fm + ((wgid % nig) % gsz); u.pn = (wgid % nig) / gsz; return true;
    }
    __device__ __forceinline__ void a_ready(const Unit&) const {}
};
struct DenseOrder : OrderBase {
    const char* Bt; int Kb;
    __device__ __forceinline__ unsigned arow(const Unit& u, int r) const { return (unsigned)(u.pm * BM + r); }
    __device__ __forceinline__ const char* bptr(const Unit& u) const { return Bt + (size_t)u.pn * BM * Kb; }
};
struct XDenseOrder {
    const char* Bt; int Kb; int nN, p0, pc, rank, nloc;
    const unsigned* pcnt = nullptr; unsigned need = 0; unsigned* tmo = nullptr;
    __device__ __forceinline__ void init_xcd(int nM, int nN_, int Gt, volatile LAS unsigned* st) {
        const unsigned P = st[3], n = st[4]; nN = nN_;
        p0 = (int)((unsigned)nM * P / (unsigned)Gt); pc = (int)((unsigned)nM * (P + n) / (unsigned)Gt) - p0; rank = (int)st[2]; nloc = (int)n;
    }
    __device__ __forceinline__ bool next(int i, Unit& u) const {
        const int j = rank + nloc * i; if (j >= pc * nN) return false;
        const int nig = 8 * nN, fm = (j / nig) * 8, gsz = (pc - fm) < 8 ? (pc - fm) : 8, jj = j % nig;
        u.pm = p0 + fm + jj % gsz; u.pn = jj / gsz; return true;
    }
    __device__ __forceinline__ unsigned arow(const Unit& u, int r) const { return (unsigned)(u.pm * BM + r); }
    __device__ __forceinline__ const char* bptr(const Unit& u) const { return Bt + (size_t)u.pn * BM * Kb; }
    __device__ __forceinline__ void a_ready(const Unit& u) const { if (pcnt) wait_count(pcnt + 16 * u.pm, need, tmo); }
};
struct MoeOrder {
    const LAS int* tab; const GAS int* list; const char* wbase; size_t wstride; int Kb; int gather;
    int t0, tcnt, rank, nloc;
    __device__ __forceinline__ void init_xcd(int T, int Gt, volatile LAS unsigned* st) {
        const unsigned P = st[3], n = st[4];
        t0 = (int)((unsigned)T * P / (unsigned)Gt); tcnt = (int)((unsigned)T * (P + n) / (unsigned)Gt) - t0; rank = (int)st[2]; nloc = (int)n;
    }
    __device__ __forceinline__ bool next(int i, Unit& u) const {
        const int j = rank + nloc * i; if (j >= tcnt * 4) return false;
        const int fm = (j >> 5) * 8, gsz = (tcnt - fm) < 8 ? (tcnt - fm) : 8;
        u.pm = t0 + fm + (j & 31) % gsz; u.pn = (j & 31) / gsz; return true;
    }
    const unsigned* hcnt = nullptr; unsigned* tmo = nullptr;
    __device__ __forceinline__ void a_ready(const Unit& u) const {
        if (!hcnt) return;
        const unsigned* p = hcnt + 64 * u.pm; unsigned v, sp = 0;
        for (;;) {
            asm volatile("s_load_dword %0, %1, 0x0 glc\n\ts_waitcnt lgkmcnt(0)" : "=s"(v) : "s"(p) : "memory");
            if (v >= 32u) break;
            if (++sp > 4000000u) { if ((threadIdx.x & 63) == 0) __hip_atomic_store(tmo, 1u, __ATOMIC_RELAXED, __HIP_MEMORY_SCOPE_AGENT); break; }
            __builtin_amdgcn_s_sleep(2); }
    }
    __device__ __forceinline__ unsigned arow(const Unit& u, int r) const {
        if (!gather) return (unsigned)(u.pm * BM + r);
        const int e = tab[128 + u.pm]; const int pos = (u.pm - tab[e]) * BM + r;
        return pos < tab[64 + e] ? (unsigned)(list[e * LISTCAP + pos] >> 1) : 0u;
    }
    __device__ __forceinline__ const char* bptr(const Unit& u) const { const int e = tab[128 + u.pm]; return wbase + (size_t)e * wstride + (size_t)u.pn * BM * Kb; }
};

struct EpiProj {
    static constexpr bool PERM = true;
    bf16_t* O; int ldc; unsigned* pcnt;
    __device__ __forceinline__ void publish(int pm) const { if ((threadIdx.x & 63) == 0) __hip_atomic_fetch_add(pcnt + 16 * pm, 1u, __ATOMIC_RELAXED, __HIP_MEMORY_SCOPE_AGENT); }
    __device__ __forceinline__ void operator()(const f32x4 (&acc)[2][2][4][2], const Unit& u, int wr, int wc, int fr, int fq) const {
        const int row0 = u.pm * BM + wr * 64 + fr, col0 = u.pn * BM + wc * 32 + 8 * fq;
#pragma unroll
        for (int ai = 0; ai < 2; ++ai)
#pragma unroll
            for (int m = 0; m < 4; ++m) { bf16_t* rowp = O + (size_t)(row0 + ai * HALF + m * 16) * ldc + col0;
#pragma unroll
                for (int bj = 0; bj < 2; ++bj) { const f32x4 v0 = acc[ai][bj][m][0], v1 = acc[ai][bj][m][1];
                    u32x4 w; w.x = cvtpk(v0[0], v0[1]); w.y = cvtpk(v0[2], v0[3]); w.z = cvtpk(v1[0], v1[1]); w.w = cvtpk(v1[2], v1[3]);
                    *(GAS u32x4*)(rowp + bj * HALF) = w; } }
    }
};
struct EpiRes {
    static constexpr bool PERM = false;
    const bf16_t* base; float* out; int dry; unsigned* pcnt;
    __device__ __forceinline__ void publish(int pm) const { if ((threadIdx.x & 63) == 0) __hip_atomic_fetch_add(pcnt + 16 * pm, 1u, __ATOMIC_RELAXED, __HIP_MEMORY_SCOPE_AGENT); }
    __device__ __forceinline__ void operator()(const f32x4 (&acc)[2][2][4][2], const Unit& u, int wr, int wc, int fr, int fq) const {
        const int row0 = u.pm * BM + wr * 64 + fr, col0 = u.pn * BM + wc * 32 + 4 * fq;
#pragma unroll
        for (int ai = 0; ai < 2; ++ai)
#pragma unroll
            for (int m = 0; m < 4; ++m) { const size_t off = (size_t)(row0 + ai * HALF + m * 16) * DM + col0;
#pragma unroll
                for (int bj = 0; bj < 2; ++bj)
#pragma unroll
                    for (int n = 0; n < 2; ++n) { const u32x2 bw = *(const GAS u32x2*)(base + off + bj * HALF + n * 16);
                        const f32x4 bs = {__uint_as_float(bw.x << 16), __uint_as_float(bw.x & 0xffff0000u), __uint_as_float(bw.y << 16), __uint_as_float(bw.y & 0xffff0000u)};
                        if (!dry) *(GAS f32x4*)(out + off + bj * HALF + n * 16) = bs * ALPHA + acc[ai][bj][m][n]; }
                asm volatile("" ::: "memory"); }
    }
};
struct EpiMoe1 {
    static constexpr bool PERM = true;
    bf16_t* H; unsigned* hcnt;
    __device__ __forceinline__ void operator()(const f32x4 (&acc)[2][2][4][2], const Unit& u, int wr, int wc, int fr, int fq) const {
        const int row0 = u.pm * BM + wr * 64 + fr, col0 = u.pn * HALF + wc * 32 + 8 * fq;
#pragma unroll
        for (int ai = 0; ai < 2; ++ai)
#pragma unroll
            for (int m = 0; m < 4; ++m) { bf16_t* rowp = H + (size_t)(row0 + ai * HALF + m * 16) * EH + col0;
                float h[8];
#pragma unroll
                for (int n = 0; n < 2; ++n)
#pragma unroll
                    for (int j = 0; j < 4; ++j) { const float g = acc[ai][0][m][n][j], up = acc[ai][1][m][n][j]; h[n * 4 + j] = g * __builtin_amdgcn_rcpf(1.f + __expf(-g)) * up; }
                u32x4 w; w.x = cvtpk(h[0], h[1]); w.y = cvtpk(h[2], h[3]); w.z = cvtpk(h[4], h[5]); w.w = cvtpk(h[6], h[7]);
                *(GAS u32x4*)rowp = w; }
    }
    __device__ __forceinline__ void publish(int pm) const { if (hcnt && (threadIdx.x & 63) == 0) __hip_atomic_fetch_add(hcnt + 64 * pm, 1u, __ATOMIC_RELAXED, __HIP_MEMORY_SCOPE_AGENT); }
};
struct EpiMoe2 {
    __device__ __forceinline__ void publish(int) const {}
    static constexpr bool PERM = true;
    bf16_t* Y; const LAS int* tab; const GAS int* list; const GAS float* glist;
    __device__ __forceinline__ void operator()(const f32x4 (&acc)[2][2][4][2], const Unit& u, int wr, int wc, int fr, int fq) const {
        const int e = tab[128 + u.pm], pos0 = (u.pm - tab[e]) * BM + wr * 64 + fr, cnt = tab[64 + e], col0 = u.pn * BM + wc * 32 + 8 * fq;
        int pr[8]; float gv[8];
#pragma unroll
        for (int i = 0; i < 8; ++i) { const int pos = pos0 + (i >> 2) * HALF + (i & 3) * 16, pc = pos < cnt ? pos : cnt - 1;
            pr[i] = list[e * LISTCAP + pc]; gv[i] = glist[e * LISTCAP + pc]; }
#pragma unroll
        for (int ai = 0; ai < 2; ++ai)
#pragma unroll
            for (int m = 0; m < 4; ++m) { const int pos = pos0 + ai * HALF + m * 16;
                if (pos < cnt) { const float gt = gv[ai * 4 + m]; bf16_t* rowp = Y + (size_t)pr[ai * 4 + m] * DM + col0;
#pragma unroll
                    for (int bj = 0; bj < 2; ++bj) { const f32x4 v0 = acc[ai][bj][m][0] * gt, v1 = acc[ai][bj][m][1] * gt;
                        u32x4 w; w.x = cvtpk(v0[0], v0[1]); w.y = cvtpk(v0[2], v0[3]); w.z = cvtpk(v1[0], v1[1]); w.w = cvtpk(v1[2], v1[3]);
                        *(GAS u32x4*)(rowp + bj * HALF) = w; } } }
    }
};

template <class Epi, class Sched>
__device__ __forceinline__ void gemm_phase(LAS unsigned char* lds, const char* A, const int K, const Sched& S, const Epi& E) {
    int tid_ = threadIdx.x; asm volatile("" : "+v"(tid_)); const int tid = tid_, wid = __builtin_amdgcn_readfirstlane(tid >> 6), lane = tid & 63, wr = wid >> 2, wc = wid & 3, fr = lane & 15, fq = lane >> 4;
    const int nt = K / BK; const unsigned Kb = (unsigned)K * 2u;
    int Rr[2]; unsigned Cb[2], voffB[2];
#pragma unroll
    for (int i = 0; i < 2; ++i) { int R, C; stage_rc(tid * 16 + i * 8192, R, C); const int Rb = Epi::PERM ? ((R & ~31) + perm32(R & 31)) : R;
        Rr[i] = R; Cb[i] = (unsigned)C * 2u; voffB[i] = (unsigned)(Rb * K + C) * 2u; }
    const size_t kstep = (size_t)(BK * 2);
    const size_t hstep = (size_t)HALF * K * 2;
    const unsigned ldsw = (unsigned)wid * 1024u;
    const int aoff = lds_byte(wr * 64 + fr, fq * 8), boff = lds_byte(wc * 32 + fr, fq * 8);
#define PG8_SA(b, h) (((b) * 2 + (h)) * HTB)
#define PG8_SB(b, h) ((4 + (b) * 2 + (h)) * HTB)
#define PG8_STAGE(bufoff, gbase, voff) do { _Pragma("unroll") for (int _i = 0; _i < 2; ++_i) \
        __builtin_amdgcn_global_load_lds((const unsigned*)((const char*)(gbase) + (voff)[_i]), (LAS unsigned*)(lds + (bufoff) + ldsw + _i * 8192), 16, 0, 0); } while (0)
#define PG8_STAGEA(bufoff, arr, h, kb) do { _Pragma("unroll") for (int _i = 0; _i < 2; ++_i) \
        __builtin_amdgcn_global_load_lds((const unsigned*)((A + (size_t)(kb)) + (arr)[h][_i]), (LAS unsigned*)(lds + (bufoff) + ldsw + _i * 8192), 16, 0, 0); } while (0)
#define PG8_SETA(arr, u) do { _Pragma("unroll") for (int _h = 0; _h < 2; ++_h) _Pragma("unroll") for (int _i = 0; _i < 2; ++_i) (arr)[_h][_i] = S.arow((u), _h * HALF + Rr[_i]) * Kb + Cb[_i]; } while (0)
#define PG8_LDA(dst, b, h) do { _Pragma("unroll") for (int m = 0; m < 4; ++m) _Pragma("unroll") for (int k = 0; k < 2; ++k) dst[m][k] = *(const LAS bf16x8*)(lds + PG8_SA(b, h) + aoff + m * 2048 + k * 1024); } while (0)
#define PG8_LDB(dst, b, h) do { _Pragma("unroll") for (int n = 0; n < 2; ++n) _Pragma("unroll") for (int k = 0; k < 2; ++k) dst[n][k] = *(const LAS bf16x8*)(lds + PG8_SB(b, h) + boff + n * 2048 + k * 1024); } while (0)
#define PG8_MMA(ai, bj, At, Bt) do { __builtin_amdgcn_s_setprio(1); _Pragma("unroll") for (int m = 0; m < 4; ++m) _Pragma("unroll") for (int n = 0; n < 2; ++n) _Pragma("unroll") for (int k = 0; k < 2; ++k) \
        acc[ai][bj][m][n] = __builtin_amdgcn_mfma_f32_16x16x32_bf16(Bt[n][k], At[m][k], acc[ai][bj][m][n], 0, 0, 0); __builtin_amdgcn_s_setprio(0); } while (0)
#define PG8_WAIT_V(n) asm volatile("s_waitcnt vmcnt(" #n ")" ::: "memory")
#define PG8_WAIT_L(n) asm volatile("s_waitcnt lgkmcnt(" #n ")" ::: "memory")
#define PG8_BAR __builtin_amdgcn_s_barrier()
#define PG8_SCHED __builtin_amdgcn_sched_barrier(0)
    Unit cur, nxt; int ui = 0;
    if (!S.next(0, cur)) return;
    f32x4 acc[2][2][4][2];
#pragma unroll
    for (int a = 0; a < 2; ++a)
#pragma unroll
        for (int b = 0; b < 2; ++b)
#pragma unroll
            for (int m = 0; m < 4; ++m)
#pragma unroll
                for (int n = 0; n < 2; ++n) acc[a][b][m][n] = (f32x4){0.f, 0.f, 0.f, 0.f};
    bf16x8 At[4][2], B0[2][2], B1[2][2];
    unsigned ac[2][2], an[2][2];
    int ppm = -1;
    S.a_ready(cur);
    PG8_SETA(ac, cur);
    const char* cB = S.bptr(cur);
    PG8_STAGE(PG8_SB(0, 0), cB, voffB); PG8_STAGE(PG8_SB(0, 1), cB + hstep, voffB); PG8_STAGEA(PG8_SA(0, 0), ac, 0, 0); PG8_STAGEA(PG8_SA(0, 1), ac, 1, 0);
    if (wr == 1) PG8_BAR;
    PG8_WAIT_V(2); PG8_BAR;
    PG8_STAGE(PG8_SB(1, 0), cB + kstep, voffB); PG8_STAGEA(PG8_SA(1, 0), ac, 0, kstep); PG8_STAGE(PG8_SB(1, 1), cB + hstep + kstep, voffB);
    PG8_WAIT_V(6); PG8_BAR;
    for (;;) {
        const bool has_next = S.next(ui + 1, nxt);
        const char* nB = cB;
        if (has_next) { PG8_SETA(an, nxt); nB = S.bptr(nxt); }
        else {
#pragma unroll
            for (int h = 0; h < 2; ++h)
#pragma unroll
                for (int i = 0; i < 2; ++i) an[h][i] = ac[h][i]; }
        for (int t = 0; t < nt; t += 2) {
            const bool last = (t == nt - 2);
            if (last && has_next) S.a_ready(nxt);
            const size_t k1 = (size_t)(t + 1) * kstep;
            const size_t k2 = last ? 0 : (size_t)(t + 2) * kstep, k3 = k2 + kstep;
            const char* b2 = last ? nB : cB + (size_t)(t + 2) * kstep; const char* b3 = b2 + kstep;
            unsigned a2[2][2];
#pragma unroll
            for (int h = 0; h < 2; ++h)
#pragma unroll
                for (int i = 0; i < 2; ++i) a2[h][i] = last ? an[h][i] : ac[h][i];
            PG8_LDB(B0, 0, 0); PG8_LDB(B1, 0, 1); PG8_SCHED; PG8_LDA(At, 0, 0); PG8_STAGEA(PG8_SA(1, 1), ac, 1, k1);
            PG8_WAIT_V(8); PG8_WAIT_L(0); PG8_BAR; PG8_MMA(0, 0, At, B0); PG8_MMA(0, 1, At, B1); PG8_BAR; PG8_SCHED;
            PG8_LDA(At, 0, 1); PG8_STAGE(PG8_SB(0, 0), b2, voffB); PG8_STAGE(PG8_SB(0, 1), b2 + hstep, voffB); PG8_STAGEA(PG8_SA(0, 0), a2, 0, k2);
            PG8_WAIT_V(8); PG8_WAIT_L(0); PG8_BAR; PG8_MMA(1, 0, At, B0); PG8_MMA(1, 1, At, B1); PG8_BAR; PG8_SCHED;
            PG8_LDB(B0, 1, 0); PG8_LDB(B1, 1, 1); PG8_SCHED; PG8_LDA(At, 1, 0); PG8_STAGEA(PG8_SA(0, 1), a2, 1, k2);
            PG8_WAIT_V(8); PG8_WAIT_L(0); PG8_BAR; PG8_MMA(0, 0, At, B0); PG8_MMA(0, 1, At, B1); PG8_BAR; PG8_SCHED;
            PG8_LDA(At, 1, 1); PG8_STAGE(PG8_SB(1, 0), b3, voffB); PG8_STAGE(PG8_SB(1, 1), b3 + hstep, voffB); PG8_STAGEA(PG8_SA(1, 0), a2, 0, k3);
            PG8_WAIT_V(8); PG8_WAIT_L(0); PG8_BAR; PG8_MMA(1, 0, At, B0); PG8_MMA(1, 1, At, B1); PG8_BAR; PG8_SCHED;
        }
        if (wr == 0) PG8_BAR;
        E(acc, cur, wr, wc, fr, fq);
        if (ppm >= 0) E.publish(ppm);
        ppm = cur.pm;
        if (!has_next) break;
#pragma unroll
        for (int a = 0; a < 2; ++a)
#pragma unroll
            for (int b = 0; b < 2; ++b)
#pragma unroll
                for (int m = 0; m < 4; ++m)
#pragma unroll
                    for (int n = 0; n < 2; ++n) acc[a][b][m][n] = (f32x4){0.f, 0.f, 0.f, 0.f};
        cur = nxt; cB = nB; ++ui;
#pragma unroll
        for (int h = 0; h < 2; ++h)
#pragma unroll
            for (int i = 0; i < 2; ++i) ac[h][i] = an[h][i];
        if (wr == 1) PG8_BAR;
    }
    PG8_WAIT_V(0);
    if (ppm >= 0) E.publish(ppm);
    PG8_BAR;
#undef PG8_SA
#undef PG8_SB
#undef PG8_STAGE
#undef PG8_STAGEA
#undef PG8_SETA
#undef PG8_LDA
#undef PG8_LDB
#undef PG8_MMA
#undef PG8_WAIT_V
#undef PG8_WAIT_L
#undef PG8_BAR
#undef PG8_SCHED
}
}

namespace attn_body {
using bf16 = __hip_bfloat16;
using bf16x8 = __attribute__((ext_vector_type(8))) short;
using s16x4 = __attribute__((ext_vector_type(4))) short;
using f32x16 = __attribute__((ext_vector_type(16))) float;
using u32x4 = __attribute__((ext_vector_type(4))) unsigned;
constexpr int D = 64, QP = INP, KP = INP, VP = INP, OP = DM;
constexpr int NW = 8, QBLK = 32, QB = QBLK * NW, KVBLK = 64;
__device__ __forceinline__ int crow(int r, int hi) { return (r & 3) + 8 * (r >> 2) + 4 * hi; }
#define SBAR() __builtin_amdgcn_sched_barrier(0)
constexpr int NSLOT = 3, SLOTB = 8192;
constexpr int LDS_K = 0, LDS_V = NSLOT * SLOTB, LDS_WS = 2 * NSLOT * SLOTB, LDS_OST = LDS_WS + NW * 64 * 4, LDS_BYTES_A = LDS_OST + NW * 4096;
__device__ __forceinline__ void glds16(const void* gsrc, unsigned lds_dst) { unsigned keep;
  asm volatile("s_mov_b32 %0, m0\n\ts_mov_b32 m0, %2\n\ts_nop 0\n\tglobal_load_lds_dwordx4 %1, off\n\ts_mov_b32 m0, %0" : "=&s"(keep) : "v"(gsrc), "s"(lds_dst) : "memory"); }
__device__ __forceinline__ float max3f(float a, float b, float c) { float r; asm("v_max3_f32 %0, %1, %2, %3" : "=v"(r) : "v"(a), "v"(b), "v"(c)); return r; }
__device__ __forceinline__ float max2f(float a, float b) { float r; asm("v_max_f32_e32 %0, %1, %2" : "=v"(r) : "v"(a), "v"(b)); return r; }
__device__ __forceinline__ float fadd_s(float a, float b) { float r; asm("v_add_f32_e32 %0, %1, %2" : "=v"(r) : "v"(a), "v"(b)); return r; }
__device__ __forceinline__ float fsub_s(float a, float b) { float r; asm("v_sub_f32_e32 %0, %1, %2" : "=v"(r) : "v"(a), "v"(b)); return r; }
typedef float f32x2_t __attribute__((ext_vector_type(2)));
__device__ __forceinline__ unsigned cvtpk_s(float lo, float hi) { f32x2_t v = {lo, hi}; bf16x2_t b = __builtin_convertvector(v, bf16x2_t); return __builtin_bit_cast(unsigned, b); }
#define WAIT_BAR(N) asm volatile("s_waitcnt vmcnt(" #N ") lgkmcnt(0)\n\ts_barrier" ::: "memory")
__device__ __forceinline__ void qkt(f32x16& p0, f32x16& p1, const char* Kslot, const bf16x8* qr, const f32x16& negm, int r32, int hi) {
  const char* kb = Kslot + hi * 1024 + r32 * 16;
  #pragma unroll
  for (int d0 = 0; d0 < 4; ++d0) {
    const bf16x8 b0 = *reinterpret_cast<const bf16x8*>(kb + d0 * 2048);
    const bf16x8 b1 = *reinterpret_cast<const bf16x8*>(kb + d0 * 2048 + 512);
    if (d0 == 0) { p0 = __builtin_amdgcn_mfma_f32_32x32x16_bf16(b0, qr[0], negm, 0, 0, 0); p1 = __builtin_amdgcn_mfma_f32_32x32x16_bf16(b1, qr[0], negm, 0, 0, 0); }
    else { p0 = __builtin_amdgcn_mfma_f32_32x32x16_bf16(b0, qr[d0], p0, 0, 0, 0); p1 = __builtin_amdgcn_mfma_f32_32x32x16_bf16(b1, qr[d0], p1, 0, 0, 0); } }
}
typedef __attribute__((address_space(3))) const char* lds_cptr;
typedef short v4i16_t __attribute__((ext_vector_type(4)));
__device__ __forceinline__ void kload8(bf16x8* kf, lds_cptr kp) {
  kf[0] = *(const __attribute__((address_space(3))) bf16x8*)(kp);        kf[1] = *(const __attribute__((address_space(3))) bf16x8*)(kp + 512);
  kf[2] = *(const __attribute__((address_space(3))) bf16x8*)(kp + 2048); kf[3] = *(const __attribute__((address_space(3))) bf16x8*)(kp + 2560);
  kf[4] = *(const __attribute__((address_space(3))) bf16x8*)(kp + 4096); kf[5] = *(const __attribute__((address_space(3))) bf16x8*)(kp + 4608);
  kf[6] = *(const __attribute__((address_space(3))) bf16x8*)(kp + 6144); kf[7] = *(const __attribute__((address_space(3))) bf16x8*)(kp + 6656);
}
__device__ __forceinline__ void kload2(bf16x8* kf, lds_cptr kp, int j) { kf[2 * j] = *(const __attribute__((address_space(3))) bf16x8*)(kp + j * 2048); kf[2 * j + 1] = *(const __attribute__((address_space(3))) bf16x8*)(kp + j * 2048 + 512); }
__device__ __forceinline__ s16x4 vtr(lds_cptr p) { return __builtin_bit_cast(s16x4, __builtin_amdgcn_ds_read_tr16_b64_v4i16((__attribute__((address_space(3))) v4i16_t*)p)); }
__device__ __forceinline__ float rowmax(const f32x16& p0, const f32x16& p1) {
  float a = max3f(p0[0], p0[1], p1[0]), b = max3f(p0[2], p0[3], p1[1]); a = max3f(a, p1[2], p1[3]);
  #pragma unroll
  for (int r = 4; r < 16; r += 4) { a = max3f(a, p0[r], p0[r + 1]); b = max3f(b, p0[r + 2], p0[r + 3]); a = max3f(a, p1[r], p1[r + 1]); b = max3f(b, p1[r + 2], p1[r + 3]); }
  const float m = max2f(a, b);
  auto rr = __builtin_amdgcn_permlane32_swap(__float_as_uint(m), __float_as_uint(m), false, false);
  return max2f(__uint_as_float(rr[0]), __uint_as_float(rr[1]));
}
__device__ __forceinline__ void pv(f32x16* o, int vb, bf16x8 pa0, bf16x8 pa1, bf16x8 pa2, bf16x8 pa3) {
  #pragma unroll
  for (int d0 = 0; d0 < 2; ++d0) { s16x4 lo[4], hi[4];
    #pragma unroll
    for (int ks = 0; ks < 4; ++ks) {
      asm volatile("ds_read_b64_tr_b16 %0,%1 offset:%c2" : "=&v"(lo[ks]) : "v"(vb), "i"(d0 * 4096 + ks * 1024) : "memory");
      asm volatile("ds_read_b64_tr_b16 %0,%1 offset:%c2" : "=&v"(hi[ks]) : "v"(vb), "i"(d0 * 4096 + ks * 1024 + 512) : "memory"); }
    asm volatile("s_waitcnt lgkmcnt(0)" ::: "memory"); SBAR();
    #define PK(k) (bf16x8){lo[k][0], lo[k][1], lo[k][2], lo[k][3], hi[k][0], hi[k][1], hi[k][2], hi[k][3]}
    o[d0] = __builtin_amdgcn_mfma_f32_32x32x16_bf16(pa0, PK(0), o[d0], 0, 0, 0);
    o[d0] = __builtin_amdgcn_mfma_f32_32x32x16_bf16(pa1, PK(1), o[d0], 0, 0, 0);
    o[d0] = __builtin_amdgcn_mfma_f32_32x32x16_bf16(pa2, PK(2), o[d0], 0, 0, 0);
    o[d0] = __builtin_amdgcn_mfma_f32_32x32x16_bf16(pa3, PK(3), o[d0], 0, 0, 0);
    #undef PK
  }
}
#define ATTN_STORE16(p, v) (*(GAS u32x4*)(p) = (v))
template <int THRL> __device__ __forceinline__ void attn_unit(int b, int h, int kvh, int qb, const bf16* Q, const bf16* __restrict__ K, const bf16* __restrict__ V, bf16* O, char* shm) {
  int tid_ = threadIdx.x; asm volatile("" : "+v"(tid_)); const int tid = tid_, lane = tid & 63, r32 = lane & 31, hi = lane >> 5; const int wid = __builtin_amdgcn_readfirstlane(tid >> 6);
  const long rowbase = (long)b * SEQ; const int q0 = qb * QB;
  const bf16* Qw = Q + (rowbase + q0 + wid * QBLK) * QP + h * D;
  const bf16* Kh = K + rowbase * KP + kvh * D, *Vh = V + rowbase * VP + kvh * D;
  const unsigned lds0 = (unsigned)(uintptr_t)shm;
  float* wsf = (float*)(shm + LDS_WS) + wid * 64;
  const bf16* ksrc = Kh + (long)lane * KP + wid * 8;
  const bf16* vsrc = Vh + (long)(16 * (wid & 3) + (lane >> 2)) * VP + (wid >> 2) * 32 + (lane & 3) * 8;
  const unsigned kdst = lds0 + LDS_K + wid * 1024, vdst = lds0 + LDS_V + wid * 1024;
  #define DMA_K(t, slot) glds16(ksrc + (long)(t) * KVBLK * KP, (unsigned)__builtin_amdgcn_readfirstlane(kdst + (slot)))
  #define DMA_V(t, slot) glds16(vsrc + (long)(t) * KVBLK * VP, (unsigned)__builtin_amdgcn_readfirstlane(vdst + (slot)))
  const int vb0 = (int)(lds0 + LDS_V) + ((lane >> 4) & 1) * 32 + (lane & 3) * 8 + (4 * hi + ((lane & 15) >> 2)) * 64;
  const char* Kbase = shm + LDS_K; bf16x8 kf[8];
  const lds_cptr shm3 = (lds_cptr)shm; const lds_cptr kp0 = shm3 + LDS_K + hi * 1024 + r32 * 16; const lds_cptr vp0 = shm3 + LDS_V + ((lane >> 4) & 1) * 32 + (lane & 3) * 8 + (4 * hi + ((lane & 15) >> 2)) * 64;
  constexpr int NT = SEQ / KVBLK;
  DMA_K(0, 0); DMA_V(0, 0); DMA_K(1, SLOTB);
  bf16x8 qr[4];
  #pragma unroll
  for (int d0 = 0; d0 < 4; ++d0) qr[d0] = *(const GAS bf16x8*)(&Qw[(long)r32 * QP + d0 * 16 + hi * 8]);
  float mhat = 0.f, l_reg = 0.f; f32x16 o[2]; o[0] = f32x16{}; o[1] = f32x16{}; f32x16 negm = f32x16{}; asm volatile("" : "+v"(negm));
  bool resc = false;
  #define START(P0, P1) do { const float rm = rowmax(P0, P1); resc = false; \
    { const float dl = rm; mhat = fadd_s(mhat, dl); \
      _Pragma("unroll") for (int r = 0; r < 16; ++r) { P0[r] = fsub_s(P0[r], dl); P1[r] = fsub_s(P1[r], dl); } \
      _Pragma("unroll") for (int r = 0; r < 16; ++r) negm[r] = -mhat; asm volatile("" : "+v"(negm)); } \
    _Pragma("unroll") for (int r = 0; r < 16; ++r) P0[r] = __builtin_amdgcn_exp2f(P0[r]); } while (0)
  #define RESC() do { if (resc) { asm volatile("s_waitcnt lgkmcnt(0)" ::: "memory"); \
      _Pragma("unroll") for (int d_ = 0; d_ < 2; ++d_) _Pragma("unroll") for (int r = 0; r < 16; ++r) o[d_][r] *= wsf[crow(r, hi)]; } } while (0)
  f32x16 pA0 = {}, pA1 = {}, pB0 = {}, pB1 = {};
  int sl_prev = 0, sl_cur = 0, sl_next = SLOTB;
  #define ROT() do { sl_prev = sl_cur; sl_cur = sl_next; sl_next = (sl_next == (NSLOT - 1) * SLOTB) ? 0 : sl_next + SLOTB; } while (0)
  DMA_K(2, 2 * SLOTB);
  WAIT_BAR(3);
  qkt(pA0, pA1, Kbase, qr, negm, r32, hi); asm volatile("s_nop 15\n\ts_nop 7" : "+v"(pA0), "+v"(pA1));
  START(pA0, pA1);
  _Pragma("unroll") for (int r = 0; r < 16; ++r) pA1[r] = __builtin_amdgcn_exp2f(pA1[r]);
  WAIT_BAR(0);
  DMA_K(3, 0); DMA_V(1, SLOTB);
  ROT();
  kload8(kf, kp0 + sl_cur);
  WAIT_BAR(2);
  s16x4 vlo[8] = {}, vhi[8] = {}; u32x4 pw0 = {}, pw1 = {}, pw2 = {}, pw3 = {};
  #define PKW(P, B) cvtpk_s(P[B], P[B + 1])
  #define PAF(k) __builtin_bit_cast(bf16x8, pw##k)
  #define VFR(i) (bf16x8){vlo[i][0], vlo[i][1], vlo[i][2], vlo[i][3], vhi[i][0], vhi[i][1], vhi[i][2], vhi[i][3]}
  #define PIN(x) asm volatile("" : "+v"(x))
  #define MX3(a, b, c) __builtin_fmaxf(__builtin_fmaxf((a), (b)), (c))
  #define GAPA(MF, A0, A1, A2, A3, W0, W1, PW) do { MF; sacc += A0; sacc += A1; sacc += A2; sacc += A3; PIN(sacc); W0; W1; PIN(PW); SBAR(); } while (0)
  #define EX(v) __builtin_amdgcn_exp2f(v)
  #define GAPB(MF, X, B) do { MF; X[B] = EX(X[B]); X[B + 1] = EX(X[B + 1]); X[B + 2] = EX(X[B + 2]); X[B + 3] = EX(X[B + 3]); PIN(X); SBAR(); } while (0)
  #define VRD(i) do { vlo[i] = vtr(vp_ + (((i) >> 2) * 4096 + ((i) & 3) * 1024)); vhi[i] = vtr(vp_ + (((i) >> 2) * 4096 + ((i) & 3) * 1024 + 512)); } while (0)
  #define KRD(G, j) do { if (G) { kload2(kf, kp0 + sl_next, j); SBAR(); } } while (0)
  #define STEP(C0, C1, P0, P1, t, GK, GV, GL) do { SBAR(); \
    const lds_cptr vp_ = vp0 + sl_prev; \
    VRD(0); SBAR(); float sacc = (P0[0] + P0[1]); \
    GAPA(C0 = __builtin_amdgcn_mfma_f32_32x32x16_bf16(kf[0], qr[0], negm, 0, 0, 0), P0[2], P0[3], P0[4], P0[5],     pw0[0] = PKW(P0, 0), pw0[1] = PKW(P0, 2), pw0); \
    VRD(4); SBAR(); GAPA(C1 = __builtin_amdgcn_mfma_f32_32x32x16_bf16(kf[1], qr[0], negm, 0, 0, 0), P0[6], P0[7], P0[8], P0[9],     pw0[2] = PKW(P0, 4), pw0[3] = PKW(P0, 6), pw0); \
    VRD(1); SBAR(); GAPA(C0 = __builtin_amdgcn_mfma_f32_32x32x16_bf16(kf[2], qr[1], C0, 0, 0, 0),   P0[10], P0[11], P0[12], P0[13], pw1[0] = PKW(P0, 8), pw1[1] = PKW(P0, 10), pw1); \
    VRD(5); SBAR(); GAPA(C1 = __builtin_amdgcn_mfma_f32_32x32x16_bf16(kf[3], qr[1], C1, 0, 0, 0),   P0[14], P0[15], P1[0], P1[1],   pw1[2] = PKW(P0, 12), pw1[3] = PKW(P0, 14), pw1); \
    VRD(2); SBAR(); GAPA(C0 = __builtin_amdgcn_mfma_f32_32x32x16_bf16(kf[4], qr[2], C0, 0, 0, 0),   P1[2], P1[3], P1[4], P1[5],     pw2[0] = PKW(P1, 0), pw2[1] = PKW(P1, 2), pw2); \
    VRD(6); SBAR(); GAPA(C1 = __builtin_amdgcn_mfma_f32_32x32x16_bf16(kf[5], qr[2], C1, 0, 0, 0),   P1[6], P1[7], P1[8], P1[9],     pw2[2] = PKW(P1, 4), pw2[3] = PKW(P1, 6), pw2); \
    VRD(3); SBAR(); GAPA(C0 = __builtin_amdgcn_mfma_f32_32x32x16_bf16(kf[6], qr[3], C0, 0, 0, 0),   P1[10], P1[11], P1[12], P1[13], pw3[0] = PKW(P1, 8), pw3[1] = PKW(P1, 10), pw3); \
    VRD(7); SBAR(); GAPA(C1 = __builtin_amdgcn_mfma_f32_32x32x16_bf16(kf[7], qr[3], C1, 0, 0, 0),   P1[14], P1[15], 0.f, 0.f,       pw3[2] = PKW(P1, 12), pw3[3] = PKW(P1, 14), pw3); \
    l_reg += sacc; \
    if (GK) { DMA_K((t) + 3, sl_cur); } if (GV) { DMA_V((t) + 1, sl_next); } \
    { float a = MX3(C0[0], C0[1], C1[0]), b = MX3(C0[2], C0[3], C1[1]); a = MX3(a, C1[2], C1[3]); \
      _Pragma("unroll") for (int r = 4; r < 16; r += 4) { a = MX3(a, C0[r], C0[r + 1]); b = MX3(b, C0[r + 2], C0[r + 3]); a = MX3(a, C1[r], C1[r + 1]); b = MX3(b, C1[r + 2], C1[r + 3]); } \
      float rm = __builtin_fmaxf(a, b); { auto rr = __builtin_amdgcn_permlane32_swap(__float_as_uint(rm), __float_as_uint(rm), false, false); rm = __builtin_fmaxf(__uint_as_float(rr[0]), __uint_as_float(rr[1])); } \
      resc = false; \
      if (__builtin_expect(__any(rm > (float)THRL), 0)) { const float dl = __builtin_fmaxf(rm, 0.f); mhat += dl; \
        _Pragma("unroll") for (int r = 0; r < 16; ++r) { C0[r] -= dl; C1[r] -= dl; } \
        _Pragma("unroll") for (int r = 0; r < 16; ++r) negm[r] = -mhat; asm volatile("" : "+v"(negm)); \
        const float f = __builtin_amdgcn_exp2f(-dl); l_reg *= f; if (hi == 0) wsf[r32] = f; resc = true; } } \
    SBAR(); \
    GAPB(o[0] = __builtin_amdgcn_mfma_f32_32x32x16_bf16(PAF(0), VFR(0), o[0], 0, 0, 0), C0, 0); \
    GAPB(o[1] = __builtin_amdgcn_mfma_f32_32x32x16_bf16(PAF(0), VFR(4), o[1], 0, 0, 0), C0, 4); \
    KRD(GL, 0); GAPB(o[0] = __builtin_amdgcn_mfma_f32_32x32x16_bf16(PAF(1), VFR(1), o[0], 0, 0, 0), C0, 8); \
    KRD(GL, 1); GAPB(o[1] = __builtin_amdgcn_mfma_f32_32x32x16_bf16(PAF(1), VFR(5), o[1], 0, 0, 0), C0, 12); \
    KRD(GL, 2); GAPB(o[0] = __builtin_amdgcn_mfma_f32_32x32x16_bf16(PAF(2), VFR(2), o[0], 0, 0, 0), C1, 0); \
    KRD(GL, 3); GAPB(o[1] = __builtin_amdgcn_mfma_f32_32x32x16_bf16(PAF(2), VFR(6), o[1], 0, 0, 0), C1, 4); \
    GAPB(o[0] = __builtin_amdgcn_mfma_f32_32x32x16_bf16(PAF(3), VFR(3), o[0], 0, 0, 0), C1, 8); \
    GAPB(o[1] = __builtin_amdgcn_mfma_f32_32x32x16_bf16(PAF(3), VFR(7), o[1], 0, 0, 0), C1, 12); \
    } while (0)
  int t = 1;
  for (; t + 5 < NT; t += 2) {
    STEP(pB0, pB1, pA0, pA1, t, true, true, true);     WAIT_BAR(2); RESC(); ROT();
    STEP(pA0, pA1, pB0, pB1, t + 1, true, true, true); WAIT_BAR(2); RESC(); ROT();
  }
  #define ENDW(tt) do { if ((tt) + 3 < NT) { WAIT_BAR(2); } else if ((tt) + 2 < NT) { WAIT_BAR(1); } else { WAIT_BAR(0); } } while (0)
  for (; t + 1 < NT; t += 2) {
    STEP(pB0, pB1, pA0, pA1, t, (t + 3 < NT), (t + 1 < NT), (t + 1 < NT));         ENDW(t);     RESC(); ROT();
    STEP(pA0, pA1, pB0, pB1, t + 1, (t + 4 < NT), (t + 2 < NT), (t + 2 < NT));     ENDW(t + 1); RESC(); ROT();
  }
  STEP(pB0, pB1, pA0, pA1, NT - 1, false, false, false); RESC();
  { float sacc = pB0[0] + pB0[1]; _Pragma("unroll") for (int r = 2; r < 16; ++r) sacc += pB0[r]; _Pragma("unroll") for (int r = 0; r < 16; ++r) sacc += pB1[r]; l_reg += sacc;
    pw0 = (u32x4){PKW(pB0, 0), PKW(pB0, 2), PKW(pB0, 4), PKW(pB0, 6)}; pw1 = (u32x4){PKW(pB0, 8), PKW(pB0, 10), PKW(pB0, 12), PKW(pB0, 14)}; pw2 = (u32x4){PKW(pB1, 0), PKW(pB1, 2), PKW(pB1, 4), PKW(pB1, 6)}; pw3 = (u32x4){PKW(pB1, 8), PKW(pB1, 10), PKW(pB1, 12), PKW(pB1, 14)};
    SBAR(); pv(o, vb0 + sl_cur, PAF(0), PAF(1), PAF(2), PAF(3)); }
  #undef PKW
  #undef PAF
  #undef VFR
  #undef PIN
  #undef MX3
  #undef GAPA
  #undef GAPB
  #undef EX
  #undef VRD
  #undef KRD
  #undef STEP
  #undef ENDW
  { auto rr = __builtin_amdgcn_permlane32_swap(__float_as_uint(l_reg), __float_as_uint(l_reg), false, false); l_reg = __uint_as_float(rr[0]) + __uint_as_float(rr[1]); }
  if (hi == 0) wsf[32 + r32] = l_reg; asm volatile("s_waitcnt lgkmcnt(0)" ::: "memory");
  float rli[16];
  #pragma unroll
  for (int r = 0; r < 16; ++r) rli[r] = __builtin_amdgcn_rcpf(wsf[32 + crow(r, hi)]);
  bf16* Ow = O + (rowbase + q0 + wid * QBLK) * OP + h * D;
  { bf16* stg = (bf16*)(shm + LDS_OST) + wid * 2048;
    #pragma unroll
    for (int r = 0; r < 16; ++r) { const int orow = crow(r, hi);
      #pragma unroll
      for (int d0 = 0; d0 < 2; ++d0) stg[orow * 64 + d0 * 32 + r32] = __float2bfloat16(o[d0][r] * rli[r]); }
    asm volatile("s_waitcnt lgkmcnt(0)" ::: "memory");
    #pragma unroll
    for (int i = 0; i < 4; ++i) { const int row = i * 8 + (lane >> 3), ch = lane & 7; const u32x4 v = *(const u32x4*)(stg + row * 64 + ch * 8); ATTN_STORE16(Ow + (long)row * OP + ch * 8, v); } }
  asm volatile("s_waitcnt lgkmcnt(0)\n\ts_barrier" ::: "memory");
  #undef DMA_K
  #undef DMA_V
  #undef START
  #undef RESC
  #undef ROT
}
#undef SBAR
#undef WAIT_BAR
}

typedef GAS unsigned gu32;
#define RLX_AGENT __ATOMIC_RELAXED, __HIP_MEMORY_SCOPE_AGENT
#define XB_TMO      128
#define XB_XCNT(j)  (256  + 64 * (j))
#define XB_XSUB(j)  (1280 + 64 * (j))
#define XB_XGEN(j)  (2304 + 64 * (j))
#define XB_TOP      3328
#define XB_TOPGEN   3392
#define XCD_BAR_WORDS 3456
#define XB_SPIN_CAP (1u << 22)
__device__ __forceinline__ unsigned xb_ld(unsigned* p)              { return __hip_atomic_load(p, __ATOMIC_RELAXED, __HIP_MEMORY_SCOPE_AGENT); }
__device__ __forceinline__ unsigned xb_add(unsigned* p, unsigned v) { return __hip_atomic_fetch_add(p, v, __ATOMIC_RELAXED, __HIP_MEMORY_SCOPE_AGENT); }
__device__ __forceinline__ unsigned xb_xcc_id() { return (unsigned)__builtin_amdgcn_s_getreg((3 << 11) | 20) & 0xFu; }
#define XB_SPIN(cond, bar) do { unsigned _sp = 0; while (cond) { __builtin_amdgcn_s_sleep(1); \
    if ((++_sp & 255u) == 0u) { if (xb_ld(&(bar)[XB_TMO])) break; if (_sp > XB_SPIN_CAP) { atomicAdd(&(bar)[XB_TMO], 1u); break; } } } } while (0)
struct XcdBarrier { unsigned* bar; unsigned x; volatile LAS unsigned* st; };
__device__ __forceinline__ XcdBarrier xcd_barrier_post(unsigned* bar, volatile LAS unsigned* st) {
    XcdBarrier b; b.bar = bar; b.x = xb_xcc_id(); b.st = st;
    if (threadIdx.x == 0) st[2] = xb_add(&bar[XB_XCNT(b.x)], 1u);
    return b;
}
__device__ __forceinline__ void xcd_barrier_complete(unsigned* bar, unsigned x, unsigned& nloc, unsigned& nx) {
    const unsigned G = gridDim.x * gridDim.y * gridDim.z;
    unsigned sum, cnt, mine, sp = 0u;
    for (;;) {
        sum = 0u; cnt = 0u; mine = 0u;
#pragma unroll
        for (unsigned j = 0; j < 16; ++j) { const unsigned c = xb_ld(&bar[XB_XCNT(j)]); sum += c; cnt += (c > 0u) ? 1u : 0u; mine = (j == x) ? c : mine; }
        if (sum == G) break;
        __builtin_amdgcn_s_sleep(1);
        if ((++sp & 255u) == 0u) { if (xb_ld(&bar[XB_TMO])) break; if (sp > XB_SPIN_CAP) { atomicAdd(&bar[XB_TMO], 1u); break; } }
    }
    nloc = mine > 0u ? mine : 1u; nx = cnt > 0u ? cnt : 1u;
}
__device__ __forceinline__ void xcd_barrier(const XcdBarrier& b) {
    asm volatile("s_waitcnt vmcnt(0)" ::: "memory");
    __syncthreads();
    if (threadIdx.x == 0) {
        unsigned* bar = b.bar;
        __builtin_amdgcn_s_waitcnt(0);
        unsigned nloc = b.st[0], nx = b.st[1];
        if (nloc == 0u) { xcd_barrier_complete(bar, b.x, nloc, nx); b.st[0] = nloc; b.st[1] = nx; }
        const unsigned old = xb_add(&bar[XB_XSUB(b.x)], 1u);
        const unsigned gen = old / nloc;
        if (old + 1u == (gen + 1u) * nloc) {
            __builtin_amdgcn_fence(__ATOMIC_RELEASE, "agent");
            asm volatile("s_waitcnt vmcnt(0)" ::: "memory");
            const unsigned og = xb_add(&bar[XB_TOP], 1u);
            const unsigned tg = og / nx;
            if (og + 1u == (tg + 1u) * nx) xb_add(&bar[XB_TOPGEN], 1u);
            else XB_SPIN(xb_ld(&bar[XB_TOPGEN]) == tg, bar);
            __builtin_amdgcn_fence(__ATOMIC_ACQUIRE, "agent");
            xb_add(&bar[XB_XGEN(b.x)], 1u);
            asm volatile("s_waitcnt vmcnt(0)" ::: "memory");
        } else {
            XB_SPIN(xb_ld(&bar[XB_XGEN(b.x)]) == gen, bar);
            __builtin_amdgcn_fence(__ATOMIC_ACQUIRE, "agent");
            asm volatile("s_waitcnt vmcnt(0)" ::: "memory");
        }
    }
    __syncthreads();
}

struct Args { const float* in[30]; float* out; unsigned char* ws; int ph_lo, ph_hi, multi, pad; };
typedef const __attribute__((address_space(4))) unsigned char* kptr_t;
struct PArgs { kptr_t kp; unsigned char* ws_; float* out_;
    __device__ __forceinline__ const float* in(int i) const { return (const float*)(const GAS float*)(*(const float* const __attribute__((address_space(4)))*)(kp + 8 * i)); }
    __device__ __forceinline__ unsigned char* ws() const { return (unsigned char*)(GAS unsigned char*)ws_; }
    __device__ __forceinline__ float* out() const { return (float*)(GAS float*)out_; } };
enum { I_X = 0, I_WIN, I_MUP, I_MUN, I_POOLW, I_POOLS, I_W0, I_WUP, I_A0, I_AUP, I_GUP, I_KK, I_KA, I_RK, I_GNG, I_GNB, I_QN, I_KN, I_WO, I_LN1G, I_LN1B,
       I_RG, I_RGB, I_RE, I_REB, I_EG, I_EU, I_ED, I_LN2G, I_LN2B };
constexpr int LDSCTL_OFF = 163840 - 256;
constexpr int MOE_TAB_OFF = 131072 + 2048;

__device__ __forceinline__ void transpose_item(const float* W, int N, int k0, int n0, bf16_t* WT, int Kout, int row0, LAS float* scr, int lane) {
    float tv[32];
#pragma unroll
    for (int i = 0; i < 32; ++i) { const int kk = 2 * i + (lane >> 5); tv[i] = ((const GAS float*)W)[(size_t)(k0 + kk) * N + n0 + (lane & 31)]; }
#pragma unroll
    for (int i = 0; i < 32; ++i) { const int kk = 2 * i + (lane >> 5); scr[kk * 33 + (lane & 31)] = tv[i]; }
    asm volatile("s_waitcnt lgkmcnt(0)" ::: "memory");
    const int c = lane & 7;
#pragma unroll
    for (int j = 0; j < 4; ++j) { const int n = (lane >> 3) + 8 * j; const LAS float* s = scr + (8 * c) * 33 + n;
        u32x4 o; o.x = cvtpk(s[0 * 33], s[1 * 33]); o.y = cvtpk(s[2 * 33], s[3 * 33]); o.z = cvtpk(s[4 * 33], s[5 * 33]); o.w = cvtpk(s[6 * 33], s[7 * 33]);
        *(GAS u32x4*)(WT + (size_t)(row0 + n) * Kout + k0 + 8 * c) = o; }
    asm volatile("s_waitcnt lgkmcnt(0)" ::: "memory");
}
__device__ __forceinline__ void sincos_d(double a, double& s, double& c) {
    const double TWO_PI = 6.283185307179586476925;
    const double n = rint(a / TWO_PI); const double r = a - n * TWO_PI;
    const double q = r * 0.25, q2 = q * q;
    const double sq = q * (1.0 + q2 * (-1.0 / 6 + q2 * (1.0 / 120 + q2 * (-1.0 / 5040 + q2 * (1.0 / 362880 + q2 * (-1.0 / 39916800 + q2 * (1.0 / 6227020800.0)))))));
    const double cq = 1.0 + q2 * (-0.5 + q2 * (1.0 / 24 + q2 * (-1.0 / 720 + q2 * (1.0 / 40320 + q2 * (-1.0 / 3628800 + q2 * (1.0 / 479001600.0 + q2 * (-1.0 / 87178291200.0)))))));
    const double s2 = 2 * sq * cq, c2 = 1 - 2 * sq * sq;
    s = 2 * s2 * c2; c = 1 - 2 * s2 * s2;
}
__device__ __forceinline__ void convert_layer_weights(const PArgs& a, LAS unsigned char* lds, int l, int vcu, int G, int sel) {
    unsigned char* ws = a.ws();
    int tid_ = threadIdx.x; asm volatile("" : "+v"(tid_)); const int tid = tid_, lane = tid & 63, wave = __builtin_amdgcn_readfirstlane(tid >> 6);
    const int gw = vcu * NWAVES + wave, NGW = G * NWAVES;
    const size_t gt = (size_t)vcu * NTHR + tid, NGT = (size_t)G * NTHR;
    LAS float* scr = (LAS float*)(lds + wave * 16384);
    constexpr int I_A = 16 * 62, I_B = 16 * 32, I_C = 32 * 16 * 16, I_E = 32 * 8 * 32, PER_L = I_A + I_B + 2 * I_C + I_E;
    const int it_lo = (sel & 1) ? 0 : I_A + I_B, it_hi = (sel & 2) ? PER_L : I_A + I_B;
    for (int it = it_lo + gw; it < it_hi; it += NGW) {
        int r = it;
        if (r < I_A) { const int kb = r / 62, nb = r % 62; transpose_item(a.in(I_WIN) + (size_t)l * DM * INW, INW, 64 * kb, 32 * nb, (bf16_t*)(ws + WS_WIN + (size_t)l * 4 * MiB), DM, 32 * nb, scr, lane); continue; } r -= I_A;
        if (r < I_B) { const int kb = r / 32, nb = r % 32; transpose_item(a.in(I_WO) + (size_t)l * DM * DM, DM, 64 * kb, 32 * nb, (bf16_t*)(ws + WS_WO + (size_t)l * 2 * MiB), DM, 32 * nb, scr, lane); continue; } r -= I_B;
        if (r < 2 * I_C) { const int up = r >= I_C; if (up) r -= I_C; const int e = r / 256, rr = r % 256, kb = rr / 16, nb = rr % 16; const int n0 = 32 * nb;
            transpose_item(a.in(up ? I_EU : I_EG) + ((size_t)l * NEXP + e) * DM * EH, EH, 64 * kb, n0, (bf16_t*)(ws + WS_WGU) + (size_t)e * 1024 * DM, DM, 256 * (n0 >> 7) + (n0 & 127) + (up ? 128 : 0), scr, lane); continue; } r -= 2 * I_C;
        { const int e = r / 256, rr = r % 256, kb = rr / 32, nb = rr % 32;
            transpose_item(a.in(I_ED) + ((size_t)l * NEXP + e) * EH * DM, DM, 64 * kb, 32 * nb, (bf16_t*)(ws + WS_WD) + (size_t)e * DM * EH, EH, 32 * nb, scr, lane); }
    }
    if (sel & 1) for (size_t i = gt; i < (size_t)64 * DM / 8; i += NGT) *(GAS u32x4*)((bf16_t*)(ws + WS_WIN + (size_t)l * 4 * MiB) + (size_t)INW * DM + i * 8) = (u32x4){0u, 0u, 0u, 0u};
}
__device__ __forceinline__ void phase_prologue(const PArgs& a, LAS unsigned char* lds, int vcu, int G) {
    unsigned char* ws = a.ws();
    int tid_ = threadIdx.x; asm volatile("" : "+v"(tid_)); const int tid = tid_, lane = tid & 63, wave = __builtin_amdgcn_readfirstlane(tid >> 6);
    const int gw = vcu * NWAVES + wave, NGW = G * NWAVES;
    const size_t gt = (size_t)vcu * NTHR + tid, NGT = (size_t)G * NTHR;
    LAS float* scr = (LAS float*)(lds + wave * 16384);
    convert_layer_weights(a, lds, 0, vcu, G, 3);
#pragma unroll 1
    for (int l = 1; l < DEPTH; ++l) convert_layer_weights(a, lds, l, vcu, G, 1);
    for (size_t i = gt; i < (size_t)NTOK * DM / 8; i += NGT) { const f32x4 v0 = *(const GAS f32x4*)(a.in(I_X) + i * 8), v1 = *(const GAS f32x4*)(a.in(I_X) + i * 8 + 4);
        u32x4 o; o.x = cvtpk(v0[0], v0[1]); o.y = cvtpk(v0[2], v0[3]); o.z = cvtpk(v1[0], v1[1]); o.w = cvtpk(v1[2], v1[3]);
        *(GAS u32x4*)((bf16_t*)(ws + WS_XN) + i * 8) = o; }
    unsigned char* sm = ws + WS_SMALL;
    for (size_t i = gt; i < 64 * 16; i += NGT) { const int pos = (int)(i >> 4), f = (int)(i & 15); double inv = 1.0; for (int k = 0; k < f; ++k) inv *= 0.56234132519034908;
        double s, c; sincos_d((double)pos * inv, s, c); float* R = (float*)(sm + SM_ROPE) + pos * 32; R[f] = (float)c; R[16 + f] = (float)s; }
    for (size_t i = gt; i < (size_t)DEPTH * 4 * 64 * 64; i += NGT) { const int k = (int)(i & 63), n = (int)((i >> 6) & 63); const size_t lg = i >> 12;
        ((bf16_t*)(sm + SM_PWT))[i] = (bf16_t)(cvtpk(a.in(I_POOLW)[(lg * 64 + k) * 64 + n], 0.f) & 0xffffu); }
    for (size_t i = gt; i < (size_t)DEPTH * 2 * 256 * 32; i += NGT) { const int k = (int)(i & 31), n = (int)((i >> 5) & 255); const size_t ld = i >> 13;
        ((bf16_t*)(sm + SM_WUPT))[i] = (bf16_t)(cvtpk(a.in(I_WUP)[(ld * 32 + k) * 256 + n], 0.f) & 0xffffu);
        ((bf16_t*)(sm + SM_AUPT))[i] = (bf16_t)(cvtpk(a.in(I_AUP)[(ld * 32 + k) * 256 + n], 0.f) & 0xffffu); }
    for (size_t i = gt; i < (size_t)DEPTH * 256 * 64; i += NGT) { const int k = (int)(i & 63), n = (int)((i >> 6) & 255); const size_t l = i >> 14;
        ((bf16_t*)(sm + SM_GUPT))[i] = (bf16_t)(cvtpk(a.in(I_GUP)[(l * 64 + k) * 256 + n], 0.f) & 0xffffu); }
    for (size_t i = gt; i < (size_t)DEPTH * 48 * 1024; i += NGT) { const int k = (int)(i & 1023); const int c = (int)((i >> 10) % 48); const size_t l = i / (48 * 1024);
        const float w = (c < 32 ? ((const GAS float*)a.in(I_RE))[(l * DM + k) * 32 + c] : (c < 36 ? ((const GAS float*)a.in(I_RG))[(l * DM + k) * 4 + (c - 32)] : 0.f)) * ((const GAS float*)a.in(I_LN1G))[l * DM + k];
        const unsigned hi_ = cvtpk(w, 0.f) & 0xffffu; const float lo_ = w - __uint_as_float(hi_ << 16);
        bf16_t* RWB = (bf16_t*)(ws + WS_RWB) + l * 2 * 48 * 1024; RWB[c * 1024 + k] = (bf16_t)hi_; RWB[48 * 1024 + c * 1024 + k] = (bf16_t)(cvtpk(lo_, 0.f) & 0xffffu); }
    for (int it = gw; it < DEPTH * 48; it += NGW) { const int l = it / 48, c = it % 48; float sb_ = 0.f;
        if (c < 36) for (int k = lane; k < DM; k += 64) sb_ += ((const GAS float*)a.in(I_LN1B))[l * DM + k] * (c < 32 ? ((const GAS float*)a.in(I_RE))[((size_t)l * DM + k) * 32 + c] : ((const GAS float*)a.in(I_RG))[((size_t)l * DM + k) * 4 + (c - 32)]);
        sb_ = wave_sum(sb_); if (lane == 0) ((GAS float*)(ws + WS_RB))[it] = sb_; }
}

constexpr size_t REC_BYTES = 13568, REC_AOP = 0  , REC_AY = 5120  , REC_AS = 7168  , REC_GC = 11264  , REC_VT = 11520  ;
__device__ __forceinline__ int permp(int x) { return (x & 3) | ((x & 4) << 1) | ((x & 8) >> 1); }
__device__ __forceinline__ bf16x8 pack_frag(const float (&x)[8]) { u32x4 o; o.x = cvtpk(x[0], x[1]); o.y = cvtpk(x[2], x[3]); o.z = cvtpk(x[4], x[5]); o.w = cvtpk(x[6], x[7]); return __builtin_bit_cast(bf16x8, o); }
__device__ __forceinline__ void swap32(float a, float b, float& lo, float& hi) {
    auto rr = __builtin_amdgcn_permlane32_swap(__float_as_uint(a), __float_as_uint(b), false, false); lo = __uint_as_float(rr[0]); hi = __uint_as_float(rr[1]); }

__device__ __forceinline__ void scan_pre_item(const PArgs& a, LAS bf16_t* X, int bh, int dir, int c, int lane, int var = 0) {
    unsigned char* ws0 = a.ws_; asm volatile("" : "+s"(ws0)); unsigned char* ws = (unsigned char*)(GAS unsigned char*)ws0;
    asm volatile("" : "+v"(lane));
    const int l31 = lane & 31, hi = lane >> 5;
    {
        const int item = (bh * 2 + dir) * 128 + c;
        const size_t hb = (size_t)bh * SEQ * 64 + lane;
        const GAS unsigned short* gW = (const GAS unsigned short*)(ws + (dir ? WS_WH1 : WS_WH0)) + hb; const GAS bf16_t* gV = (const GAS bf16_t*)(ws + WS_V) + hb;
        const GAS unsigned char* gFC = (const GAS unsigned char*)(ws + (dir ? WS_FC1 : WS_FC0)) + ((size_t)bh * SEQ * 32 + (lane >> 1)) * 16;
        unsigned char* rec = ws + WS_REC + (size_t)item * REC_BYTES;
        float ah[16], bhh[16], khh[16], rh[16]; unsigned vv2[8] = {0u, 0u, 0u, 0u, 0u, 0u, 0u, 0u};
        float g = 1.f;
        {
            u32x4 ck[16]; unsigned short wr_[16], vr[16];
#pragma unroll
            for (int t = 0; t < 16; ++t) { const int tt = dir ? SEQ - 1 - (16 * c + t) : 16 * c + t; const size_t o = (size_t)tt * 64;
                ck[t] = *(const GAS u32x4*)(gFC + (size_t)tt * 512); wr_[t] = gW[o]; vr[t] = gV[o]; }
            asm volatile("" ::: "memory");
            const int sh = (lane & 1) * 16;
#pragma unroll
            for (int t = 0; t < 16; ++t) {
                const float w = (float)__builtin_bit_cast(_Float16, wr_[t]), b = __uint_as_float((ck[t].x >> sh) << 16), kh = __uint_as_float((ck[t].y >> sh) << 16), kk = __uint_as_float((ck[t].z >> sh) << 16), r = __uint_as_float((ck[t].w >> sh) << 16);
                vv2[t >> 1] |= (unsigned)vr[t] << (16 * (t & 1));
                ah[t] = g * kk; g *= w; const float ig = __builtin_amdgcn_rcpf(g); bhh[t] = b * ig; khh[t] = kh * ig; rh[t] = g * r; }
        }
        const float gC = g;
#pragma unroll
        for (int t = 0; t < 16; ++t) { X[(0 * 16 + t) * 64 + lane] = (bf16_t)(cvtpk(ah[t], 0.f) & 0xffffu); X[(1 * 16 + t) * 64 + lane] = (bf16_t)(cvtpk(bhh[t], 0.f) & 0xffffu);
            X[(2 * 16 + t) * 64 + lane] = (bf16_t)(cvtpk(khh[t], 0.f) & 0xffffu); X[(3 * 16 + t) * 64 + lane] = (bf16_t)(cvtpk(rh[t], 0.f) & 0xffffu); }
        f32x16 Nacc = f32x16{};
        { const LAS bf16_t* pa = X + ((l31 < 16 ? 1 : 2) * 16 + (l31 & 15)) * 64 + 8 * hi; const LAS bf16_t* pb = X + ((l31 < 16 ? 0 : 3) * 16 + (l31 & 15)) * 64 + 8 * hi;
#pragma unroll
          for (int ks = 0; ks < 4; ++ks) Nacc = __builtin_amdgcn_mfma_f32_32x32x16_bf16(*(const LAS bf16x8*)(pa + 16 * ks), *(const LAS bf16x8*)(pb + 16 * ks), Nacc, 0, 0, 0); }
        float NB[16], NK[16];
        { const int lim = (l31 & 15) + (l31 >> 4);
#pragma unroll
          for (int r = 0; r < 16; ++r) { float lo_, oth; swap32(Nacc[r], Nacc[r], lo_, oth);
              const int r7 = r & 7, s_own = (r7 & 3) + 8 * (r7 >> 2), s_oth = s_own + 4;
              const float vo = (s_own < lim) ? Nacc[r] : 0.f, vt = (s_oth < lim) ? oth : 0.f;
              if (r < 8) { NB[s_own] = vo; NB[s_oth] = vt; } else { NK[s_own] = vo; NK[s_oth] = vt; } } }
        float Tc[16], Mc[16];
#pragma unroll
        for (int s_ = 0; s_ < 16; ++s_) { Tc[s_] = (s_ == lane) ? 1.f : 0.f; Mc[s_] = 0.f; }
        if (var < 2) {
#pragma unroll
        for (int p = 0; p < 15; ++p)
#pragma unroll
            for (int s_ = 0; s_ <= p; ++s_) { const float tb_ = __int_as_float(__builtin_amdgcn_readlane(__float_as_int(Tc[s_]), p)); Tc[s_] -= tb_ * NB[p]; }
#pragma unroll
        for (int p = 1; p < 16; ++p)
#pragma unroll
            for (int s_ = 0; s_ < p; ++s_) { const float nb_ = __int_as_float(__builtin_amdgcn_readlane(__float_as_int(NK[s_]), p)); Mc[s_] += nb_ * Tc[p]; }
        }
        f32x16 Ap0, Ap1;
        { float ta[8], f0[8], f1[8];
#pragma unroll
          for (int jj = 0; jj < 8; ++jj) { float lo_, hi_; swap32(Tc[jj], Tc[8 + jj], lo_, hi_); ta[jj] = lo_; swap32(ah[jj], ah[8 + jj], f0[jj], f1[jj]); }
          const bf16x8 TA = pack_frag(ta);
          Ap0 = __builtin_amdgcn_mfma_f32_32x32x16_bf16(TA, pack_frag(f0), f32x16{}, 0, 0, 0); Ap1 = __builtin_amdgcn_mfma_f32_32x32x16_bf16(TA, pack_frag(f1), f32x16{}, 0, 0, 0); }
        if (var == 0) {
#define FRAG_OFF(m, ks, p) ((ks) * 1024 + ((m) + 32 * ((p) >> 3)) * 16 + ((p) & 7) * 2)
        { LAS unsigned char* AL = (LAS unsigned char*)X;
          { const int ksl = l31 >> 4, pj = permp(l31 & 15);
#pragma unroll
            for (int r = 0; r < 8; ++r) { const int t = (r & 3) + 8 * (r >> 2) + 4 * hi;
                *(LAS bf16_t*)(AL + FRAG_OFF(t, ksl, pj)) = (bf16_t)(cvtpk(Ap0[r], 0.f) & 0xffffu); *(LAS bf16_t*)(AL + FRAG_OFF(t, 2 + ksl, pj)) = (bf16_t)(cvtpk(Ap1[r], 0.f) & 0xffffu); } }
          { const int ksj = lane >> 4, pj = permp(lane & 15);
#pragma unroll
            for (int t = 0; t < 16; ++t) *(LAS bf16_t*)(AL + FRAG_OFF(16 + t, ksj, pj)) = (bf16_t)(cvtpk(rh[t], 0.f) & 0xffffu); }
          if (lane < 16) { float m0[8], m1[8];
#pragma unroll
              for (int jj = 0; jj < 8; ++jj) { m0[jj] = Mc[jj]; m1[jj] = Mc[8 + jj]; }
              *(LAS bf16x8*)(AL + 4096 + lane * 16) = pack_frag(m0); *(LAS bf16x8*)(AL + 4096 + (lane + 32) * 16) = pack_frag(m1);
              *(LAS u32x4*)(AL + 4096 + (16 + lane) * 16) = (u32x4){0u, 0u, 0u, 0u}; *(LAS u32x4*)(AL + 4096 + (48 + lane) * 16) = (u32x4){0u, 0u, 0u, 0u}; }
          asm volatile("s_waitcnt lgkmcnt(0)" ::: "memory");
#pragma unroll
          for (int k = 0; k < 5; ++k) { const u32x4 v = *(const LAS u32x4*)(AL + k * 1024 + lane * 16); *(GAS u32x4*)(rec + REC_AOP + k * 1024 + lane * 16) = v; }
          asm volatile("s_waitcnt lgkmcnt(0)" ::: "memory"); }
        if (lane >= 16 && lane < 32) { unsigned char* AY = rec + REC_AY; const int t = lane - 16;
            float y0[8], y1[8], y2[8], y3[8];
#pragma unroll
            for (int jj = 0; jj < 8; ++jj) { y0[jj] = -NB[permp(jj)]; y1[jj] = -NB[permp(8 + jj)]; y2[jj] = NK[jj]; y3[jj] = NK[8 + jj]; }
            *(GAS bf16x8*)(AY + t * 16) = pack_frag(y0); *(GAS bf16x8*)(AY + (t + 32) * 16) = pack_frag(y1); *(GAS bf16x8*)(AY + 1024 + t * 16) = pack_frag(y2); *(GAS bf16x8*)(AY + 1024 + (t + 32) * 16) = pack_frag(y3);
            const u32x4 z = {0u, 0u, 0u, 0u};
            *(GAS u32x4*)(AY + (16 + t) * 16) = z; *(GAS u32x4*)(AY + (48 + t) * 16) = z; *(GAS u32x4*)(AY + 1024 + (16 + t) * 16) = z; *(GAS u32x4*)(AY + 1024 + (48 + t) * 16) = z; }
        { unsigned char* AS = rec + REC_AS + (lane >> 5) * 2048; const int jl = lane & 31;
            float s0[8], s1[8], s2[8], s3[8];
#pragma unroll
            for (int jj = 0; jj < 8; ++jj) { s0[jj] = -bhh[permp(jj)] * gC; s1[jj] = -bhh[permp(8 + jj)] * gC; s2[jj] = khh[jj] * gC; s3[jj] = khh[8 + jj] * gC; }
            *(GAS bf16x8*)(AS + jl * 16) = pack_frag(s0); *(GAS bf16x8*)(AS + (jl + 32) * 16) = pack_frag(s1); *(GAS bf16x8*)(AS + 1024 + jl * 16) = pack_frag(s2); *(GAS bf16x8*)(AS + 1024 + (jl + 32) * 16) = pack_frag(s3); }
        { const int jl = lane & 31; ((GAS float*)(rec + REC_GC))[(lane >> 5) * 32 + ((jl >> 2) & 1) * 16 + (jl & 3) + 4 * (jl >> 3)] = gC; }
        { unsigned char* VT = rec + REC_VT + (lane >> 5) * 1024; const int il = lane & 31;
            *(GAS u32x4*)(VT + il * 16) = (u32x4){vv2[0], vv2[1], vv2[2], vv2[3]};
            *(GAS u32x4*)(VT + (il + 32) * 16) = (u32x4){vv2[4], vv2[5], vv2[6], vv2[7]}; }
        } else { asm volatile("" :: "v"(Ap0[0]), "v"(Ap1[0]), "v"(Mc[0]), "v"(NB[1]), "v"(NK[1]), "v"(gC), "v"(vv2[0])); }
#undef FRAG_OFF
    }
}

constexpr int FT_STRIDE = 968, DT_STRIDE = 264, DT_OFF = 64 * FT_STRIDE * 2;
static_assert(DT_OFF + 64 * DT_STRIDE * 2 <= LDSCTL_OFF, "prep LDS");
__device__ __forceinline__ void unpack8(const u32x4 w, float (&x)[8]) { x[0] = bflo(w.x); x[1] = bfhi(w.x); x[2] = bflo(w.y); x[3] = bfhi(w.y); x[4] = bflo(w.z); x[5] = bfhi(w.z); x[6] = bflo(w.w); x[7] = bfhi(w.w); }
__device__ __forceinline__ u32x4 pack8(const float (&x)[8]) { u32x4 o; o.x = cvtpk(x[0], x[1]); o.y = cvtpk(x[2], x[3]); o.z = cvtpk(x[4], x[5]); o.w = cvtpk(x[6], x[7]); return o; }
__device__ __forceinline__ void unpack4(const u32x2 w, float (&x)[4]) { x[0] = bflo(w.x); x[1] = bfhi(w.x); x[2] = bflo(w.y); x[3] = bfhi(w.y); }

__device__ __forceinline__ void phase_prep(const PArgs& a_in, LAS unsigned char* lds, int l, int dry, int i0, int ihi, int istep, const unsigned* pcnt) {
    int tid_ = threadIdx.x; asm volatile("" : "+v"(tid_)); const int tid = tid_, lane = tid & 63, wave = __builtin_amdgcn_readfirstlane(tid >> 6), l31 = lane & 31, hi = lane >> 5;
    LAS bf16_t* Ft = (LAS bf16_t*)lds; LAS bf16_t* Dt = (LAS bf16_t*)(lds + DT_OFF);
    for (int item = i0; item < (dry >= 5 ? 0 : ihi); item += istep) {
        const int tb = item * 64, t0 = tb & (SEQ - 1), bidx = tb / SEQ;
        if (pcnt) { const int pm = item >> 2, q = item & 3; unsigned* tmo = (unsigned*)(a_in.ws() + WS_CTL) + 8;
            wait_count(pcnt + 16 * pm, 64u, tmo);
            if (q == 0 && t0 > 0) wait_count(pcnt + 16 * (pm - 1), 64u, tmo);
            if (q == 3 && t0 + 64 < SEQ) wait_count(pcnt + 16 * (pm + 1), 64u, tmo); }
        PArgs a = a_in; asm volatile("" : "+s"(a.kp), "+s"(a.ws_));
        unsigned char* ws = a.ws(); unsigned char* sm = ws + WS_SMALL; bf16_t* PROJ = (bf16_t*)(ws + WS_PROJ); bf16_t* MIX = (bf16_t*)(ws + WS_MIX); const float* ROPE = (const float*)(sm + SM_ROPE);
        int tv = tid; asm volatile("" : "+v"(tv));
        {
            u32x4 raw[10];
#pragma unroll
            for (int it = 0; it < 10; ++it) { const int idx = tv + NTHR * it, chunk = idx & 7, hv = idx >> 3, tok = hv / 10, head = hv - tok * 10;
                const int col = head < 8 ? C_Q + head * 64 : C_K + (head - 8) * 64;
                raw[it] = *(const GAS u32x4*)(PROJ + (size_t)(tb + tok) * INP + col + chunk * 8); }
#pragma unroll
            for (int it = 0; it < 10; ++it) { const int idx = tv + NTHR * it, chunk = idx & 7, hv = idx >> 3, tok = hv / 10, head = hv - tok * 10;
                const int col = head < 8 ? C_Q + head * 64 : C_K + (head - 8) * 64;
                bf16_t* p = PROJ + (size_t)(tb + tok) * INP + col + chunk * 8;
                float x[8]; unpack8(raw[it], x);
                float ss = 0.f;
#pragma unroll
                for (int j = 0; j < 8; ++j) ss += x[j] * x[j];
                ss += __shfl_xor(ss, 1); ss += __shfl_xor(ss, 2); ss += __shfl_xor(ss, 4);
                const float rs = rsqrtf(ss * (1.f / 64.f) + QK_EPS);
                const GAS float* gw = (const GAS float*)(a.in(head < 8 ? I_QN : I_KN) + l * 64 + chunk * 8);
                const int t = t0 + tok, pos = chunk < 4 ? (t >> 6) : (t & 63);
                const GAS float* ct = (const GAS float*)(ROPE + pos * 32 + (chunk & 1) * 8);
                const float sgn = (chunk & 2) ? 1.f : -1.f, qs = head < 8 ? QSCALE : 1.f;
                float y[8], o[8];
#pragma unroll
                for (int j = 0; j < 8; ++j) y[j] = x[j] * rs * gw[j];
#pragma unroll
                for (int j = 0; j < 8; ++j) { const float yp = __shfl_xor(y[j], 2); o[j] = (y[j] * ct[j] + sgn * yp * ct[16 + j]) * qs; }
                if (!dry) *(GAS u32x4*)p = pack8(o); }
        }
        asm volatile("" ::: "memory");
        if (tv < 480) {
            const int ch8 = tv % 120, tg = tv / 120, c = ch8 * 8;
            float mp[8], mn[8];
#pragma unroll
            for (int j = 0; j < 8; ++j) { mp[j] = ((const GAS float*)a.in(I_MUP))[l * 960 + c + j]; mn[j] = ((const GAS float*)a.in(I_MUN))[l * 960 + c + j]; }
            const int mode = (c >= 768 && c < 832) ? 1 : (c >= 896 ? 2 : 0);
#pragma unroll
            for (int hf = 0; hf < 2; ++hf) {
                asm volatile("" ::: "memory");
                const int tk0 = tg * 16 + hf * 8;
                u32x4 rw[10];
#pragma unroll
                for (int r = 0; r < 10; ++r) { const int t = t0 + tk0 - 1 + r;
                    rw[r] = (t >= 0 && t < SEQ) ? *(const GAS u32x4*)(PROJ + (size_t)(tb + tk0 - 1 + r) * INP + C_RW + c) : (u32x4){0u, 0u, 0u, 0u}; }
#pragma unroll
                for (int k = 0; k < 8; ++k) { float pp[8], p[8], pn[8], f[8]; unpack8(rw[k], pp); unpack8(rw[k + 1], p); unpack8(rw[k + 2], pn);
#pragma unroll
                    for (int j = 0; j < 8; ++j) f[j] = p[j] + mp[j] * (pp[j] - p[j]) + mn[j] * (pn[j] - p[j]);
                    if (mode == 1) {
#pragma unroll
                        for (int j = 0; j < 8; ++j) f[j] = 1.f - 2.f * __builtin_amdgcn_rcpf(__expf(2.f * f[j]) + 1.f);
                    } else if (mode == 2) {
#pragma unroll
                        for (int j = 0; j < 8; ++j) f[j] = sigmoidf_(f[j]);
                    }
                    *(LAS u32x4*)(Ft + (tk0 + k) * FT_STRIDE + c) = pack8(f); }
            }
        }
        asm volatile("" ::: "memory");
#pragma unroll 1
        for (int it = 0; it < 4; ++it) {
            asm volatile("" ::: "memory");
            const int idx = tv + NTHR * it, tok = idx >> 5, ch8 = idx & 31, g = ch8 >> 3, w = 2 << g, t = t0 + tok;
            const bf16_t* base = PROJ + (size_t)(bidx * SEQ) * INP + ch8 * 8;
            u32x4 rw[16];
#pragma unroll
            for (int i = 0; i < 16; ++i) { const int r = t - (w >> 1) + i; rw[i] = (i < w && r >= 0 && r < SEQ) ? *(const GAS u32x4*)(base + (size_t)r * INP) : (u32x4){0u, 0u, 0u, 0u}; }
            const u32x4 ur = *(const GAS u32x4*)(base + (size_t)t * INP);
            float acc[8] = {0.f, 0.f, 0.f, 0.f, 0.f, 0.f, 0.f, 0.f};
#pragma unroll
            for (int i = 0; i < 16; ++i) { float v[8]; unpack8(rw[i], v);
#pragma unroll
                for (int j = 0; j < 8; ++j) acc[j] += v[j]; }
            const int lo = max(t - (w >> 1), 0), hiw = min(t + (w >> 1), SEQ);
            float u[8]; unpack8(ur, u);
            const float inv = 1.f / (float)(hiw - lo);
            float d[8];
#pragma unroll
            for (int j = 0; j < 8; ++j) d[j] = acc[j] * inv - u[j];
            *(LAS u32x4*)(Dt + tok * DT_STRIDE + ch8 * 8) = pack8(d);
        }
        __syncthreads();
        if (dry != 2) {
        const int th = wave & 1, hd = wave >> 1, tokl = 32 * th + l31;
        const int ce = 64 * hd + 2 * l31;
#define TOKR(r) (32 * th + ((r) & 3) + 8 * ((r) >> 2) + 4 * hi)
        {
            const bf16_t* PWT = (const bf16_t*)(sm + SM_PWT) + (size_t)(l * 4 + hd) * 4096;
            f32x16 pe = f32x16{}, po = f32x16{};
#pragma unroll
            for (int s = 0; s < 4; ++s) { const bf16x8 A = *(const LAS bf16x8*)(Dt + tokl * DT_STRIDE + 64 * hd + 16 * s + 8 * hi);
                pe = __builtin_amdgcn_mfma_f32_32x32x16_bf16(A, *(const GAS bf16x8*)(PWT + (2 * l31) * 64 + 16 * s + 8 * hi), pe, 0, 0, 0);
                po = __builtin_amdgcn_mfma_f32_32x32x16_bf16(A, *(const GAS bf16x8*)(PWT + (2 * l31 + 1) * 64 + 16 * s + 8 * hi), po, 0, 0, 0); }
            const f32x2 sc = *(const GAS f32x2*)(a.in(I_POOLS) + l * 256 + ce);
#pragma unroll
            for (int r = 0; r < 16; ++r) *(GAS unsigned*)(MIX + (size_t)(tb + TOKR(r)) * DM + ce) = cvtpk(pe[r] * sc[0], po[r] * sc[1]);
        }
        {
            const LAS bf16_t* Frow = Ft + tokl * FT_STRIDE;
            const int bh = bidx * 4 + hd; const size_t hbase = ((size_t)bh * SEQ + t0) * 64 + 2 * l31;
            const f32x2 kkw = *(const GAS f32x2*)(a.in(I_KK) + l * 256 + ce), kaw = *(const GAS f32x2*)(a.in(I_KA) + l * 256 + ce), rkw = *(const GAS f32x2*)(a.in(I_RK) + l * 256 + ce);
            const bf16_t* WUPT = (const bf16_t*)(sm + SM_WUPT) + (size_t)l * 2 * 256 * 32; const bf16_t* AUPT = (const bf16_t*)(sm + SM_AUPT) + (size_t)l * 2 * 256 * 32;
            const bf16_t* GUPT = (const bf16_t*)(sm + SM_GUPT) + (size_t)l * 256 * 64;
            const int ne = ce, no = ce + 1;
            unsigned kp[16];
            float invn[16];
#pragma unroll
            for (int r = 0; r < 16; ++r) { kp[r] = *(const LAS unsigned*)(Ft + TOKR(r) * FT_STRIDE + 256 + ce);
                const float ve = bflo(kp[r]) * kkw[0], vo = bfhi(kp[r]) * kkw[1]; float q = ve * ve + vo * vo;
                q = red16(q); q += __shfl_xor(q, 16); invn[r] = 1.f / fmaxf(sqrtf(q), 1e-12f); }
            asm volatile("" ::: "memory"); __builtin_amdgcn_sched_barrier(0);
            {
                f32x16 d0e = f32x16{}, d0o = f32x16{}, d1e = f32x16{}, d1o = f32x16{};
#pragma unroll
                for (int s = 0; s < 2; ++s) { const int ko = 16 * s + 8 * hi; const bf16x8 A0 = *(const LAS bf16x8*)(Frow + 768 + ko), A1 = *(const LAS bf16x8*)(Frow + 800 + ko);
                    d0e = __builtin_amdgcn_mfma_f32_32x32x16_bf16(A0, *(const GAS bf16x8*)(WUPT + (0 * 256 + ne) * 32 + ko), d0e, 0, 0, 0);
                    d0o = __builtin_amdgcn_mfma_f32_32x32x16_bf16(A0, *(const GAS bf16x8*)(WUPT + (0 * 256 + no) * 32 + ko), d0o, 0, 0, 0);
                    d1e = __builtin_amdgcn_mfma_f32_32x32x16_bf16(A1, *(const GAS bf16x8*)(WUPT + (1 * 256 + ne) * 32 + ko), d1e, 0, 0, 0);
                    d1o = __builtin_amdgcn_mfma_f32_32x32x16_bf16(A1, *(const GAS bf16x8*)(WUPT + (1 * 256 + no) * 32 + ko), d1o, 0, 0, 0); }
                const f32x2 w00 = *(const GAS f32x2*)(a.in(I_W0) + (l * 2 + 0) * 256 + ce), w01 = *(const GAS f32x2*)(a.in(I_W0) + (l * 2 + 1) * 256 + ce);
#pragma unroll
                for (int r = 0; r < 16; ++r) { const size_t o = hbase + (size_t)TOKR(r) * 64;
                    const f32x2 x0 = {__expf(-0.6065306597126334f * sigmoidf_(w00[0] + d0e[r])), __expf(-0.6065306597126334f * sigmoidf_(w00[1] + d0o[r]))};
                    const f32x2 x1 = {__expf(-0.6065306597126334f * sigmoidf_(w01[0] + d1e[r])), __expf(-0.6065306597126334f * sigmoidf_(w01[1] + d1o[r]))};
                    typedef _Float16 h2_t __attribute__((ext_vector_type(2)));
                    const unsigned p0 = __builtin_bit_cast(unsigned, (h2_t){(_Float16)x0[0], (_Float16)x0[1]}), p1 = __builtin_bit_cast(unsigned, (h2_t){(_Float16)x1[0], (_Float16)x1[1]});
                    if (dry != 3) { *(GAS unsigned*)((unsigned short*)(ws + WS_WH0) + o) = p0; *(GAS unsigned*)((unsigned short*)(ws + WS_WH1) + o) = p1; } else asm volatile("" :: "v"(p0), "v"(p1)); }
            }
            asm volatile("" ::: "memory"); __builtin_amdgcn_sched_barrier(0);
            {
                f32x16 a0e = f32x16{}, a0o = f32x16{}, a1e = f32x16{}, a1o = f32x16{};
#pragma unroll
                for (int s = 0; s < 2; ++s) { const int ko = 16 * s + 8 * hi; const bf16x8 A0 = *(const LAS bf16x8*)(Frow + 832 + ko), A1 = *(const LAS bf16x8*)(Frow + 864 + ko);
                    a0e = __builtin_amdgcn_mfma_f32_32x32x16_bf16(A0, *(const GAS bf16x8*)(AUPT + (0 * 256 + ne) * 32 + ko), a0e, 0, 0, 0);
                    a0o = __builtin_amdgcn_mfma_f32_32x32x16_bf16(A0, *(const GAS bf16x8*)(AUPT + (0 * 256 + no) * 32 + ko), a0o, 0, 0, 0);
                    a1e = __builtin_amdgcn_mfma_f32_32x32x16_bf16(A1, *(const GAS bf16x8*)(AUPT + (1 * 256 + ne) * 32 + ko), a1e, 0, 0, 0);
                    a1o = __builtin_amdgcn_mfma_f32_32x32x16_bf16(A1, *(const GAS bf16x8*)(AUPT + (1 * 256 + no) * 32 + ko), a1o, 0, 0, 0); }
                const f32x2 b00 = *(const GAS f32x2*)(a.in(I_A0) + (l * 2 + 0) * 256 + ce), b01 = *(const GAS f32x2*)(a.in(I_A0) + (l * 2 + 1) * 256 + ce);
                GAS float* bsp = (GAS float*)(ws + WS_BON) + (size_t)bh * SEQ + t0 + 32 * th + 4 * hi; float bsacc = 0.f;
#define ST2(base, lo_, hi_) do { const unsigned _o = cvtpk(lo_, hi_); if (dry != 3) *(GAS unsigned*)((bf16_t*)(ws + (base)) + o) = _o; else asm volatile("" :: "v"(_o)); } while (0)
#pragma unroll
                for (int r = 0; r < 16; ++r) { const size_t o = hbase + (size_t)TOKR(r) * 64;
                    const unsigned rp = *(const LAS unsigned*)(Ft + TOKR(r) * FT_STRIDE + ce);
                    const float ke = bflo(kp[r]), ko_ = bfhi(kp[r]), re = bflo(rp), ro = bfhi(rp);
                    const float s0e = sigmoidf_(b00[0] + a0e[r]), s0o = sigmoidf_(b00[1] + a0o[r]), s1e = sigmoidf_(b01[0] + a1e[r]), s1o = sigmoidf_(b01[1] + a1o[r]);
                    const float kke = ke * kkw[0] * invn[r], kko = ko_ * kkw[1] * invn[r];
                    const float h0e = ke * (1.f + (s0e - 1.f) * kaw[0]), h0o = ko_ * (1.f + (s0o - 1.f) * kaw[1]), h1e = ke * (1.f + (s1e - 1.f) * kaw[0]), h1o = ko_ * (1.f + (s1o - 1.f) * kaw[1]);
                    float bs = re * (h0e + h1e) * rkw[0] + ro * (h0o + h1o) * rkw[1];
                    bs = red16(bs); bs += __shfl_xor(bs, 16);
                    const unsigned vp = *(const LAS unsigned*)(Ft + TOKR(r) * FT_STRIDE + 512 + ce);
                    if (dry != 3) *(GAS unsigned*)((bf16_t*)(ws + WS_V) + o) = vp; else asm volatile("" :: "v"(vp));
                    bsacc = (l31 == r) ? bs : bsacc;
                    { const unsigned kkp = cvtpk(kke, kko);
                      const u32x4 c0 = {cvtpk(kke * s0e, kko * s0o), cvtpk(h0e, h0o), kkp, rp}, c1 = {cvtpk(kke * s1e, kko * s1o), cvtpk(h1e, h1o), kkp, rp};
                      if (dry != 3) { *(GAS u32x4*)((unsigned char*)(ws + WS_FC0) + 8 * o) = c0; *(GAS u32x4*)((unsigned char*)(ws + WS_FC1) + 8 * o) = c1; } else asm volatile("" :: "v"(c0), "v"(c1)); } }
                if (l31 < 16) bsp[(l31 & 3) + 8 * (l31 >> 2)] = bsacc;
            }
            asm volatile("" ::: "memory"); __builtin_amdgcn_sched_barrier(0);
            {
                f32x16 ge = f32x16{}, go = f32x16{};
#pragma unroll
                for (int s = 0; s < 4; ++s) { const int ko = 16 * s + 8 * hi; const bf16x8 A0 = *(const LAS bf16x8*)(Frow + 896 + ko);
                    ge = __builtin_amdgcn_mfma_f32_32x32x16_bf16(A0, *(const GAS bf16x8*)(GUPT + ne * 64 + ko), ge, 0, 0, 0);
                    go = __builtin_amdgcn_mfma_f32_32x32x16_bf16(A0, *(const GAS bf16x8*)(GUPT + no * 64 + ko), go, 0, 0, 0); }
#pragma unroll
                for (int r = 0; r < 16; ++r) { const size_t o = hbase + (size_t)TOKR(r) * 64;
                    ST2(WS_G, ge[r], go[r]); }
#undef ST2
            }
        }
#undef TOKR
        }
        __syncthreads();
    }
    asm volatile("s_waitcnt vmcnt(0)" ::: "memory");
    __syncthreads();
    if (dry != 2 && dry != 4) {
#pragma unroll 1
        for (int item = i0; item < ihi; item += istep) {
            const int tb = item * 64, t0 = tb & (SEQ - 1), bidx = tb / SEQ;
#pragma unroll 1
            for (int q4 = 0; q4 < 4; ++q4) { const int itx = wave * 4 + q4, hd2 = itx & 3, qb = (itx >> 2) & 3, dir = itx >> 4;
                const int c0 = (t0 >> 4) + qb;
                int lz = lane; asm volatile("" : "+v"(lz));
                scan_pre_item(a_in, (LAS bf16_t*)(lds + wave * 8192), bidx * 4 + hd2, dir, dir ? 127 - c0 : c0, lz, dry >= 5 ? dry - 5 : 0); }
        }
    }
    __syncthreads();
}

typedef _Float16 h16x8 __attribute__((ext_vector_type(8)));
typedef _Float16 h16x4 __attribute__((ext_vector_type(4)));
constexpr int SC_CHUNK = 16, SC_NCH = SEQ / SC_CHUNK, SC_STEPB = 768  , SC_BUFB = SC_CHUNK * SC_STEPB, SC_YOFF = 2 * SC_BUFB, SC_YB = SC_CHUNK * 512 * 4;
static_assert(SC_YOFF + 2 * SC_YB <= LDSCTL_OFF, "scan LDS");
__device__ __forceinline__ float fmix_lo(float a, unsigned pk, float c) { float d; asm("v_fma_mix_f32 %0, %1, %2, %3 op_sel:[0,0,0] op_sel_hi:[0,1,0]" : "=v"(d) : "v"(a), "v"(pk), "v"(c)); return d; }
__device__ __forceinline__ float fmix_hi(float a, unsigned pk, float c) { float d; asm("v_fma_mix_f32 %0, %1, %2, %3 op_sel:[0,1,0] op_sel_hi:[0,1,0]" : "=v"(d) : "v"(a), "v"(pk), "v"(c)); return d; }
__device__ __forceinline__ float fmixn_lo(float a, unsigned pk, float c) { float d; asm("v_fma_mix_f32 %0, -%1, %2, %3 op_sel:[0,0,0] op_sel_hi:[0,1,0]" : "=v"(d) : "v"(a), "v"(pk), "v"(c)); return d; }
__device__ __forceinline__ float fmixn_hi(float a, unsigned pk, float c) { float d; asm("v_fma_mix_f32 %0, -%1, %2, %3 op_sel:[0,1,0] op_sel_hi:[0,1,0]" : "=v"(d) : "v"(a), "v"(pk), "v"(c)); return d; }
__device__ __forceinline__ unsigned h2pack(float lo, float hi) { typedef _Float16 h2 __attribute__((ext_vector_type(2))); h2 v = {(_Float16)lo, (_Float16)hi}; return __builtin_bit_cast(unsigned, v); }
struct ScOp { u32x4 q0, q1; u32x2 q2; unsigned short v; };
template <int DIR, int VAR>
__device__ __forceinline__ void scan_item(const PArgs& a, LAS unsigned char* lds, int bh, int half, int dummy) {
    unsigned char* ws = a.ws();
    int tid_ = threadIdx.x; asm volatile("" : "+v"(tid_)); const int tid = tid_, lane = tid & 63, wave = __builtin_amdgcn_readfirstlane(tid >> 6), c4 = lane & 15;
    const int irow = 32 * half + 4 * wave + (lane >> 4);
    const size_t hb = (size_t)bh * SEQ * 64;
    const bf16_t* gKK = (const bf16_t*)(ws + WS_KK) + hb; const bf16_t* gB = (const bf16_t*)(ws + WS_B + (size_t)DIR * 16 * MiB) + hb;
    const bf16_t* gKH = (const bf16_t*)(ws + WS_KH + (size_t)DIR * 16 * MiB) + hb; const bf16_t* gR = (const bf16_t*)(ws + WS_R) + hb; const bf16_t* gV = (const bf16_t*)(ws + WS_V) + hb;
    const float* gW = (const float*)(ws + WS_W + (size_t)DIR * 32 * MiB) + hb;
    float* gY = (float*)(ws + (dummy ? 950 * MiB : WS_WKV) + (size_t)DIR * 32 * MiB) + hb;
    const int sst = tid >> 4, sq = tid & 15; const size_t so = (size_t)sst * 64 + sq * 4; const int sd = sst * SC_STEPB + sq * 16;
    const int vt = tid - 256; const size_t vo = (size_t)(vt >> 3) * 64 + (vt & 7) * 8; const int vd = (vt >> 3) * SC_STEPB + 640 + (vt & 7) * 16;
    u32x2 rkk = {}, rb = {}, rkh = {}, rr = {}; f32x4 rw = {}; u32x4 rv = {};
#define SC_T0(cidx) (DIR ? SEQ - SC_CHUNK * ((cidx) + 1) : SC_CHUNK * (cidx))
#define SC_LOAD(cidx) do { const size_t _o = (size_t)SC_T0(cidx) * 64; \
        if (tid < 256) { rkk = *(const GAS u32x2*)(gKK + _o + so); rb = *(const GAS u32x2*)(gB + _o + so); rkh = *(const GAS u32x2*)(gKH + _o + so); rr = *(const GAS u32x2*)(gR + _o + so); rw = *(const GAS f32x4*)(gW + _o + so); } \
        else if (tid < 384) rv = *(const GAS u32x4*)(gV + _o + vo); } while (0)
#define SC_H4(vv) (u32x2){h2pack(bflo((vv)[0]), bfhi((vv)[0])), h2pack(bflo((vv)[1]), bfhi((vv)[1]))}
#define SC_STORE(bufb) do { if (tid < 256) { const u32x2 _a = SC_H4(rkk), _b = SC_H4(rb), _c = SC_H4(rkh), _d = SC_H4(rr); \
            *(LAS u32x4*)(lds + (bufb) + sd) = (u32x4){_a.x, _a.y, _b.x, _b.y}; *(LAS u32x4*)(lds + (bufb) + sd + 256) = (u32x4){_c.x, _c.y, _d.x, _d.y}; \
            *(LAS u32x2*)(lds + (bufb) + sst * SC_STEPB + 512 + sq * 8) = (u32x2){h2pack(rw[0], rw[1]), h2pack(rw[2], rw[3])}; } \
        else if (tid < 384) { *(LAS u32x4*)(lds + (bufb) + vd) = (u32x4){h2pack(bflo(rv.x), bfhi(rv.x)), h2pack(bflo(rv.y), bfhi(rv.y)), h2pack(bflo(rv.z), bfhi(rv.z)), h2pack(bflo(rv.w), bfhi(rv.w))}; } } while (0)
#define SC_RD(op, p) do { (op).q0 = *(const LAS u32x4*)((p) + 16 * c4); (op).q1 = *(const LAS u32x4*)((p) + 256 + 16 * c4); (op).q2 = *(const LAS u32x2*)((p) + 512 + 8 * c4); \
        (op).v = *(const LAS unsigned short*)((p) + 640 + 2 * irow); } while (0)
    const int fl_step = tid >> 5, fl_row = tid & 31;
#define SC_FLUSH(ybufb, t0) do { const LAS float* _q = (const LAS float*)(lds + (ybufb)) + fl_step * 512 + fl_row * 16; f32x4 _s = {0.f, 0.f, 0.f, 0.f}; \
        _Pragma("unroll") for (int _k = 0; _k < 4; ++_k) { const int _c = (_k + (tid >> 2)) & 3; _s += *(const LAS f32x4*)(_q + 4 * _c); } \
        ((GAS float*)gY)[(size_t)((t0) + fl_step) * 64 + 32 * half + fl_row] = (_s[0] + _s[1]) + (_s[2] + _s[3]); } while (0)
    SC_LOAD(0); SC_STORE(0);
    __syncthreads();
    float S0 = 0.f, S1 = 0.f, S2 = 0.f, S3 = 0.f;
#pragma unroll 1
    for (int cidx = 0; cidx < SC_NCH; ++cidx) {
        const int cb = cidx & 1;
        if (cidx + 1 < SC_NCH && VAR != 4) SC_LOAD(cidx + 1);
        if (cidx > 0 && VAR != 4 && VAR != 3) SC_FLUSH(SC_YOFF + (cb ^ 1) * SC_YB, SC_T0(cidx - 1));
        const LAS unsigned char* buf = lds + cb * SC_BUFB;
        LAS float* yb = (LAS float*)(lds + SC_YOFF + cb * SC_YB) + tid;
        ScOp cur, nxt;
        SC_RD(nxt, buf + (DIR ? SC_CHUNK - 1 : 0) * SC_STEPB);
#pragma unroll
        for (int jj = 0; jj < SC_CHUNK; ++jj) {
            const int s = DIR ? SC_CHUNK - 1 - jj : jj;
            cur = nxt;
            if (jj + 1 < SC_CHUNK && VAR != 2) { SC_RD(nxt, buf + (DIR ? s - 1 : s + 1) * SC_STEPB); }
            __builtin_amdgcn_sched_barrier(0);
            const float dot = fmix_hi(S1, cur.q0.x, fmix_lo(S0, cur.q0.x, 0.f)) + fmix_hi(S3, cur.q0.y, fmix_lo(S2, cur.q0.y, 0.f));
            const float vi = (float)__builtin_bit_cast(_Float16, cur.v);
            const float u0 = fmix_lo(S0, cur.q2.x, fmix_lo(vi, cur.q1.x, 0.f)), u1 = fmix_hi(S1, cur.q2.x, fmix_hi(vi, cur.q1.x, 0.f));
            const float u2 = fmix_lo(S2, cur.q2.y, fmix_lo(vi, cur.q1.y, 0.f)), u3 = fmix_hi(S3, cur.q2.y, fmix_hi(vi, cur.q1.y, 0.f));
            const float sk = VAR == 1 ? dot : red16(dot);
            S0 = fmixn_lo(sk, cur.q0.z, u0); S1 = fmixn_hi(sk, cur.q0.z, u1); S2 = fmixn_lo(sk, cur.q0.w, u2); S3 = fmixn_hi(sk, cur.q0.w, u3);
            { const float yv = fmix_hi(S1, cur.q1.z, fmix_lo(S0, cur.q1.z, 0.f)) + fmix_hi(S3, cur.q1.w, fmix_lo(S2, cur.q1.w, 0.f)); if (VAR == 3) { if (jj == SC_CHUNK - 1) yb[s * 512] = yv; else asm volatile("" :: "v"(yv)); } else yb[s * 512] = yv; }
        }
        if (cidx + 1 < SC_NCH && VAR != 4) SC_STORE((cb ^ 1) * SC_BUFB);
        if (VAR != 5) __syncthreads();
    }
    SC_FLUSH(SC_YOFF + ((SC_NCH & 1) ^ 1) * SC_YB, SC_T0(SC_NCH - 1));
    __syncthreads();
#undef SC_T0
#undef SC_LOAD
#undef SC_H4
#undef SC_STORE
#undef SC_RD
#undef SC_FLUSH
}
#ifndef PROBE_SCANVAR
#define PROBE_SCANVAR 0
#endif
__device__ __forceinline__ void phase_scan(const PArgs& a, LAS unsigned char* lds, int dummy) {
    for (int item = blockIdx.x; item < 256; item += gridDim.x) {
        const int half = item & 1, dir = (item >> 1) & 1, bh = item >> 2;
        if (dummy) { if (dir) scan_item<1, PROBE_SCANVAR>(a, lds, bh, half, 1); else scan_item<0, PROBE_SCANVAR>(a, lds, bh, half, 1); }
        else { if (dir) scan_item<1, 0>(a, lds, bh, half, 0); else scan_item<0, 0>(a, lds, bh, half, 0); }
    }
}

constexpr int RING_D = 4, RING_FLAGS = 2 * RING_D * 13568;
__device__ __forceinline__ void scan_serial_wave(const PArgs& a, int bh, int dir, int it, int lane, LAS unsigned char* ring, volatile LAS int* flg) {
    unsigned char* ws = a.ws();
    const int l31 = lane & 31, hi = lane >> 5;
    GAS float* gY = (GAS float*)(ws + WS_WKV + (size_t)dir * 32 * MiB) + (size_t)bh * SEQ * 64 + 32 * it + l31;
    f32x16 ST0 = f32x16{}, ST1 = f32x16{};
#define SS_ISSUE(P, cc) do { { unsigned _sp = 0; while (flg[0] <= (cc) && ++_sp < 2000000u) __builtin_amdgcn_s_sleep(1); } asm volatile("" ::: "memory"); \
        const LAS unsigned char* _r = ring + ((cc) & (RING_D - 1)) * 13568 + lane * 16; \
        _Pragma("unroll") for (int _k = 0; _k < 5; ++_k) P##aop[_k] = *(const LAS bf16x8*)(_r + REC_AOP + _k * 1024); \
        P##vt = *(const LAS bf16x8*)(_r + REC_VT + it * 1024); \
        _Pragma("unroll") for (int _k = 0; _k < 2; ++_k) P##ay[_k] = *(const LAS bf16x8*)(_r + REC_AY + _k * 1024); \
        _Pragma("unroll") for (int _k = 0; _k < 4; ++_k) P##as[_k] = *(const LAS bf16x8*)(_r + REC_AS + _k * 1024); \
        __builtin_amdgcn_sched_barrier(0); } while (0)
#define SS_RELEASE(cc) do { asm volatile("s_waitcnt lgkmcnt(0)" ::: "memory"); __builtin_amdgcn_sched_barrier(0); \
        if (lane == 0) __hip_atomic_fetch_add((LAS int*)&flg[4 + ((cc) & (RING_D - 1))], 1, __ATOMIC_RELAXED, __HIP_MEMORY_SCOPE_WORKGROUP); } while (0)
#define SS_BODY(P, cc) do { \
        f32x4 gc_[8]; { const LAS unsigned char* _g = ring + ((cc) & (RING_D - 1)) * 13568 + REC_GC + hi * 64; \
          _Pragma("unroll") for (int _k = 0; _k < 8; ++_k) gc_[_k] = *(const LAS f32x4*)(_g + ((_k >> 2) * 32 + (_k & 3) * 4) * 4); } \
        f32x16 UQ = f32x16{}; \
        { float f[8]; \
          _Pragma("unroll") for (int s_ = 0; s_ < 2; ++s_) { _Pragma("unroll") for (int jj = 0; jj < 8; ++jj) f[jj] = ST0[8 * s_ + jj]; \
            UQ = __builtin_amdgcn_mfma_f32_32x32x16_bf16(P##aop[s_], pack_frag(f), UQ, 0, 0, 0); } \
          _Pragma("unroll") for (int s_ = 0; s_ < 2; ++s_) { _Pragma("unroll") for (int jj = 0; jj < 8; ++jj) f[jj] = ST1[8 * s_ + jj]; \
            UQ = __builtin_amdgcn_mfma_f32_32x32x16_bf16(P##aop[2 + s_], pack_frag(f), UQ, 0, 0, 0); } } \
        UQ = __builtin_amdgcn_mfma_f32_32x32x16_bf16(P##aop[4], P##vt, UQ, 0, 0, 0); \
        bf16x8 Uf; { float f[8]; _Pragma("unroll") for (int jj = 0; jj < 8; ++jj) f[jj] = UQ[jj]; Uf = pack_frag(f); } \
        f32x16 Y = f32x16{}; \
        _Pragma("unroll") for (int r = 0; r < 8; ++r) Y[r] = UQ[8 + r]; \
        Y = __builtin_amdgcn_mfma_f32_32x32x16_bf16(P##ay[0], Uf, Y, 0, 0, 0); \
        Y = __builtin_amdgcn_mfma_f32_32x32x16_bf16(P##ay[1], P##vt, Y, 0, 0, 0); \
        _Pragma("unroll") for (int q = 0; q < 4; ++q) _Pragma("unroll") for (int e = 0; e < 4; ++e) { ST0[4 * q + e] *= gc_[q][e]; ST1[4 * q + e] *= gc_[4 + q][e]; } \
        ST0 = __builtin_amdgcn_mfma_f32_32x32x16_bf16(P##as[0], Uf, ST0, 0, 0, 0); ST0 = __builtin_amdgcn_mfma_f32_32x32x16_bf16(P##as[1], P##vt, ST0, 0, 0, 0); \
        ST1 = __builtin_amdgcn_mfma_f32_32x32x16_bf16(P##as[2], Uf, ST1, 0, 0, 0); ST1 = __builtin_amdgcn_mfma_f32_32x32x16_bf16(P##as[3], P##vt, ST1, 0, 0, 0); \
        _Pragma("unroll") for (int r = 0; r < 8; ++r) { const int t = 16 * (cc) + (r & 3) + 8 * (r >> 2) + 4 * hi; const int tt = dir ? SEQ - 1 - t : t; gY[(size_t)tt * 64] = Y[r]; } } while (0)
    bf16x8 A_aop[5], A_vt, A_ay[2], A_as[4];
    bf16x8 B_aop[5], B_vt, B_ay[2], B_as[4];
    SS_ISSUE(A_, 0);
#pragma unroll 1
    for (int c = 0; c < 128; c += 2) {
        SS_ISSUE(B_, c + 1);
        SS_BODY(A_, c);
        SS_RELEASE(c);
        if (c + 2 < 128) SS_ISSUE(A_, c + 2);
        SS_BODY(B_, c + 1);
        SS_RELEASE(c + 1);
    }
#undef SS_ISSUE
#undef SS_RELEASE
#undef SS_BODY

}

__device__ __forceinline__ void glds4(const void* gsrc, unsigned lds_dst) { unsigned keep;
    asm volatile("s_mov_b32 %0, m0\n\ts_mov_b32 m0, %2\n\ts_nop 0\n\tglobal_load_lds_dword %1, off\n\ts_mov_b32 m0, %0" : "=&s"(keep) : "v"(gsrc), "s"(lds_dst) : "memory"); }
__device__ __forceinline__ void scan_loader_wave(const PArgs& a, int bh, int dir, int lane, LAS unsigned char* ring, volatile LAS int* flg) {
    unsigned char* ws = a.ws();
    const unsigned char* rec0 = ws + WS_REC + (size_t)((bh * 2 + dir) * 128) * REC_BYTES;
    const unsigned ring0 = (unsigned)(uintptr_t)ring;
#pragma unroll 1
    for (int c = 0; c < 128; ++c) {
        const int slot = c & (RING_D - 1);
        if (c >= RING_D) { unsigned sp = 0; while (flg[4 + slot] < 2 * (c / RING_D) && ++sp < 2000000u) __builtin_amdgcn_s_sleep(1); }
        asm volatile("" ::: "memory");
        const unsigned char* r = rec0 + (size_t)c * REC_BYTES; const unsigned dst = (unsigned)__builtin_amdgcn_readfirstlane(ring0 + slot * 13568);
#pragma unroll
        for (int k = 0; k < 13; ++k) { const int off = k < 5 ? REC_AOP + k * 1024 : k < 7 ? REC_AY + (k - 5) * 1024 : k < 11 ? REC_AS + (k - 7) * 1024 : REC_VT + (k - 11) * 1024;
            attn_body::glds16(r + off + lane * 16, dst + off); }
        glds4(r + REC_GC + lane * 4, dst + REC_GC);
        asm volatile("s_waitcnt vmcnt(14)" ::: "memory");
        if (lane == 0) flg[0] = c;
    }
    asm volatile("s_waitcnt vmcnt(0)" ::: "memory");
    if (lane == 0) flg[0] = 128;
}

constexpr int AQ_LDS = 100000;
__device__ __forceinline__ void rwkv_post(const PArgs& a, int l, int hv0, int nhv, int wave, int lane) {
    unsigned char* ws = a.ws();
    const int sub = lane >> 4, c4 = lane & 15;
    bf16_t* MIX = (bf16_t*)(ws + WS_MIX);
    for (int it = wave; it < nhv / 4; it += NWAVES) {
        const size_t hv = (size_t)hv0 + (size_t)it * 4 + sub; const size_t o = hv * 64 + 4 * c4;
        const f32x4 f = *(const GAS f32x4*)((const float*)(ws + WS_WKV) + o), bk = *(const GAS f32x4*)((const float*)(ws + WS_WKV + 32 * MiB) + o);
        float g4[4], bo[4]; unpack4(*(const GAS u32x2*)((const bf16_t*)(ws + WS_G) + o), g4); unpack4(*(const GAS u32x2*)((const bf16_t*)(ws + WS_V) + o), bo);
        { const float bs = ((const GAS float*)(ws + WS_BON))[hv];
#pragma unroll
          for (int e = 0; e < 4; ++e) bo[e] *= bs; }
        const f32x4 x = f + bk;
        const float mean = red16((x[0] + x[1]) + (x[2] + x[3])) * (1.f / 64.f);
        const f32x4 d = x - mean;
        const float var = red16((d[0] * d[0] + d[1] * d[1]) + (d[2] * d[2] + d[3] * d[3])) * (1.f / 64.f);
        const float rs = rsqrtf(var + GN_EPS);
        const int bh = (int)(hv / SEQ), t = (int)(hv % SEQ), bb = bh >> 2, hh = bh & 3, c = 64 * hh + 4 * c4;
        const f32x4 gg = *(const GAS f32x4*)(a.in(I_GNG) + l * 256 + c), gb = *(const GAS f32x4*)(a.in(I_GNB) + l * 256 + c);
        float y[4];
#pragma unroll
        for (int e = 0; e < 4; ++e) y[e] = (d[e] * rs * gg[e] + gb[e] + bo[e]) * g4[e];
        u32x2 ov; ov.x = cvtpk(y[0], y[1]); ov.y = cvtpk(y[2], y[3]);
        *(GAS u32x2*)(MIX + ((size_t)bb * SEQ + t) * DM + 256 + c) = ov;
    }
}
__device__ __forceinline__ void phase_attn_post(const PArgs& a, unsigned char* lds_generic, int l, int bx) {
    unsigned char* ws = a.ws();
    int tid_ = threadIdx.x; asm volatile("" : "+v"(tid_)); const int tid = tid_, lane = tid & 63, wave = __builtin_amdgcn_readfirstlane(tid >> 6);
    if (bx < 64) {
        LAS unsigned char* L = (LAS unsigned char*)lds_generic; volatile LAS int* flags = (volatile LAS int*)(L + RING_FLAGS);
        if (tid < 16) flags[tid] = 0;
        __syncthreads();
        if (wave < 4) scan_serial_wave(a, bx, wave >> 1, wave & 1, lane, L + (wave >> 1) * RING_D * 13568, flags + (wave >> 1) * 8);
        else if (wave < 6) scan_loader_wave(a, bx, wave - 4, lane, L + (wave - 4) * RING_D * 13568, flags + (wave - 4) * 8);
        asm volatile("s_waitcnt vmcnt(0)" ::: "memory");
        __syncthreads();
        rwkv_post(a, l, bx * SEQ, SEQ, wave, lane);
    }
    const attn_body::bf16* PROJ = (const attn_body::bf16*)(ws + WS_PROJ); attn_body::bf16* MIXO = (attn_body::bf16*)(ws + WS_MIX) + 512;
    unsigned* qhead = (unsigned*)(ws + WS_CTL) + CW_AQ + l * 64;
    volatile LAS unsigned* slot = (volatile LAS unsigned*)((LAS unsigned char*)lds_generic + AQ_LDS);
    for (;;) {
        if (tid == 0) *slot = __hip_atomic_fetch_add(qhead, 1u, __ATOMIC_RELAXED, __HIP_MEMORY_SCOPE_AGENT);
        __syncthreads();
        const int uidx = (int)__builtin_amdgcn_readfirstlane(*slot);
        __syncthreads();
        if (uidx >= 1024) break;
        const int grp = uidx >> 5, u = uidx & 31, b = grp >> 1, kvh = grp & 1, h = kvh * 4 + (u >> 3), qb = u & 7;
        attn_body::attn_unit<8>(b, h, kvh, qb, PROJ + C_Q, PROJ + C_K, PROJ + C_V, MIXO, (char*)lds_generic);
    }
}

constexpr int RT_ZROW = 2064;
constexpr int RT_ZH = 0, RT_ZL = 16 * RT_ZROW, RT_PL = 2 * 16 * RT_ZROW, RT_LOGS = RT_PL + 8 * 16 * 48 * 4, RT_INFO = RT_LOGS + 16 * 48 * 4;
static_assert(RT_INFO + 4096 <= LDSCTL_OFF, "router LDS");
__device__ __forceinline__ void phase_ln1_router(const PArgs& a, LAS unsigned char* lds, int l, int dry, int grank, const unsigned* pcnt) {
    unsigned char* ws = a.ws();
    int tid_ = threadIdx.x; asm volatile("" : "+v"(tid_)); const int tid = tid_, lane = tid & 63, wave = __builtin_amdgcn_readfirstlane(tid >> 6);
    const float* Z = (const float*)(ws + WS_Z); bf16_t* XN = (bf16_t*)(ws + WS_XN);
    LAS unsigned char* ZH = lds + RT_ZH; LAS unsigned char* ZL = lds + RT_ZL; LAS float* PL = (LAS float*)(lds + RT_PL); LAS float* LOG = (LAS float*)(lds + RT_LOGS);
    LAS int* inf_e = (LAS int*)(lds + RT_INFO); LAS int* inf_r = inf_e + 256; LAS float* inf_g = (LAS float*)(inf_r + 256); LAS int* lcnt = (LAS int*)(inf_g + 256); LAS int* lbase = lcnt + 32;
    if (tid < 32) lcnt[tid] = 0;
    __syncthreads();
    const bf16_t* RWH = (const bf16_t*)(ws + WS_RWB) + (size_t)l * 2 * 48 * 1024; const bf16_t* RWL = RWH + 48 * 1024;
    const float* lng = a.in(I_LN1G) + l * DM; const float* lnb = a.in(I_LN1B) + l * DM;
    const int tk = lane & 15, kg = lane >> 4;
    for (int chunk = grank; chunk < NTOK / 128; chunk += gridDim.x) {
        const int tb = chunk * 128;
        bf16x8 Bh[3][4];
#pragma unroll
        for (int nb = 0; nb < 3; ++nb)
#pragma unroll
            for (int s_ = 0; s_ < 4; ++s_) { const size_t wo = (size_t)(16 * nb + tk) * 1024 + 128 * wave + 32 * s_ + 8 * kg; Bh[nb][s_] = *(const GAS bf16x8*)(RWH + wo); }
        if (pcnt) wait_count(pcnt + 16 * (chunk >> 1), 32u, (unsigned*)(ws + WS_CTL) + 8);
        f32x4 xc[2][4];
#define RT_LOAD(X_, sb_) do { _Pragma("unroll") for (int u = 0; u < 2; ++u) _Pragma("unroll") for (int j = 0; j < 4; ++j) \
            X_[u][j] = *(const GAS f32x4*)(Z + (size_t)(tb + (sb_) * 16 + 2 * wave + u) * DM + 4 * lane + 256 * j); } while (0)
#pragma unroll 1
        for (int sb = 0; sb < 8; ++sb) {
            RT_LOAD(xc, sb);
            f32x4 lg[4], lb[4];
#pragma unroll
            for (int j = 0; j < 4; ++j) { lg[j] = *(const GAS f32x4*)(lng + 4 * lane + 256 * j); lb[j] = *(const GAS f32x4*)(lnb + 4 * lane + 256 * j); }
            asm volatile("" ::: "memory");
#pragma unroll
            for (int u = 0; u < 2; ++u) { const int tl = 2 * wave + u; float s = 0.f;
#pragma unroll
                for (int j = 0; j < 4; ++j) s += (xc[u][j][0] + xc[u][j][1]) + (xc[u][j][2] + xc[u][j][3]);
                const float mean = wave_sum(s) * (1.f / DM); float s2 = 0.f;
#pragma unroll
                for (int j = 0; j < 4; ++j) { xc[u][j] = xc[u][j] - mean; s2 += (xc[u][j][0] * xc[u][j][0] + xc[u][j][1] * xc[u][j][1]) + (xc[u][j][2] * xc[u][j][2] + xc[u][j][3] * xc[u][j][3]); }
                const float rstd = rsqrtf(wave_sum(s2) * (1.f / DM) + LN_EPS);
                bf16_t* xr = XN + (size_t)(tb + sb * 16 + tl) * DM;
#pragma unroll
                for (int j = 0; j < 4; ++j) { const f32x4 nz = xc[u][j] * rstd; const f32x4 v = nz * lg[j] + lb[j];
                    u32x2 o; o.x = cvtpk(v[0], v[1]); o.y = cvtpk(v[2], v[3]); if (!dry) *(GAS u32x2*)(xr + 4 * lane + 256 * j) = o;
                    u32x2 h; h.x = cvtpk(nz[0], nz[1]); h.y = cvtpk(nz[2], nz[3]);
                    u32x2 lo_; lo_.x = cvtpk(nz[0] - bflo(h.x), nz[1] - bfhi(h.x)); lo_.y = cvtpk(nz[2] - bflo(h.y), nz[3] - bfhi(h.y));
                    *(LAS u32x2*)(ZH + tl * RT_ZROW + (4 * lane + 256 * j) * 2) = h; *(LAS u32x2*)(ZL + tl * RT_ZROW + (4 * lane + 256 * j) * 2) = lo_; } }
            __syncthreads();
            { f32x4 acc[3] = {f32x4{0.f, 0.f, 0.f, 0.f}, f32x4{0.f, 0.f, 0.f, 0.f}, f32x4{0.f, 0.f, 0.f, 0.f}};
#pragma unroll
              for (int s_ = 0; s_ < 4; ++s_) { const int co = tk * RT_ZROW + (128 * wave + 32 * s_ + 8 * kg) * 2;
                  const bf16x8 Ah = *(const LAS bf16x8*)(ZH + co), Al = *(const LAS bf16x8*)(ZL + co);
#pragma unroll
                  for (int nb = 0; nb < 3; ++nb) { const bf16x8 Bl_ = *(const GAS bf16x8*)(RWL + (size_t)(16 * nb + tk) * 1024 + 128 * wave + 32 * s_ + 8 * kg);
                      acc[nb] = __builtin_amdgcn_mfma_f32_16x16x32_bf16(Ah, Bh[nb][s_], acc[nb], 0, 0, 0);
                      acc[nb] = __builtin_amdgcn_mfma_f32_16x16x32_bf16(Ah, Bl_, acc[nb], 0, 0, 0);
                      acc[nb] = __builtin_amdgcn_mfma_f32_16x16x32_bf16(Al, Bh[nb][s_], acc[nb], 0, 0, 0); } }
#pragma unroll
              for (int nb = 0; nb < 3; ++nb)
#pragma unroll
                  for (int r = 0; r < 4; ++r) PL[wave * 768 + (4 * kg + r) * 48 + 16 * nb + tk] = acc[nb][r]; }
            __syncthreads();
            for (int i = tid; i < 768; i += NTHR) { float v = 0.f;
#pragma unroll
                for (int w = 0; w < 8; ++w) v += PL[w * 768 + i];
                LOG[i] = v; }
            __syncthreads();
            if (tid < 16) {
            const LAS float* lt = LOG + lane * 48;
            float gl[4];
#pragma unroll
            for (int g = 0; g < 4; ++g) gl[g] = lt[32 + g] + ((const GAS float*)a.in(I_RGB))[l * 4 + g] + ((const GAS float*)(ws + WS_RB))[l * 48 + 32 + g];
            int grp = 0; float gm = gl[0];
#pragma unroll
            for (int g = 1; g < 4; ++g) if (gl[g] > gm) { gm = gl[g]; grp = g; }
            float den = 0.f;
#pragma unroll
            for (int g = 0; g < 4; ++g) den += __expf(gl[g] - gm);
            const float gwt = 1.f / den;
            float el[8];
#pragma unroll
            for (int j = 0; j < 8; ++j) el[j] = lt[grp * 8 + j] + ((const GAS float*)a.in(I_REB))[l * 32 + grp * 8 + j] + ((const GAS float*)(ws + WS_RB))[l * 48 + grp * 8 + j];
            int i1 = 0; float v1 = el[0];
#pragma unroll
            for (int j = 1; j < 8; ++j) if (el[j] > v1) { v1 = el[j]; i1 = j; }
            int i2 = -1; float v2 = -INFINITY;
#pragma unroll
            for (int j = 0; j < 8; ++j) if (j != i1 && el[j] > v2) { v2 = el[j]; i2 = j; }
            const float e2 = __expf(v2 - v1), g1 = gwt / (1.f + e2), g2 = gwt * e2 / (1.f + e2);
            const int p = (sb * 16 + lane) * 2, ea = grp * 8 + i1, eb = grp * 8 + i2;
            inf_e[p] = ea; inf_g[p] = g1; inf_r[p] = atomicAdd((int*)&lcnt[ea], 1);
            inf_e[p + 1] = eb; inf_g[p + 1] = g2; inf_r[p + 1] = atomicAdd((int*)&lcnt[eb], 1);
        }
        }
#undef RT_LOAD
        __syncthreads();
        unsigned char* ws2 = a.ws_; asm volatile("" : "+s"(ws2)); ws2 = (unsigned char*)(GAS unsigned char*)ws2;
        unsigned* gcnt = (unsigned*)(ws2 + WS_CTL) + CW_CNT + l * 64;
        GAS int* list = (GAS int*)(ws2 + WS_LIST); GAS float* gate = (GAS float*)(ws2 + WS_GLIST);
        if (tid < 32) { const int n = lcnt[tid]; lbase[tid] = (n && !dry) ? (int)atomicAdd(gcnt + tid, (unsigned)n) : 0; lcnt[tid] = 0; }
        __syncthreads();
        if (tid < 256 && !dry) { const int e = inf_e[tid], pos = lbase[e] + inf_r[tid], pair = tb * 2 + tid;
            list[e * LISTCAP + pos] = pair; gate[e * LISTCAP + pos] = inf_g[tid]; }
        __syncthreads();
    }
}

__device__ __forceinline__ int moe_build_tab(const PArgs& a, LAS unsigned char* lds, int l) {
    LAS int* tab = (LAS int*)(lds + MOE_TAB_OFF);
    const unsigned* gcnt = (const unsigned*)(a.ws() + WS_CTL) + CW_CNT + l * 64;
    int tid_ = threadIdx.x; asm volatile("" : "+v"(tid_)); const int tid = tid_;
    if (tid < 64) {
        const int cnt = tid < 32 ? (int)__hip_atomic_load(gcnt + (tid & 31), __ATOMIC_RELAXED, __HIP_MEMORY_SCOPE_AGENT) : 0;
        const int nt = (cnt + 255) >> 8; int inc = nt;
#pragma unroll
        for (int d = 1; d < 32; d <<= 1) { const int o = __shfl_up(inc, d); if (tid >= d) inc += o; }
        const int ts = inc - nt;
        if (tid < 32) { tab[64 + tid] = cnt; tab[tid] = ts; for (int k = 0; k < nt; ++k) tab[128 + ts + k] = tid; if (tid == 31) tab[32] = inc; } }
    __syncthreads();
    return tab[32];
}

__device__ __forceinline__ void phase_ln2(const PArgs& a, int l, int grank, int G, int dry, unsigned* pcnt) {
    unsigned char* ws = a.ws();
    int tid_ = threadIdx.x; asm volatile("" : "+v"(tid_)); const int tid = tid_, lane = tid & 63, wave = __builtin_amdgcn_readfirstlane(tid >> 6);
    float* X = a.out(); bf16_t* XN = (bf16_t*)(ws + WS_XN); const bf16_t* Y = (const bf16_t*)(ws + WS_Y);
    const bool last = (l + 1 == DEPTH);
    f32x4 lg[4], lb[4];
#pragma unroll
    for (int j = 0; j < 4; ++j) { lg[j] = *(const GAS f32x4*)(a.in(I_LN2G) + l * DM + 4 * lane + 256 * j); lb[j] = *(const GAS f32x4*)(a.in(I_LN2B) + l * DM + 4 * lane + 256 * j); }
    for (int chunk = grank; chunk < NTOK / 128; chunk += G) {
    for (int ti = 0; ti < 16; ti += 2) {
        f32x4 x[2][4]; float s[2] = {0.f, 0.f};
#pragma unroll
        for (int u = 0; u < 2; ++u) { const int tok = chunk * 128 + wave + 8 * (ti + u);
            const bf16_t* xr = XN + (size_t)tok * DM; const bf16_t* y0 = Y + (size_t)(2 * tok) * DM; const bf16_t* y1 = y0 + DM;
#pragma unroll
            for (int j = 0; j < 4; ++j) { float xv[4], ya[4], yb[4]; unpack4(*(const GAS u32x2*)(xr + 4 * lane + 256 * j), xv);
                unpack4(*(const GAS u32x2*)(y0 + 4 * lane + 256 * j), ya); unpack4(*(const GAS u32x2*)(y1 + 4 * lane + 256 * j), yb);
#pragma unroll
                for (int e = 0; e < 4; ++e) x[u][j][e] = ALPHA * xv[e] + (ya[e] + yb[e]);
                s[u] += (x[u][j][0] + x[u][j][1]) + (x[u][j][2] + x[u][j][3]); } }
#pragma unroll
        for (int u = 0; u < 2; ++u) { const int tok = chunk * 128 + wave + 8 * (ti + u);
            float* row = X + (size_t)tok * DM; bf16_t* xr = XN + (size_t)tok * DM;
            const float mean = wave_sum(s[u]) * (1.f / DM); float s2 = 0.f;
#pragma unroll
            for (int j = 0; j < 4; ++j) { x[u][j] = x[u][j] - mean; s2 += (x[u][j][0] * x[u][j][0] + x[u][j][1] * x[u][j][1]) + (x[u][j][2] * x[u][j][2] + x[u][j][3] * x[u][j][3]); }
            const float rstd = rsqrtf(wave_sum(s2) * (1.f / DM) + LN_EPS);
#pragma unroll
            for (int j = 0; j < 4; ++j) { x[u][j] = x[u][j] * rstd * lg[j] + lb[j]; if (!dry) { if (last) *(GAS f32x4*)(row + 4 * lane + 256 * j) = x[u][j];
                else { u32x2 o; o.x = cvtpk(x[u][j][0], x[u][j][1]); o.y = cvtpk(x[u][j][2], x[u][j][3]); *(GAS u32x2*)(xr + 4 * lane + 256 * j) = o; } } } }
    }
        if (pcnt) { asm volatile("s_waitcnt vmcnt(0)" ::: "memory");
            if (lane == 0) __hip_atomic_fetch_add(pcnt + 16 * (chunk >> 1), 1u, __ATOMIC_RELAXED, __HIP_MEMORY_SCOPE_AGENT); }
    }
}

constexpr int NPH_L = 8, NPHASE = 1 + DEPTH * NPH_L;
__global__ void __launch_bounds__(NTHR, 2) hyb_fwd(Args args) {
    extern __shared__ __attribute__((aligned(16))) unsigned char lds_raw[];
    LAS unsigned char* lds = (LAS unsigned char*)lds_raw;
    const int tid = threadIdx.x;
    const int G = gridDim.x; const int bx = blockIdx.x; const int vcu = (G % 8 == 0) ? (bx % 8) * (G / 8) + bx / 8 : bx;
    unsigned char* ws = (unsigned char*)(GAS unsigned char*)args.ws;
    volatile LAS unsigned* st = (volatile LAS unsigned*)(lds + LDSCTL_OFF);
    if (tid < 64) st[tid] = 0u;
    __syncthreads();
    XcdBarrier bar; bar.bar = (unsigned*)(ws + WS_CTL) + CW_BAR; bar.x = 0; bar.st = st;
    if (!args.multi) bar = xcd_barrier_post((unsigned*)(ws + WS_CTL) + CW_BAR, st);
    int ph0 = args.ph_lo;
    if (ph0 == 0) {
        PArgs pa; pa.kp = (kptr_t)__builtin_amdgcn_kernarg_segment_ptr(); pa.ws_ = args.ws; pa.out_ = args.out;
        if (PHMASK & 1) phase_prologue(pa, lds, vcu, G);
        if (PROBE_DUP & 512) { cg::this_grid().sync(); phase_prologue(pa, lds, vcu, G); }
        ph0 = 1;
        if (ph0 < args.ph_hi) cg::this_grid().sync();
    }
    if (tid == 0) {
        if (args.multi) { st[2] = (unsigned)bx; st[3] = 0u; st[4] = (unsigned)G; }
        else { unsigned P = 0, n = 1;
            unsigned std_ = 1u;
            for (unsigned j = 0; j < 16; ++j) { const unsigned cj = xb_ld(bar.bar + XB_XCNT(j)); P += (j < bar.x) ? cj : 0u; n = (j == bar.x) ? cj : n; std_ &= (cj == (j < 8u ? 32u : 0u)) ? 1u : 0u; }
            st[3] = P; st[4] = n;
            st[5] = (G == 256) ? std_ : 0u; } }
    __syncthreads();
    for (int ph = ph0; ph < args.ph_hi; ++ph) {
        const int kq = (ph - 1) % NPH_L; const bool xl = !args.multi && st[5] != 0u;
        if (ph > ph0 && !(kq == 6 && !args.multi && !PROBE_KEEPBAR) && !(xl && (HANDOFF_SEAMS >> kq & 1))) {
            if (MK_ALLCG) cg::this_grid().sync(); else xcd_barrier(bar);
        }
#if PROBE_X == 5
        _Pragma("unroll 1") for (int q_ = 0; q_ < 4; ++q_) xcd_barrier(bar);
#endif
        PArgs pa; pa.kp = (kptr_t)__builtin_amdgcn_kernarg_segment_ptr(); asm volatile("" : "+s"(pa.kp)); pa.ws_ = args.ws; pa.out_ = args.out; asm volatile("" : "+s"(pa.ws_), "+s"(pa.out_));
        const int l = (ph - 1) / NPH_L, k = (ph - 1) % NPH_L;
        unsigned char* pws = pa.ws();
        const int nrep = ((PROBE_DUP >> k) & 1) ? 2 : 1;
        for (int rep = 0; rep < nrep; ++rep) {
        if (rep) xcd_barrier(bar);
        if (k == 0 && (PHMASK & 2)) {
            __syncthreads();
            pg8::XDenseOrder S; S.init_xcd(NTOK / 256, INP / 256, G, st); S.Bt = (const char*)(pws + WS_WIN + (size_t)l * 4 * MiB); S.Kb = DM * 2;
            if (l > 0 && !args.multi) { S.pcnt = (const unsigned*)(pws + WS_CTL) + CW_PAN + ((l - 1) * 4 + 1) * 2048; S.need = 16u; S.tmo = (unsigned*)(pws + WS_CTL) + 8; }
            pg8::EpiProj E{(bf16_t*)(pws + WS_PROJ), INP, (unsigned*)(pws + WS_CTL) + CW_PAN + (l * 4 + 2) * 2048};
            pg8::gemm_phase(lds, (const char*)(pws + WS_XN), DM, S, E);
        } else if (k == 1 && (PHMASK & 4)) {
#if PROBE_X == 6
            phase_prep(pa, lds, l, 4, PT_I0, PT_IHI, PT_STEP, nullptr); xcd_barrier(bar);
#endif
#if PROBE_P2
            phase_prep(pa, lds, l, PROBE_P2, PT_I0, PT_IHI, PT_STEP, nullptr); xcd_barrier(bar);
#endif
#if PROBE_X >= 8
            phase_prep(pa, lds, l, PROBE_X - 2, PT_I0, PT_IHI, PT_STEP, nullptr); xcd_barrier(bar);
#endif
            phase_prep(pa, lds, l, 0, PT_I0, PT_IHI, PT_STEP, args.multi ? nullptr : (const unsigned*)(pws + WS_CTL) + CW_PAN + (l * 4 + 2) * 2048);
#if PROBE_X == 7
            xcd_barrier(bar); phase_prep(pa, lds, l, 5, PT_I0, PT_IHI, PT_STEP, nullptr);
#endif
        } else if (k == 2 && (PHMASK & 16)) { phase_attn_post(pa, lds_raw, l, bx);
#if PROBE_X == 2
            xcd_barrier(bar); phase_attn_post(pa, lds_raw, l, bx);
#endif
        } else if (k == 3 && (PHMASK & 32)) {
            pg8::XDenseOrder S; S.init_xcd(NTOK / 256, DM / 256, G, st); S.Bt = (const char*)(pws + WS_WO + (size_t)l * 2 * MiB); S.Kb = DM * 2;
            pg8::EpiRes E{(const bf16_t*)(pws + WS_XN), (float*)(pws + WS_Z), nrep == 2 && rep == 0, (unsigned*)(pws + WS_CTL) + CW_PAN + (l * 4 + 0) * 2048};
            pg8::gemm_phase(lds, (const char*)(pws + WS_MIX), DM, S, E);
        } else if (k == 4 && (PHMASK & 64)) {
#if PROBE_X == 3
            phase_ln1_router(pa, lds, l, 1, (int)(st[2] + st[3]), nullptr); xcd_barrier(bar);
#endif
#if PROBE_X == 4
            phase_ln2(pa, l, vcu, G, 1, nullptr); xcd_barrier(bar);
#endif
            phase_ln1_router(pa, lds, l, 0, (int)(st[2] + st[3]), args.multi ? nullptr : (const unsigned*)(pws + WS_CTL) + CW_PAN + (l * 4 + 0) * 2048);
        } else if (k == 5 && (PHMASK & 128)) {
            const int T = moe_build_tab(pa, lds, l);
            pg8::MoeOrder S; S.tab = (const LAS int*)(lds + MOE_TAB_OFF); S.list = (const GAS int*)(pws + WS_LIST);
            S.wbase = (const char*)(pws + WS_WGU); S.wstride = (size_t)1024 * DM * 2; S.Kb = DM * 2; S.gather = 1;
            const bool ho = !args.multi && !PROBE_KEEPBAR;
            S.init_xcd(T, G, st);
            pg8::EpiMoe1 E{(bf16_t*)(pws + WS_H), ho ? (unsigned*)(pws + WS_CTL) + CW_MH + l * 18432 : nullptr};
            pg8::gemm_phase(lds, (const char*)(pws + WS_XN), DM, S, E);
        } else if (k == 6 && (PHMASK & 256)) {
            const int T = (!args.multi && !PROBE_KEEPBAR) ? ((const LAS int*)(lds + MOE_TAB_OFF))[32] : moe_build_tab(pa, lds, l);
            pg8::MoeOrder S; S.tab = (const LAS int*)(lds + MOE_TAB_OFF); S.list = (const GAS int*)(pws + WS_LIST);
            S.wbase = (const char*)(pws + WS_WD); S.wstride = (size_t)DM * EH * 2; S.Kb = EH * 2; S.gather = 0;
            S.init_xcd(T, G, st);
            if (!args.multi && !PROBE_KEEPBAR) { S.rank = S.nloc - 1 - S.rank;
                S.hcnt = (const unsigned*)(pws + WS_CTL) + CW_MH + l * 18432; S.tmo = (unsigned*)(pws + WS_CTL) + 8; }
            pg8::EpiMoe2 E{(bf16_t*)(pws + WS_Y), (const LAS int*)(lds + MOE_TAB_OFF), (const GAS int*)(pws + WS_LIST), (const GAS float*)(pws + WS_GLIST)};
            pg8::gemm_phase(lds, (const char*)(pws + WS_H), EH, S, E);
        } else if (k == 7 && (PHMASK & 512)) { phase_ln2(pa, l, (int)(st[2] + st[3]), G, nrep == 2 && rep == 0, (args.multi || l + 1 >= DEPTH) ? nullptr : (unsigned*)(pws + WS_CTL) + CW_PAN + (l * 4 + 1) * 2048); if (l + 1 < DEPTH) convert_layer_weights(pa, lds, l + 1, vcu, G, 2); }
        }
    }
}

extern "C" void kernel_launch(void* const* d_in, const int* in_sizes, int n_in, void* d_out, int out_size, void* d_ws, size_t ws_size, hipStream_t stream) {
    static int grid = 0;
    if (grid == 0) {
        if (n_in != 30 || out_size != NTOK * DM || ws_size < WS_END) { fprintf(stderr, "kernel_launch: unexpected shapes (n_in %d, out %d, ws %zu)\n", n_in, out_size, ws_size); grid = -1; return; }
        int dev = 0, cus = 0, per_cu = 0;
        hipGetDevice(&dev); hipDeviceGetAttribute(&cus, hipDeviceAttributeMultiprocessorCount, dev);
        if (hipFuncSetAttribute((const void*)hyb_fwd, hipFuncAttributeMaxDynamicSharedMemorySize, LDS_BYTES) != hipSuccess) { fprintf(stderr, "kernel_launch: hipFuncSetAttribute failed\n"); grid = -1; return; }
        if (hipOccupancyMaxActiveBlocksPerMultiprocessor(&per_cu, (const void*)hyb_fwd, NTHR, LDS_BYTES) != hipSuccess || per_cu < 1) { fprintf(stderr, "kernel_launch: occupancy query says %d\n", per_cu); per_cu = 1; }
        (void)hipGetLastError();
        grid = cus * 1;
        fprintf(stderr, "kernel_launch: %d CUs, occupancy %d, grid %d\n", cus, per_cu, grid);
    }
    if (grid < 0) return;
    hipMemsetAsync((char*)d_ws + WS_CTL, 0, CTL_ZERO_BYTES, stream);
    Args a{};
    for (int i = 0; i < 30; ++i) a.in[i] = (const float*)d_in[i];
    a.out = (float*)d_out; a.ws = (unsigned char*)d_ws;
#if MK_MULTI
    a.multi = 1;
    for (int ph = 0; ph < NPHASE; ++ph) { a.ph_lo = ph; a.ph_hi = ph + 1; hipLaunchKernelGGL(hyb_fwd, dim3(grid), dim3(NTHR), LDS_BYTES, stream, a); }
#else
    a.multi = 0; a.ph_lo = 0; a.ph_hi = NPHASE;
    void* kargs[] = {&a};
    hipError_t e = hipLaunchCooperativeKernel((const void*)hyb_fwd, dim3(grid), dim3(NTHR), kargs, LDS_BYTES, stream);
    if (e != hipSuccess) fprintf(stderr, "cooperative launch failed: %s (grid %d)\n", hipGetErrorString(e), grid);
#endif
}
```

```cpp
#include <hip/hip_runtime.h>
#include <hip/hip_cooperative_groups.h>
#include <hip/hip_bf16.h>
#include <cstdio>
#include <cstdint>
namespace cg = cooperative_groups;

#ifndef MK_MULTI
#define MK_MULTI 0
#endif
#ifndef PROBE_DUP
#define PROBE_DUP 0
#endif
#ifndef PROBE_PREPDRY
#define PROBE_PREPDRY 1
#endif
#ifndef PROBE_X
#define PROBE_X 0
#endif
#ifndef PHMASK
#define PHMASK 1023
#endif
#ifndef MK_ALLCG
#define MK_ALLCG 0
#endif

#define GAS __attribute__((address_space(1)))
#define LAS __attribute__((address_space(3)))
typedef unsigned short bf16_t;
typedef short bf16x8 __attribute__((ext_vector_type(8)));
typedef float f32x4 __attribute__((ext_vector_type(4)));
typedef float f32x2 __attribute__((ext_vector_type(2)));
typedef float f32x16 __attribute__((ext_vector_type(16)));
typedef unsigned u32x4 __attribute__((ext_vector_type(4)));
typedef unsigned u32x2 __attribute__((ext_vector_type(2)));
typedef __bf16 bf16x2_t __attribute__((ext_vector_type(2)));

constexpr int NB = 16, SEQ = 2048, DM = 1024, NTOK = NB * SEQ, DEPTH = 4;
constexpr int INW = 1984, INP = 2048;
constexpr int C_RW = 256, C_Q = 1216, C_K = 1728, C_V = 1856;
constexpr int NEXP = 32, EH = 512;
constexpr float ALPHA = 1.6817928305074290f;
constexpr float LN_EPS = 1e-5f, GN_EPS = 64e-5f, QK_EPS = 1e-6f;
constexpr float QSCALE = 0.125f * 1.4426950408889634f;
constexpr int NWAVES = 8, NTHR = 512;
constexpr int LDS_BYTES = 163840;
constexpr int LISTCAP = 32768;

constexpr size_t MiB = 1u << 20;
constexpr size_t WS_CTL = 0, CTL_ZERO_BYTES = 1 * MiB;
constexpr size_t WS_SMALL = 1 * MiB;
constexpr size_t WS_WGU = 10 * MiB, WS_WD = 74 * MiB;
constexpr size_t WS_WIN = 983 * MiB  , WS_WO = 999 * MiB  ;
constexpr size_t WS_REC = 106 * MiB;
constexpr size_t WS_XN = 320 * MiB, WS_MIX = 384 * MiB, WS_PROJ = 448 * MiB;
constexpr size_t WS_R = 576 * MiB, WS_V = 592 * MiB, WS_KK = 608 * MiB, WS_KH = 624 * MiB  , WS_B = 656 * MiB  ;
constexpr size_t WS_G = 688 * MiB, WS_BON = 704 * MiB, WS_W = 720 * MiB  , WS_WKV = 784 * MiB  ;
constexpr size_t WS_FC0 = 608 * MiB  , WS_FC1 = 720 * MiB  ;
constexpr size_t WS_WH0 = 672 * MiB  , WS_WH1 = 576 * MiB  ;
constexpr size_t WS_LIST = 848 * MiB  , WS_GATE = 852 * MiB  ;
constexpr size_t WS_H = 106 * MiB  , WS_Y = 180 * MiB  ;
constexpr size_t WS_Z = 853 * MiB  , WS_STAT = 981 * MiB  , WS_RWB = 982 * MiB  ;
constexpr size_t WS_RB = 981 * MiB + 512 * 1024;
constexpr size_t WS_GLIST = 1007 * MiB;
constexpr size_t WS_END = 1014 * MiB;
constexpr size_t SM_ROPE = 0;
constexpr size_t SM_PWT = 16384;
constexpr size_t SM_WUPT = SM_PWT + 131072;
constexpr size_t SM_AUPT = SM_WUPT + 131072;
constexpr size_t SM_GUPT = SM_AUPT + 131072;
constexpr size_t SM_RWT = SM_GUPT + 131072;
static_assert(SM_RWT + 589824 <= 3 * MiB, "small region");
constexpr int CW_BAR = 4096;
constexpr int CW_CNT = 16384;
#define PT_I0 ((int)((unsigned)(NTOK / 64) * st[3] / (unsigned)G + st[2]))
#define PT_IHI ((int)((unsigned)(NTOK / 64) * (st[3] + st[4]) / (unsigned)G))
#define PT_STEP ((int)st[4])
#ifndef PROBE_P2
#define PROBE_P2 0
#endif
#ifndef HANDOFF_SEAMS
#define HANDOFF_SEAMS 0x13
#endif
#ifndef PROBE_KEEPBAR
#define PROBE_KEEPBAR 0
#endif
constexpr int CW_PAN = 122880;
constexpr int CW_MH = 49152;
constexpr int CW_AQ = 20480;

__device__ __forceinline__ unsigned cvtpk(float lo, float hi) { f32x2 v = {lo, hi}; bf16x2_t b = __builtin_convertvector(v, bf16x2_t); return __builtin_bit_cast(unsigned, b); }
__device__ __forceinline__ float bflo(unsigned w) { return __uint_as_float(w << 16); }
__device__ __forceinline__ float bfhi(unsigned w) { return __uint_as_float(w & 0xffff0000u); }
__device__ __forceinline__ float sigmoidf_(float x) { return __builtin_amdgcn_rcpf(1.f + __expf(-x)); }
#define DPP_ADD(v, ctrl) ((v) + __builtin_bit_cast(float, __builtin_amdgcn_update_dpp(0, __builtin_bit_cast(int, (v)), (ctrl), 0xF, 0xF, true)))
__device__ __forceinline__ float red16(float v) {
    v = DPP_ADD(v, 0xB1); v = DPP_ADD(v, 0x4E); v = DPP_ADD(v, 0x141); v = DPP_ADD(v, 0x140); return v;
}
__device__ __forceinline__ float wave_sum(float v) { v = red16(v); v += __shfl_xor(v, 16); v += __shfl_xor(v, 32); return v; }

__device__ __forceinline__ void wait_count(const unsigned* p, unsigned need, unsigned* tmo) {
    unsigned v, sp = 0;
    for (;;) {
        asm volatile("s_load_dword %0, %1, 0x0 glc\n\ts_waitcnt lgkmcnt(0)" : "=s"(v) : "s"(p) : "memory");
        if (v >= need) break;
        if (++sp > 4000000u) { if ((threadIdx.x & 63) == 0) __hip_atomic_store(tmo, 1u, __ATOMIC_RELAXED, __HIP_MEMORY_SCOPE_AGENT); break; }
        __builtin_amdgcn_s_sleep(2); }
}
namespace pg8 {
constexpr int BM = 256, BK = 64, HALF = 128, HTB = HALF * BK * 2, STAGE_BYTES = 8 * HTB, NXCD = 8, WGM = 8;
__device__ __forceinline__ int lds_byte(int r, int c) { const int st = (r >> 4) * 2 + (c >> 5), rr = r & 15, cc = c & 31, ob = rr * 64 + cc * 2; return st * 1024 + (ob ^ (((ob >> 9) & 1) << 5)); }
__device__ __forceinline__ void stage_rc(int b, int& R, int& C) { const int st = b / 1024, sb = b % 1024, swz = sb ^ (((sb >> 9) & 1) << 5); R = (st >> 1) * 16 + swz / 64; C = (st & 1) * 32 + (swz % 64) / 2; }
__device__ __forceinline__ int perm32(int rho) { const int n = rho >> 4, i = rho & 15; return 8 * (i >> 2) + 4 * n + (i & 3); }
struct Unit { int pm, pn; };

struct OrderBase {
    int nM, nN, nwg, G, c;
    __device__ __forceinline__ void init(int nM_, int nN_, int G_, int c_) { nM = nM_; nN = nN_; nwg = nM * nN; G = G_; c = c_; }
    __device__ __forceinline__ bool next(int i, Unit& u) const {
        const long L = (long)i * G + c; if (L >= nwg) return false;
        int wgid = (int)L; { const int q = nwg / NXCD, r = nwg % NXCD, xcd = wgid % NXCD, off = wgid / NXCD; wgid = (xcd < r ? xcd * (q + 1) : r * (q + 1) + (xcd - r) * q) + off; }
        const int nig = WGM * nN, gid = wgid / nig, fm = gid * WGM, gsz = (nM - fm) < WGM ? (nM - fm) : WGM;
        u.pm = fm + ((wgid % nig) % gsz); u.pn = (wgid % nig) / gsz; return true;
    }
    __device__ __forceinline__ void a_ready(const Unit&) const {}
};
struct DenseOrder : OrderBase {
    const char* Bt; int Kb;
    __device__ __forceinline__ unsigned arow(const Unit& u, int r) const { return (unsigned)(u.pm * BM + r); }
    __device__ __forceinline__ const char* bptr(const Unit& u) const { return Bt + (size_t)u.pn * BM * Kb; }
};
struct XDenseOrder {
    const char* Bt; int Kb; int nN, p0, pc, rank, nloc;
    const unsigned* pcnt = nullptr; unsigned need = 0; unsigned* tmo = nullptr;
    __device__ __forceinline__ void init_xcd(int nM, int nN_, int Gt, volatile LAS unsigned* st) {
        const unsigned P = st[3], n = st[4]; nN = nN_;
        p0 = (int)((unsigned)nM * P / (unsigned)Gt); pc = (int)((unsigned)nM * (P + n) / (unsigned)Gt) - p0; rank = (int)st[2]; nloc = (int)n;
    }
    __device__ __forceinline__ bool next(int i, Unit& u) const {
        const int j = rank + nloc * i; if (j >= pc * nN) return false;
        const int nig = 8 * nN, fm = (j / nig) * 8, gsz = (pc - fm) < 8 ? (pc - fm) : 8, jj = j % nig;
        u.pm = p0 + fm + jj % gsz; u.pn = jj / gsz; return true;
    }
    __device__ __forceinline__ unsigned arow(const Unit& u, int r) const { return (unsigned)(u.pm * BM + r); }
    __device__ __forceinline__ const char* bptr(const Unit& u) const { return Bt + (size_t)u.pn * BM * Kb; }
    __device__ __forceinline__ void a_ready(const Unit& u) const { if (pcnt) wait_count(pcnt + 16 * u.pm, need, tmo); }
};
struct MoeOrder {
    const LAS int* tab; const GAS int* list; const char* wbase; size_t wstride; int Kb; int gather;
    int t0, tcnt, rank, nloc;
    __device__ __forceinline__ void init_xcd(int T, int Gt, volatile LAS unsigned* st) {
        const unsigned P = st[3], n = st[4];
        t0 = (int)((unsigned)T * P / (unsigned)Gt); tcnt = (int)((unsigned)T * (P + n) / (unsigned)Gt) - t0; rank = (int)st[2]; nloc = (int)n;
    }
    __device__ __forceinline__ bool next(int i, Unit& u) const {
        const int j = rank + nloc * i; if (j >= tcnt * 4) return false;
        const int fm = (j >> 5) * 8, gsz = (tcnt - fm) < 8 ? (tcnt - fm) : 8;
        u.pm = t0 + fm + (j & 31) % gsz; u.pn = (j & 31) / gsz; return true;
    }
    const unsigned* hcnt = nullptr; unsigned* tmo = nullptr;
    __device__ __forceinline__ void a_ready(const Unit& u) const {
        if (!hcnt) return;
        const unsigned* p = hcnt + 64 * u.pm; unsigned v, sp = 0;
        for (;;) {
            asm volatile("s_load_dword %0, %1, 0x0 glc\n\ts_waitcnt lgkmcnt(0)" : "=s"(v) : "s"(p) : "memory");
            if (v >= 32u) break;
            if (++sp > 4000000u) { if ((threadIdx.x & 63) == 0) __hip_atomic_store(tmo, 1u, __ATOMIC_RELAXED, __HIP_MEMORY_SCOPE_AGENT); break; }
            __builtin_amdgcn_s_sleep(2); }
    }
    __device__ __forceinline__ unsigned arow(const Unit& u, int r) const {
        if (!gather) return (unsigned)(u.pm * BM + r);
        const int e = tab[128 + u.pm]; const int pos = (u.pm - tab[e]) * BM + r;
        return pos < tab[64 + e] ? (unsigned)(list[e * LISTCAP + pos] >> 1) : 0u;
    }
    __device__ __forceinline__ const char* bptr(const Unit& u) const { const int e = tab[128 + u.pm]; return wbase + (size_t)e * wstride + (size_t)u.pn * BM * Kb; }
};

struct EpiProj {
    static constexpr bool PERM = true;
    bf16_t* O; int ldc; unsigned* pcnt;
    __device__ __forceinline__ void publish(int pm) const { if ((threadIdx.x & 63) == 0) __hip_atomic_fetch_add(pcnt + 16 * pm, 1u, __ATOMIC_RELAXED, __HIP_MEMORY_SCOPE_AGENT); }
    __device__ __forceinline__ void operator()(const f32x4 (&acc)[2][2][4][2], const Unit& u, int wr, int wc, int fr, int fq) const {
        const int row0 = u.pm * BM + wr * 64 + fr, col0 = u.pn * BM + wc * 32 + 8 * fq;
#pragma unroll
        for (int ai = 0; ai < 2; ++ai)
#pragma unroll
            for (int m = 0; m < 4; ++m) { bf16_t* rowp = O + (size_t)(row0 + ai * HALF + m * 16) * ldc + col0;
#pragma unroll
                for (int bj = 0; bj < 2; ++bj) { const f32x4 v0 = acc[ai][bj][m][0], v1 = acc[ai][bj][m][1];
                    u32x4 w; w.x = cvtpk(v0[0], v0[1]); w.y = cvtpk(v0[2], v0[3]); w.z = cvtpk(v1[0], v1[1]); w.w = cvtpk(v1[2], v1[3]);
                    *(GAS u32x4*)(rowp + bj * HALF) = w; } }
    }
};
struct EpiRes {
    static constexpr bool PERM = false;
    const bf16_t* base; float* out; int dry; unsigned* pcnt;
    __device__ __forceinline__ void publish(int pm) const { if ((threadIdx.x & 63) == 0) __hip_atomic_fetch_add(pcnt + 16 * pm, 1u, __ATOMIC_RELAXED, __HIP_MEMORY_SCOPE_AGENT); }
    __device__ __forceinline__ void operator()(const f32x4 (&acc)[2][2][4][2], const Unit& u, int wr, int wc, int fr, int fq) const {
        const int row0 = u.pm * BM + wr * 64 + fr, col0 = u.pn * BM + wc * 32 + 4 * fq;
#pragma unroll
        for (int ai = 0; ai < 2; ++ai)
#pragma unroll
            for (int m = 0; m < 4; ++m) { const size_t off = (size_t)(row0 + ai * HALF + m * 16) * DM + col0;
#pragma unroll
                for (int bj = 0; bj < 2; ++bj)
#pragma unroll
                    for (int n = 0; n < 2; ++n) { const u32x2 bw = *(const GAS u32x2*)(base + off + bj * HALF + n * 16);
                        const f32x4 bs = {__uint_as_float(bw.x << 16), __uint_as_float(bw.x & 0xffff0000u), __uint_as_float(bw.y << 16), __uint_as_float(bw.y & 0xffff0000u)};
                        if (!dry) *(GAS f32x4*)(out + off + bj * HALF + n * 16) = bs * ALPHA + acc[ai][bj][m][n]; }
                asm volatile("" ::: "memory"); }
    }
};
struct EpiMoe1 {
    static constexpr bool PERM = true;
    bf16_t* H; unsigned* hcnt;
    __device__ __forceinline__ void operator()(const f32x4 (&acc)[2][2][4][2], const Unit& u, int wr, int wc, int fr, int fq) const {
        const int row0 = u.pm * BM + wr * 64 + fr, col0 = u.pn * HALF + wc * 32 + 8 * fq;
#pragma unroll
        for (int ai = 0; ai < 2; ++ai)
#pragma unroll
            for (int m = 0; m < 4; ++m) { bf16_t* rowp = H + (size_t)(row0 + ai * HALF + m * 16) * EH + col0;
                float h[8];
#pragma unroll
                for (int n = 0; n < 2; ++n)
#pragma unroll
                    for (int j = 0; j < 4; ++j) { const float g = acc[ai][0][m][n][j], up = acc[ai][1][m][n][j]; h[n * 4 + j] = g * __builtin_amdgcn_rcpf(1.f + __expf(-g)) * up; }
                u32x4 w; w.x = cvtpk(h[0], h[1]); w.y = cvtpk(h[2], h[3]); w.z = cvtpk(h[4], h[5]); w.w = cvtpk(h[6], h[7]);
                *(GAS u32x4*)rowp = w; }
    }
    __device__ __forceinline__ void publish(int pm) const { if (hcnt && (threadIdx.x & 63) == 0) __hip_atomic_fetch_add(hcnt + 64 * pm, 1u, __ATOMIC_RELAXED, __HIP_MEMORY_SCOPE_AGENT); }
};
struct EpiMoe2 {
    __device__ __forceinline__ void publish(int) const {}
    static constexpr bool PERM = true;
    bf16_t* Y; const LAS int* tab; const GAS int* list; const GAS float* glist;
    __device__ __forceinline__ void operator()(const f32x4 (&acc)[2][2][4][2], const Unit& u, int wr, int wc, int fr, int fq) const {
        const int e = tab[128 + u.pm], pos0 = (u.pm - tab[e]) * BM + wr * 64 + fr, cnt = tab[64 + e], col0 = u.pn * BM + wc * 32 + 8 * fq;
        int pr[8]; float gv[8];
#pragma unroll
        for (int i = 0; i < 8; ++i) { const int pos = pos0 + (i >> 2) * HALF + (i & 3) * 16, pc = pos < cnt ? pos : cnt - 1;
            pr[i] = list[e * LISTCAP + pc]; gv[i] = glist[e * LISTCAP + pc]; }
#pragma unroll
        for (int ai = 0; ai < 2; ++ai)
#pragma unroll
            for (int m = 0; m < 4; ++m) { const int pos = pos0 + ai * HALF + m * 16;
                if (pos < cnt) { const float gt = gv[ai * 4 + m]; bf16_t* rowp = Y + (size_t)pr[ai * 4 + m] * DM + col0;
#pragma unroll
                    for (int bj = 0; bj < 2; ++bj) { const f32x4 v0 = acc[ai][bj][m][0] * gt, v1 = acc[ai][bj][m][1] * gt;
                        u32x4 w; w.x = cvtpk(v0[0], v0[1]); w.y = cvtpk(v0[2], v0[3]); w.z = cvtpk(v1[0], v1[1]); w.w = cvtpk(v1[2], v1[3]);
                        *(GAS u32x4*)(rowp + bj * HALF) = w; } } }
    }
};

template <class Epi, class Sched>
__device__ __forceinline__ void gemm_phase(LAS unsigned char* lds, const char* A, const int K, const Sched& S, const Epi& E) {
    int tid_ = threadIdx.x; asm volatile("" : "+v"(tid_)); const int tid = tid_, wid = __builtin_amdgcn_readfirstlane(tid >> 6), lane = tid & 63, wr = wid >> 2, wc = wid & 3, fr = lane & 15, fq = lane >> 4;
    const int nt = K / BK; const unsigned Kb = (unsigned)K * 2u;
    int Rr[2]; unsigned Cb[2], voffB[2];
#pragma unroll
    for (int i = 0; i < 2; ++i) { int R, C; stage_rc(tid * 16 + i * 8192, R, C); const int Rb = Epi::PERM ? ((R & ~31) + perm32(R & 31)) : R;
        Rr[i] = R; Cb[i] = (unsigned)C * 2u; voffB[i] = (unsigned)(Rb * K + C) * 2u; }
    const size_t kstep = (size_t)(BK * 2);
    const size_t hstep = (size_t)HALF * K * 2;
    const unsigned ldsw = (unsigned)wid * 1024u;
    const int aoff = lds_byte(wr * 64 + fr, fq * 8), boff = lds_byte(wc * 32 + fr, fq * 8);
#define PG8_SA(b, h) (((b) * 2 + (h)) * HTB)
#define PG8_SB(b, h) ((4 + (b) * 2 + (h)) * HTB)
#define PG8_STAGE(bufoff, gbase, voff) do { _Pragma("unroll") for (int _i = 0; _i < 2; ++_i) \
        __builtin_amdgcn_global_load_lds((const unsigned*)((const char*)(gbase) + (voff)[_i]), (LAS unsigned*)(lds + (bufoff) + ldsw + _i * 8192), 16, 0, 0); } while (0)
#define PG8_STAGEA(bufoff, arr, h, kb) do { _Pragma("unroll") for (int _i = 0; _i < 2; ++_i) \
        __builtin_amdgcn_global_load_lds((const unsigned*)((A + (size_t)(kb)) + (arr)[h][_i]), (LAS unsigned*)(lds + (bufoff) + ldsw + _i * 8192), 16, 0, 0); } while (0)
#define PG8_SETA(arr, u) do { _Pragma("unroll") for (int _h = 0; _h < 2; ++_h) _Pragma("unroll") for (int _i = 0; _i < 2; ++_i) (arr)[_h][_i] = S.arow((u), _h * HALF + Rr[_i]) * Kb + Cb[_i]; } while (0)
#define PG8_LDA(dst, b, h) do { _Pragma("unroll") for (int m = 0; m < 4; ++m) _Pragma("unroll") for (int k = 0; k < 2; ++k) dst[m][k] = *(const LAS bf16x8*)(lds + PG8_SA(b, h) + aoff + m * 2048 + k * 1024); } while (0)
#define PG8_LDB(dst, b, h) do { _Pragma("unroll") for (int n = 0; n < 2; ++n) _Pragma("unroll") for (int k = 0; k < 2; ++k) dst[n][k] = *(const LAS bf16x8*)(lds + PG8_SB(b, h) + boff + n * 2048 + k * 1024); } while (0)
#define PG8_MMA(ai, bj, At, Bt) do { __builtin_amdgcn_s_setprio(1); _Pragma("unroll") for (int m = 0; m < 4; ++m) _Pragma("unroll") for (int n = 0; n < 2; ++n) _Pragma("unroll") for (int k = 0; k < 2; ++k) \
        acc[ai][bj][m][n] = __builtin_amdgcn_mfma_f32_16x16x32_bf16(Bt[n][k], At[m][k], acc[ai][bj][m][n], 0, 0, 0); __builtin_amdgcn_s_setprio(0); } while (0)
#define PG8_WAIT_V(n) asm volatile("s_waitcnt vmcnt(" #n ")" ::: "memory")
#define PG8_WAIT_L(n) asm volatile("s_waitcnt lgkmcnt(" #n ")" ::: "memory")
#define PG8_BAR __builtin_amdgcn_s_barrier()
#define PG8_SCHED __builtin_amdgcn_sched_barrier(0)
    Unit cur, nxt; int ui = 0;
    if (!S.next(0, cur)) return;
    f32x4 acc[2][2][4][2];
#pragma unroll
    for (int a = 0; a < 2; ++a)
#pragma unroll
        for (int b = 0; b < 2; ++b)
#pragma unroll
            for (int m = 0; m < 4; ++m)
#pragma unroll
                for (int n = 0; n < 2; ++n) acc[a][b][m][n] = (f32x4){0.f, 0.f, 0.f, 0.f};
    bf16x8 At[4][2], B0[2][2], B1[2][2];
    unsigned ac[2][2], an[2][2];
    int ppm = -1;
    S.a_ready(cur);
    PG8_SETA(ac, cur);
    const char* cB = S.bptr(cur);
    PG8_STAGE(PG8_SB(0, 0), cB, voffB); PG8_STAGE(PG8_SB(0, 1), cB + hstep, voffB); PG8_STAGEA(PG8_SA(0, 0), ac, 0, 0); PG8_STAGEA(PG8_SA(0, 1), ac, 1, 0);
    if (wr == 1) PG8_BAR;
    PG8_WAIT_V(2); PG8_BAR;
    PG8_STAGE(PG8_SB(1, 0), cB + kstep, voffB); PG8_STAGEA(PG8_SA(1, 0), ac, 0, kstep); PG8_STAGE(PG8_SB(1, 1), cB + hstep + kstep, voffB);
    PG8_WAIT_V(6); PG8_BAR;
    for (;;) {
        const bool has_next = S.next(ui + 1, nxt);
        const char* nB = cB;
        if (has_next) { PG8_SETA(an, nxt); nB = S.bptr(nxt); }
        else {
#pragma unroll
            for (int h = 0; h < 2; ++h)
#pragma unroll
                for (int i = 0; i < 2; ++i) an[h][i] = ac[h][i]; }
        for (int t = 0; t < nt; t += 2) {
            const bool last = (t == nt - 2);
            if (last && has_next) S.a_ready(nxt);
            const size_t k1 = (size_t)(t + 1) * kstep;
            const size_t k2 = last ? 0 : (size_t)(t + 2) * kstep, k3 = k2 + kstep;
            const char* b2 = last ? nB : cB + (size_t)(t + 2) * kstep; const char* b3 = b2 + kstep;
            unsigned a2[2][2];
#pragma unroll
            for (int h = 0; h < 2; ++h)
#pragma unroll
                for (int i = 0; i < 2; ++i) a2[h][i] = last ? an[h][i] : ac[h][i];
            PG8_LDB(B0, 0, 0); PG8_LDB(B1, 0, 1); PG8_SCHED; PG8_LDA(At, 0, 0); PG8_STAGEA(PG8_SA(1, 1), ac, 1, k1);
            PG8_WAIT_V(8); PG8_WAIT_L(0); PG8_BAR; PG8_MMA(0, 0, At, B0); PG8_MMA(0, 1, At, B1); PG8_BAR; PG8_SCHED;
            PG8_LDA(At, 0, 1); PG8_STAGE(PG8_SB(0, 0), b2, voffB); PG8_STAGE(PG8_SB(0, 1), b2 + hstep, voffB); PG8_STAGEA(PG8_SA(0, 0), a2, 0, k2);
            PG8_WAIT_V(8); PG8_WAIT_L(0); PG8_BAR; PG8_MMA(1, 0, At, B0); PG8_MMA(1, 1, At, B1); PG8_BAR; PG8_SCHED;
            PG8_LDB(B0, 1, 0); PG8_LDB(B1, 1, 1); PG8_SCHED; PG8_LDA(At, 1, 0); PG8_STAGEA(PG8_SA(0, 1), a2, 1, k2);
            PG8_WAIT_V(8); PG8_WAIT_L(0); PG8_BAR; PG8_MMA(0, 0, At, B0); PG8_MMA(0, 1, At, B1); PG8_BAR; PG8_SCHED;
            PG8_LDA(At, 1, 1); PG8_STAGE(PG8_SB(1, 0), b3, voffB); PG8_STAGE(PG8_SB(1, 1), b3 + hstep, voffB); PG8_STAGEA(PG8_SA(1, 0), a2, 0, k3);
            PG8_WAIT_V(8); PG8_WAIT_L(0); PG8_BAR; PG8_MMA(1, 0, At, B0); PG8_MMA(1, 1, At, B1); PG8_BAR; PG8_SCHED;
        }
        if (wr == 0) PG8_BAR;
        E(acc, cur, wr, wc, fr, fq);
        if (ppm >= 0) E.publish(ppm);
        ppm = cur.pm;
        if (!has_next) break;
#pragma unroll
        for (int a = 0; a < 2; ++a)
#pragma unroll
            for (int b = 0; b < 2; ++b)
#pragma unroll
                for (int m = 0; m < 4; ++m)
#pragma unroll
                    for (int n = 0; n < 2; ++n) acc[a][b][m][n] = (f32x4){0.f, 0.f, 0.f, 0.f};
        cur = nxt; cB = nB; ++ui;
#pragma unroll
        for (int h = 0; h < 2; ++h)
#pragma unroll
            for (int i = 0; i < 2; ++i) ac[h][i] = an[h][i];
        if (wr == 1) PG8_BAR;
    }
    PG8_WAIT_V(0);
    if (ppm >= 0) E.publish(ppm);
    PG8_BAR;
#undef PG8_SA
#undef PG8_SB
#undef PG8_STAGE
#undef PG8_STAGEA
#undef PG8_SETA
#undef PG8_LDA
#undef PG8_LDB
#undef PG8_MMA
#undef PG8_WAIT_V
#undef PG8_WAIT_L
#undef PG8_BAR
#undef PG8_SCHED
}
}

namespace attn_body {
using bf16 = __hip_bfloat16;
using bf16x8 = __attribute__((ext_vector_type(8))) short;
using s16x4 = __attribute__((ext_vector_type(4))) short;
using f32x16 = __attribute__((ext_vector_type(16))) float;
using u32x4 = __attribute__((ext_vector_type(4))) unsigned;
constexpr int D = 64, QP = INP, KP = INP, VP = INP, OP = DM;
constexpr int NW = 8, QBLK = 32, QB = QBLK * NW, KVBLK = 64;
__device__ __forceinline__ int crow(int r, int hi) { return (r & 3) + 8 * (r >> 2) + 4 * hi; }
#define SBAR() __builtin_amdgcn_sched_barrier(0)
constexpr int NSLOT = 3, SLOTB = 8192;
constexpr int LDS_K = 0, LDS_V = NSLOT * SLOTB, LDS_WS = 2 * NSLOT * SLOTB, LDS_OST = LDS_WS + NW * 64 * 4, LDS_BYTES_A = LDS_OST + NW * 4096;
__device__ __forceinline__ void glds16(const void* gsrc, unsigned lds_dst) { unsigned keep;
  asm volatile("s_mov_b32 %0, m0\n\ts_mov_b32 m0, %2\n\ts_nop 0\n\tglobal_load_lds_dwordx4 %1, off\n\ts_mov_b32 m0, %0" : "=&s"(keep) : "v"(gsrc), "s"(lds_dst) : "memory"); }
__device__ __forceinline__ float max3f(float a, float b, float c) { float r; asm("v_max3_f32 %0, %1, %2, %3" : "=v"(r) : "v"(a), "v"(b), "v"(c)); return r; }
__device__ __forceinline__ float max2f(float a, float b) { float r; asm("v_max_f32_e32 %0, %1, %2" : "=v"(r) : "v"(a), "v"(b)); return r; }
__device__ __forceinline__ float fadd_s(float a, float b) { float r; asm("v_add_f32_e32 %0, %1, %2" : "=v"(r) : "v"(a), "v"(b)); return r; }
__device__ __forceinline__ float fsub_s(float a, float b) { float r; asm("v_sub_f32_e32 %0, %1, %2" : "=v"(r) : "v"(a), "v"(b)); return r; }
typedef float f32x2_t __attribute__((ext_vector_type(2)));
__device__ __forceinline__ unsigned cvtpk_s(float lo, float hi) { f32x2_t v = {lo, hi}; bf16x2_t b = __builtin_convertvector(v, bf16x2_t); return __builtin_bit_cast(unsigned, b); }
#define WAIT_BAR(N) asm volatile("s_waitcnt vmcnt(" #N ") lgkmcnt(0)\n\ts_barrier" ::: "memory")
__device__ __forceinline__ void qkt(f32x16& p0, f32x16& p1, const char* Kslot, const bf16x8* qr, const f32x16& negm, int r32, int hi) {
  const char* kb = Kslot + hi * 1024 + r32 * 16;
  #pragma unroll
  for (int d0 = 0; d0 < 4; ++d0) {
    const bf16x8 b0 = *reinterpret_cast<const bf16x8*>(kb + d0 * 2048);
    const bf16x8 b1 = *reinterpret_cast<const bf16x8*>(kb + d0 * 2048 + 512);
    if (d0 == 0) { p0 = __builtin_amdgcn_mfma_f32_32x32x16_bf16(b0, qr[0], negm, 0, 0, 0); p1 = __builtin_amdgcn_mfma_f32_32x32x16_bf16(b1, qr[0], negm, 0, 0, 0); }
    else { p0 = __builtin_amdgcn_mfma_f32_32x32x16_bf16(b0, qr[d0], p0, 0, 0, 0); p1 = __builtin_amdgcn_mfma_f32_32x32x16_bf16(b1, qr[d0], p1, 0, 0, 0); } }
}
typedef __attribute__((address_space(3))) const char* lds_cptr;
typedef short v4i16_t __attribute__((ext_vector_type(4)));
__device__ __forceinline__ void kload8(bf16x8* kf, lds_cptr kp) {
  kf[0] = *(const __attribute__((address_space(3))) bf16x8*)(kp);        kf[1] = *(const __attribute__((address_space(3))) bf16x8*)(kp + 512);
  kf[2] = *(const __attribute__((address_space(3))) bf16x8*)(kp + 2048); kf[3] = *(const __attribute__((address_space(3))) bf16x8*)(kp + 2560);
  kf[4] = *(const __attribute__((address_space(3))) bf16x8*)(kp + 4096); kf[5] = *(const __attribute__((address_space(3))) bf16x8*)(kp + 4608);
  kf[6] = *(const __attribute__((address_space(3))) bf16x8*)(kp + 6144); kf[7] = *(const __attribute__((address_space(3))) bf16x8*)(kp + 6656);
}
__device__ __forceinline__ void kload2(bf16x8* kf, lds_cptr kp, int j) { kf[2 * j] = *(const __attribute__((address_space(3))) bf16x8*)(kp + j * 2048); kf[2 * j + 1] = *(const __attribute__((address_space(3))) bf16x8*)(kp + j * 2048 + 512); }
__device__ __forceinline__ s16x4 vtr(lds_cptr p) { return __builtin_bit_cast(s16x4, __builtin_amdgcn_ds_read_tr16_b64_v4i16((__attribute__((address_space(3))) v4i16_t*)p)); }
__device__ __forceinline__ float rowmax(const f32x16& p0, const f32x16& p1) {
  float a = max3f(p0[0], p0[1], p1[0]), b = max3f(p0[2], p0[3], p1[1]); a = max3f(a, p1[2], p1[3]);
  #pragma unroll
  for (int r = 4; r < 16; r += 4) { a = max3f(a, p0[r], p0[r + 1]); b = max3f(b, p0[r + 2], p0[r + 3]); a = max3f(a, p1[r], p1[r + 1]); b = max3f(b, p1[r + 2], p1[r + 3]); }
  const float m = max2f(a, b);
  auto rr = __builtin_amdgcn_permlane32_swap(__float_as_uint(m), __float_as_uint(m), false, false);
  return max2f(__uint_as_float(rr[0]), __uint_as_float(rr[1]));
}
__device__ __forceinline__ void pv(f32x16* o, int vb, bf16x8 pa0, bf16x8 pa1, bf16x8 pa2, bf16x8 pa3) {
  #pragma unroll
  for (int d0 = 0; d0 < 2; ++d0) { s16x4 lo[4], hi[4];
    #pragma unroll
    for (int ks = 0; ks < 4; ++ks) {
      asm volatile("ds_read_b64_tr_b16 %0,%1 offset:%c2" : "=&v"(lo[ks]) : "v"(vb), "i"(d0 * 4096 + ks * 1024) : "memory");
      asm volatile("ds_read_b64_tr_b16 %0,%1 offset:%c2" : "=&v"(hi[ks]) : "v"(vb), "i"(d0 * 4096 + ks * 1024 + 512) : "memory"); }
    asm volatile("s_waitcnt lgkmcnt(0)" ::: "memory"); SBAR();
    #define PK(k) (bf16x8){lo[k][0], lo[k][1], lo[k][2], lo[k][3], hi[k][0], hi[k][1], hi[k][2], hi[k][3]}
    o[d0] = __builtin_amdgcn_mfma_f32_32x32x16_bf16(pa0, PK(0), o[d0], 0, 0, 0);
    o[d0] = __builtin_amdgcn_mfma_f32_32x32x16_bf16(pa1, PK(1), o[d0], 0, 0, 0);
    o[d0] = __builtin_amdgcn_mfma_f32_32x32x16_bf16(pa2, PK(2), o[d0], 0, 0, 0);
    o[d0] = __builtin_amdgcn_mfma_f32_32x32x16_bf16(pa3, PK(3), o[d0], 0, 0, 0);
    #undef PK
  }
}
#define ATTN_STORE16(p, v) (*(GAS u32x4*)(p) = (v))
template <int THRL> __device__ __forceinline__ void attn_unit(int b, int h, int kvh, int qb, const bf16* Q, const bf16* __restrict__ K, const bf16* __restrict__ V, bf16* O, char* shm) {
  int tid_ = threadIdx.x; asm volatile("" : "+v"(tid_)); const int tid = tid_, lane = tid & 63, r32 = lane & 31, hi = lane >> 5; const int wid = __builtin_amdgcn_readfirstlane(tid >> 6);
  const long rowbase = (long)b * SEQ; const int q0 = qb * QB;
  const bf16* Qw = Q + (rowbase + q0 + wid * QBLK) * QP + h * D;
  const bf16* Kh = K + rowbase * KP + kvh * D, *Vh = V + rowbase * VP + kvh * D;
  const unsigned lds0 = (unsigned)(uintptr_t)shm;
  float* wsf = (float*)(shm + LDS_WS) + wid * 64;
  const bf16* ksrc = Kh + (long)lane * KP + wid * 8;
  const bf16* vsrc = Vh + (long)(16 * (wid & 3) + (lane >> 2)) * VP + (wid >> 2) * 32 + (lane & 3) * 8;
  const unsigned kdst = lds0 + LDS_K + wid * 1024, vdst = lds0 + LDS_V + wid * 1024;
  #define DMA_K(t, slot) glds16(ksrc + (long)(t) * KVBLK * KP, (unsigned)__builtin_amdgcn_readfirstlane(kdst + (slot)))
  #define DMA_V(t, slot) glds16(vsrc + (long)(t) * KVBLK * VP, (unsigned)__builtin_amdgcn_readfirstlane(vdst + (slot)))
  const int vb0 = (int)(lds0 + LDS_V) + ((lane >> 4) & 1) * 32 + (lane & 3) * 8 + (4 * hi + ((lane & 15) >> 2)) * 64;
  const char* Kbase = shm + LDS_K; bf16x8 kf[8];
  const lds_cptr shm3 = (lds_cptr)shm; const lds_cptr kp0 = shm3 + LDS_K + hi * 1024 + r32 * 16; const lds_cptr vp0 = shm3 + LDS_V + ((lane >> 4) & 1) * 32 + (lane & 3) * 8 + (4 * hi + ((lane & 15) >> 2)) * 64;
  constexpr int NT = SEQ / KVBLK;
  DMA_K(0, 0); DMA_V(0, 0); DMA_K(1, SLOTB);
  bf16x8 qr[4];
  #pragma unroll
  for (int d0 = 0; d0 < 4; ++d0) qr[d0] = *(const GAS bf16x8*)(&Qw[(long)r32 * QP + d0 * 16 + hi * 8]);
  float mhat = 0.f, l_reg = 0.f; f32x16 o[2]; o[0] = f32x16{}; o[1] = f32x16{}; f32x16 negm = f32x16{}; asm volatile("" : "+v"(negm));
  bool resc = false;
  #define START(P0, P1) do { const float rm = rowmax(P0, P1); resc = false; \
    { const float dl = rm; mhat = fadd_s(mhat, dl); \
      _Pragma("unroll") for (int r = 0; r < 16; ++r) { P0[r] = fsub_s(P0[r], dl); P1[r] = fsub_s(P1[r], dl); } \
      _Pragma("unroll") for (int r = 0; r < 16; ++r) negm[r] = -mhat; asm volatile("" : "+v"(negm)); } \
    _Pragma("unroll") for (int r = 0; r < 16; ++r) P0[r] = __builtin_amdgcn_exp2f(P0[r]); } while (0)
  #define RESC() do { if (resc) { asm volatile("s_waitcnt lgkmcnt(0)" ::: "memory"); \
      _Pragma("unroll") for (int d_ = 0; d_ < 2; ++d_) _Pragma("unroll") for (int r = 0; r < 16; ++r) o[d_][r] *= wsf[crow(r, hi)]; } } while (0)
  f32x16 pA0 = {}, pA1 = {}, pB0 = {}, pB1 = {};
  int sl_prev = 0, sl_cur = 0, sl_next = SLOTB;
  #define ROT() do { sl_prev = sl_cur; sl_cur = sl_next; sl_next = (sl_next == (NSLOT - 1) * SLOTB) ? 0 : sl_next + SLOTB; } while (0)
  DMA_K(2, 2 * SLOTB);
  WAIT_BAR(3);
  qkt(pA0, pA1, Kbase, qr, negm, r32, hi); asm volatile("s_nop 15\n\ts_nop 7" : "+v"(pA0), "+v"(pA1));
  START(pA0, pA1);
  _Pragma("unroll") for (int r = 0; r < 16; ++r) pA1[r] = __builtin_amdgcn_exp2f(pA1[r]);
  WAIT_BAR(0);
  DMA_K(3, 0); DMA_V(1, SLOTB);
  ROT();
  kload8(kf, kp0 + sl_cur);
  WAIT_BAR(2);
  s16x4 vlo[8] = {}, vhi[8] = {}; u32x4 pw0 = {}, pw1 = {}, pw2 = {}, pw3 = {};
  #define PKW(P, B) cvtpk_s(P[B], P[B + 1])
  #define PAF(k) __builtin_bit_cast(bf16x8, pw##k)
  #define VFR(i) (bf16x8){vlo[i][0], vlo[i][1], vlo[i][2], vlo[i][3], vhi[i][0], vhi[i][1], vhi[i][2], vhi[i][3]}
  #define PIN(x) asm volatile("" : "+v"(x))
  #define MX3(a, b, c) __builtin_fmaxf(__builtin_fmaxf((a), (b)), (c))
  #define GAPA(MF, A0, A1, A2, A3, W0, W1, PW) do { MF; sacc += A0; sacc += A1; sacc += A2; sacc += A3; PIN(sacc); W0; W1; PIN(PW); SBAR(); } while (0)
  #define EX(v) __builtin_amdgcn_exp2f(v)
  #define GAPB(MF, X, B) do { MF; X[B] = EX(X[B]); X[B + 1] = EX(X[B + 1]); X[B + 2] = EX(X[B + 2]); X[B + 3] = EX(X[B + 3]); PIN(X); SBAR(); } while (0)
  #define VRD(i) do { vlo[i] = vtr(vp_ + (((i) >> 2) * 4096 + ((i) & 3) * 1024)); vhi[i] = vtr(vp_ + (((i) >> 2) * 4096 + ((i) & 3) * 1024 + 512)); } while (0)
  #define KRD(G, j) do { if (G) { kload2(kf, kp0 + sl_next, j); SBAR(); } } while (0)
  #define STEP(C0, C1, P0, P1, t, GK, GV, GL) do { SBAR(); \
    const lds_cptr vp_ = vp0 + sl_prev; \
    VRD(0); SBAR(); float sacc = (P0[0] + P0[1]); \
    GAPA(C0 = __builtin_amdgcn_mfma_f32_32x32x16_bf16(kf[0], qr[0], negm, 0, 0, 0), P0[2], P0[3], P0[4], P0[5],     pw0[0] = PKW(P0, 0), pw0[1] = PKW(P0, 2), pw0); \
    VRD(4); SBAR(); GAPA(C1 = __builtin_amdgcn_mfma_f32_32x32x16_bf16(kf[1], qr[0], negm, 0, 0, 0), P0[6], P0[7], P0[8], P0[9],     pw0[2] = PKW(P0, 4), pw0[3] = PKW(P0, 6), pw0); \
    VRD(1); SBAR(); GAPA(C0 = __builtin_amdgcn_mfma_f32_32x32x16_bf16(kf[2], qr[1], C0, 0, 0, 0),   P0[10], P0[11], P0[12], P0[13], pw1[0] = PKW(P0, 8), pw1[1] = PKW(P0, 10), pw1); \
    VRD(5); SBAR(); GAPA(C1 = __builtin_amdgcn_mfma_f32_32x32x16_bf16(kf[3], qr[1], C1, 0, 0, 0),   P0[14], P0[15], P1[0], P1[1],   pw1[2] = PKW(P0, 12), pw1[3] = PKW(P0, 14), pw1); \
    VRD(2); SBAR(); GAPA(C0 = __builtin_amdgcn_mfma_f32_32x32x16_bf16(kf[4], qr[2], C0, 0, 0, 0),   P1[2], P1[3], P1[4], P1[5],     pw2[0] = PKW(P1, 0), pw2[1] = PKW(P1, 2), pw2); \
    VRD(6); SBAR(); GAPA(C1 = __builtin_amdgcn_mfma_f32_32x32x16_bf16(kf[5], qr[2], C1, 0, 0, 0),   P1[6], P1[7], P1[8], P1[9],     pw2[2] = PKW(P1, 4), pw2[3] = PKW(P1, 6), pw2); \
    VRD(3); SBAR(); GAPA(C0 = __builtin_amdgcn_mfma_f32_32x32x16_bf16(kf[6], qr[3], C0, 0, 0, 0),   P1[10], P1[11], P1[12], P1[13], pw3[0] = PKW(P1, 8), pw3[1] = PKW(P1, 10), pw3); \
    VRD(7); SBAR(); GAPA(C1 = __builtin_amdgcn_mfma_f32_32x32x16_bf16(kf[7], qr[3], C1, 0, 0, 0),   P1[14], P1[15], 0.f, 0.f,       pw3[2] = PKW(P1, 12), pw3[3] = PKW(P1, 14), pw3); \
    l_reg += sacc; \
    if (GK) { DMA_K((t) + 3, sl_cur); } if (GV) { DMA_V((t) + 1, sl_next); } \
    { float a = MX3(C0[0], C0[1], C1[0]), b = MX3(C0[2], C0[3], C1[1]); a = MX3(a, C1[2], C1[3]); \
      _Pragma("unroll") for (int r = 4; r < 16; r += 4) { a = MX3(a, C0[r], C0[r + 1]); b = MX3(b, C0[r + 2], C0[r + 3]); a = MX3(a, C1[r], C1[r + 1]); b = MX3(b, C1[r + 2], C1[r + 3]); } \
      float rm = __builtin_fmaxf(a, b); { auto rr = __builtin_amdgcn_permlane32_swap(__float_as_uint(rm), __float_as_uint(rm), false, false); rm = __builtin_fmaxf(__uint_as_float(rr[0]), __uint_as_float(rr[1])); } \
      resc = false; \
      if (__builtin_expect(__any(rm > (float)THRL), 0)) { const float dl = __builtin_fmaxf(rm, 0.f); mhat += dl; \
        _Pragma("unroll") for (int r = 0; r < 16; ++r) { C0[r] -= dl; C1[r] -= dl; } \
        _Pragma("unroll") for (int r = 0; r < 16; ++r) negm[r] = -mhat; asm volatile("" : "+v"(negm)); \
        const float f = __builtin_amdgcn_exp2f(-dl); l_reg *= f; if (hi == 0) wsf[r32] = f; resc = true; } } \
    SBAR(); \
    GAPB(o[0] = __builtin_amdgcn_mfma_f32_32x32x16_bf16(PAF(0), VFR(0), o[0], 0, 0, 0), C0, 0); \
    GAPB(o[1] = __builtin_amdgcn_mfma_f32_32x32x16_bf16(PAF(0), VFR(4), o[1], 0, 0, 0), C0, 4); \
    KRD(GL, 0); GAPB(o[0] = __builtin_amdgcn_mfma_f32_32x32x16_bf16(PAF(1), VFR(1), o[0], 0, 0, 0), C0, 8); \
    KRD(GL, 1); GAPB(o[1] = __builtin_amdgcn_mfma_f32_32x32x16_bf16(PAF(1), VFR(5), o[1], 0, 0, 0), C0, 12); \
    KRD(GL, 2); GAPB(o[0] = __builtin_amdgcn_mfma_f32_32x32x16_bf16(PAF(2), VFR(2), o[0], 0, 0, 0), C1, 0); \
    KRD(GL, 3); GAPB(o[1] = __builtin_amdgcn_mfma_f32_32x32x16_bf16(PAF(2), VFR(6), o[1], 0, 0, 0), C1, 4); \
    GAPB(o[0] = __builtin_amdgcn_mfma_f32_32x32x16_bf16(PAF(3), VFR(3), o[0], 0, 0, 0), C1, 8); \
    GAPB(o[1] = __builtin_amdgcn_mfma_f32_32x32x16_bf16(PAF(3), VFR(7), o[1], 0, 0, 0), C1, 12); \
    } while (0)
  int t = 1;
  for (; t + 5 < NT; t += 2) {
    STEP(pB0, pB1, pA0, pA1, t, true, true, true);     WAIT_BAR(2); RESC(); ROT();
    STEP(pA0, pA1, pB0, pB1, t + 1, true, true, true); WAIT_BAR(2); RESC(); ROT();
  }
  #define ENDW(tt) do { if ((tt) + 3 < NT) { WAIT_BAR(2); } else if ((tt) + 2 < NT) { WAIT_BAR(1); } else { WAIT_BAR(0); } } while (0)
  for (; t + 1 < NT; t += 2) {
    STEP(pB0, pB1, pA0, pA1, t, (t + 3 < NT), (t + 1 < NT), (t + 1 < NT));         ENDW(t);     RESC(); ROT();
    STEP(pA0, pA1, pB0, pB1, t + 1, (t + 4 < NT), (t + 2 < NT), (t + 2 < NT));     ENDW(t + 1); RESC(); ROT();
  }
  STEP(pB0, pB1, pA0, pA1, NT - 1, false, false, false); RESC();
  { float sacc = pB0[0] + pB0[1]; _Pragma("unroll") for (int r = 2; r < 16; ++r) sacc += pB0[r]; _Pragma("unroll") for (int r = 0; r < 16; ++r) sacc += pB1[r]; l_reg += sacc;
    pw0 = (u32x4){PKW(pB0, 0), PKW(pB0, 2), PKW(pB0, 4), PKW(pB0, 6)}; pw1 = (u32x4){PKW(pB0, 8), PKW(pB0, 10), PKW(pB0, 12), PKW(pB0, 14)}; pw2 = (u32x4){PKW(pB1, 0), PKW(pB1, 2), PKW(pB1, 4), PKW(pB1, 6)}; pw3 = (u32x4){PKW(pB1, 8), PKW(pB1, 10), PKW(pB1, 12), PKW(pB1, 14)};
    SBAR(); pv(o, vb0 + sl_cur, PAF(0), PAF(1), PAF(2), PAF(3)); }
  #undef PKW
  #undef PAF
  #undef VFR
  #undef PIN
  #undef MX3
  #undef GAPA
  #undef GAPB
  #undef EX
  #undef VRD
  #undef KRD
  #undef STEP
  #undef ENDW
  { auto rr = __builtin_amdgcn_permlane32_swap(__float_as_uint(l_reg), __float_as_uint(l_reg), false, false); l_reg = __uint_as_float(rr[0]) + __uint_as_float(rr[1]); }
  if (hi == 0) wsf[32 + r32] = l_reg; asm volatile("s_waitcnt lgkmcnt(0)" ::: "memory");
  float rli[16];
  #pragma unroll
  for (int r = 0; r < 16; ++r) rli[r] = __builtin_amdgcn_rcpf(wsf[32 + crow(r, hi)]);
  bf16* Ow = O + (rowbase + q0 + wid * QBLK) * OP + h * D;
  { bf16* stg = (bf16*)(shm + LDS_OST) + wid * 2048;
    #pragma unroll
    for (int r = 0; r < 16; ++r) { const int orow = crow(r, hi);
      #pragma unroll
      for (int d0 = 0; d0 < 2; ++d0) stg[orow * 64 + d0 * 32 + r32] = __float2bfloat16(o[d0][r] * rli[r]); }
    asm volatile("s_waitcnt lgkmcnt(0)" ::: "memory");
    #pragma unroll
    for (int i = 0; i < 4; ++i) { const int row = i * 8 + (lane >> 3), ch = lane & 7; const u32x4 v = *(const u32x4*)(stg + row * 64 + ch * 8); ATTN_STORE16(Ow + (long)row * OP + ch * 8, v); } }
  asm volatile("s_waitcnt lgkmcnt(0)\n\ts_barrier" ::: "memory");
  #undef DMA_K
  #undef DMA_V
  #undef START
  #undef RESC
  #undef ROT
}
#undef SBAR
#undef WAIT_BAR
}

typedef GAS unsigned gu32;
#define RLX_AGENT __ATOMIC_RELAXED, __HIP_MEMORY_SCOPE_AGENT
#define XB_TMO      128
#define XB_XCNT(j)  (256  + 64 * (j))
#define XB_XSUB(j)  (1280 + 64 * (j))
#define XB_XGEN(j)  (2304 + 64 * (j))
#define XB_TOP      3328
#define XB_TOPGEN   3392
#define XCD_BAR_WORDS 3456
#define XB_SPIN_CAP (1u << 22)
__device__ __forceinline__ unsigned xb_ld(unsigned* p)              { return __hip_atomic_load(p, __ATOMIC_RELAXED, __HIP_MEMORY_SCOPE_AGENT); }
__device__ __forceinline__ unsigned xb_add(unsigned* p, unsigned v) { return __hip_atomic_fetch_add(p, v, __ATOMIC_RELAXED, __HIP_MEMORY_SCOPE_AGENT); }
__device__ __forceinline__ unsigned xb_xcc_id() { return (unsigned)__builtin_amdgcn_s_getreg((3 << 11) | 20) & 0xFu; }
#define XB_SPIN(cond, bar) do { unsigned _sp = 0; while (cond) { __builtin_amdgcn_s_sleep(1); \
    if ((++_sp & 255u) == 0u) { if (xb_ld(&(bar)[XB_TMO])) break; if (_sp > XB_SPIN_CAP) { atomicAdd(&(bar)[XB_TMO], 1u); break; } } } } while (0)
struct XcdBarrier { unsigned* bar; unsigned x; volatile LAS unsigned* st; };
__device__ __forceinline__ XcdBarrier xcd_barrier_post(unsigned* bar, volatile LAS unsigned* st) {
    XcdBarrier b; b.bar = bar; b.x = xb_xcc_id(); b.st = st;
    if (threadIdx.x == 0) st[2] = xb_add(&bar[XB_XCNT(b.x)], 1u);
    return b;
}
__device__ __forceinline__ void xcd_barrier_complete(unsigned* bar, unsigned x, unsigned& nloc, unsigned& nx) {
    const unsigned G = gridDim.x * gridDim.y * gridDim.z;
    unsigned sum, cnt, mine, sp = 0u;
    for (;;) {
        sum = 0u; cnt = 0u; mine = 0u;
#pragma unroll
        for (unsigned j = 0; j < 16; ++j) { const unsigned c = xb_ld(&bar[XB_XCNT(j)]); sum += c; cnt += (c > 0u) ? 1u : 0u; mine = (j == x) ? c : mine; }
        if (sum == G) break;
        __builtin_amdgcn_s_sleep(1);
        if ((++sp & 255u) == 0u) { if (xb_ld(&bar[XB_TMO])) break; if (sp > XB_SPIN_CAP) { atomicAdd(&bar[XB_TMO], 1u); break; } }
    }
    nloc = mine > 0u ? mine : 1u; nx = cnt > 0u ? cnt : 1u;
}
__device__ __forceinline__ void xcd_barrier(const XcdBarrier& b) {
    asm volatile("s_waitcnt vmcnt(0)" ::: "memory");
    __syncthreads();
    if (threadIdx.x == 0) {
        unsigned* bar = b.bar;
        __builtin_amdgcn_s_waitcnt(0);
        unsigned nloc = b.st[0], nx = b.st[1];
        if (nloc == 0u) { xcd_barrier_complete(bar, b.x, nloc, nx); b.st[0] = nloc; b.st[1] = nx; }
        const unsigned old = xb_add(&bar[XB_XSUB(b.x)], 1u);
        const unsigned gen = old / nloc;
        if (old + 1u == (gen + 1u) * nloc) {
            __builtin_amdgcn_fence(__ATOMIC_RELEASE, "agent");
            asm volatile("s_waitcnt vmcnt(0)" ::: "memory");
            const unsigned og = xb_add(&bar[XB_TOP], 1u);
            const unsigned tg = og / nx;
            if (og + 1u == (tg + 1u) * nx) xb_add(&bar[XB_TOPGEN], 1u);
            else XB_SPIN(xb_ld(&bar[XB_TOPGEN]) == tg, bar);
            __builtin_amdgcn_fence(__ATOMIC_ACQUIRE, "agent");
            xb_add(&bar[XB_XGEN(b.x)], 1u);
            asm volatile("s_waitcnt vmcnt(0)" ::: "memory");
        } else {
            XB_SPIN(xb_ld(&bar[XB_XGEN(b.x)]) == gen, bar);
            __builtin_amdgcn_fence(__ATOMIC_ACQUIRE, "agent");
            asm volatile("s_waitcnt vmcnt(0)" ::: "memory");
        }
    }
    __syncthreads();
}

struct Args { const float* in[30]; float* out; unsigned char* ws; int ph_lo, ph_hi, multi, pad; };
typedef const __attribute__((address_space(4))) unsigned char* kptr_t;
struct PArgs { kptr_t kp; unsigned char* ws_; float* out_;
    __device__ __forceinline__ const float* in(int i) const { return (const float*)(const GAS float*)(*(const float* const __attribute__((address_space(4)))*)(kp + 8 * i)); }
    __device__ __forceinline__ unsigned char* ws() const { return (unsigned char*)(GAS unsigned char*)ws_; }
    __device__ __forceinline__ float* out() const { return (float*)(GAS float*)out_; } };
enum { I_X = 0, I_WIN, I_MUP, I_MUN, I_POOLW, I_POOLS, I_W0, I_WUP, I_A0, I_AUP, I_GUP, I_KK, I_KA, I_RK, I_GNG, I_GNB, I_QN, I_KN, I_WO, I_LN1G, I_LN1B,
       I_RG, I_RGB, I_RE, I_REB, I_EG, I_EU, I_ED, I_LN2G, I_LN2B };
constexpr int LDSCTL_OFF = 163840 - 256;
constexpr int MOE_TAB_OFF = 131072 + 2048;

__device__ __forceinline__ void transpose_item(const float* W, int N, int k0, int n0, bf16_t* WT, int Kout, int row0, LAS float* scr, int lane) {
    float tv[32];
#pragma unroll
    for (int i = 0; i < 32; ++i) { const int kk = 2 * i + (lane >> 5); tv[i] = ((const GAS float*)W)[(size_t)(k0 + kk) * N + n0 + (lane & 31)]; }
#pragma unroll
    for (int i = 0; i < 32; ++i) { const int kk = 2 * i + (lane >> 5); scr[kk * 33 + (lane & 31)] = tv[i]; }
    asm volatile("s_waitcnt lgkmcnt(0)" ::: "memory");
    const int c = lane & 7;
#pragma unroll
    for (int j = 0; j < 4; ++j) { const int n = (lane >> 3) + 8 * j; const LAS float* s = scr + (8 * c) * 33 + n;
        u32x4 o; o.x = cvtpk(s[0 * 33], s[1 * 33]); o.y = cvtpk(s[2 * 33], s[3 * 33]); o.z = cvtpk(s[4 * 33], s[5 * 33]); o.w = cvtpk(s[6 * 33], s[7 * 33]);
        *(GAS u32x4*)(WT + (size_t)(row0 + n) * Kout + k0 + 8 * c) = o; }
    asm volatile("s_waitcnt lgkmcnt(0)" ::: "memory");
}
__device__ __forceinline__ void sincos_d(double a, double& s, double& c) {
    const double TWO_PI = 6.283185307179586476925;
    const double n = rint(a / TWO_PI); const double r = a - n * TWO_PI;
    const double q = r * 0.25, q2 = q * q;
    const double sq = q * (1.0 + q2 * (-1.0 / 6 + q2 * (1.0 / 120 + q2 * (-1.0 / 5040 + q2 * (1.0 / 362880 + q2 * (-1.0 / 39916800 + q2 * (1.0 / 6227020800.0)))))));
    const double cq = 1.0 + q2 * (-0.5 + q2 * (1.0 / 24 + q2 * (-1.0 / 720 + q2 * (1.0 / 40320 + q2 * (-1.0 / 3628800 + q2 * (1.0 / 479001600.0 + q2 * (-1.0 / 87178291200.0)))))));
    const double s2 = 2 * sq * cq, c2 = 1 - 2 * sq * sq;
    s = 2 * s2 * c2; c = 1 - 2 * s2 * s2;
}
__device__ __forceinline__ void convert_layer_weights(const PArgs& a, LAS unsigned char* lds, int l, int vcu, int G, int sel) {
    unsigned char* ws = a.ws();
    int tid_ = threadIdx.x; asm volatile("" : "+v"(tid_)); const int tid = tid_, lane = tid & 63, wave = __builtin_amdgcn_readfirstlane(tid >> 6);
    const int gw = vcu * NWAVES + wave, NGW = G * NWAVES;
    const size_t gt = (size_t)vcu * NTHR + tid, NGT = (size_t)G * NTHR;
    LAS float* scr = (LAS float*)(lds + wave * 16384);
    constexpr int I_A = 16 * 62, I_B = 16 * 32, I_C = 32 * 16 * 16, I_E = 32 * 8 * 32, PER_L = I_A + I_B + 2 * I_C + I_E;
    const int it_lo = (sel & 1) ? 0 : I_A + I_B, it_hi = (sel & 2) ? PER_L : I_A + I_B;
    for (int it = it_lo + gw; it < it_hi; it += NGW) {
        int r = it;
        if (r < I_A) { const int kb = r / 62, nb = r % 62; transpose_item(a.in(I_WIN) + (size_t)l * DM * INW, INW, 64 * kb, 32 * nb, (bf16_t*)(ws + WS_WIN + (size_t)l * 4 * MiB), DM, 32 * nb, scr, lane); continue; } r -= I_A;
        if (r < I_B) { const int kb = r / 32, nb = r % 32; transpose_item(a.in(I_WO) + (size_t)l * DM * DM, DM, 64 * kb, 32 * nb, (bf16_t*)(ws + WS_WO + (size_t)l * 2 * MiB), DM, 32 * nb, scr, lane); continue; } r -= I_B;
        if (r < 2 * I_C) { const int up = r >= I_C; if (up) r -= I_C; const int e = r / 256, rr = r % 256, kb = rr / 16, nb = rr % 16; const int n0 = 32 * nb;
            transpose_item(a.in(up ? I_EU : I_EG) + ((size_t)l * NEXP + e) * DM * EH, EH, 64 * kb, n0, (bf16_t*)(ws + WS_WGU) + (size_t)e * 1024 * DM, DM, 256 * (n0 >> 7) + (n0 & 127) + (up ? 128 : 0), scr, lane); continue; } r -= 2 * I_C;
        { const int e = r / 256, rr = r % 256, kb = rr / 32, nb = rr % 32;
            transpose_item(a.in(I_ED) + ((size_t)l * NEXP + e) * EH * DM, DM, 64 * kb, 32 * nb, (bf16_t*)(ws + WS_WD) + (size_t)e * DM * EH, EH, 32 * nb, scr, lane); }
    }
    if (sel & 1) for (size_t i = gt; i < (size_t)64 * DM / 8; i += NGT) *(GAS u32x4*)((bf16_t*)(ws + WS_WIN + (size_t)l * 4 * MiB) + (size_t)INW * DM + i * 8) = (u32x4){0u, 0u, 0u, 0u};
}
__device__ __forceinline__ void phase_prologue(const PArgs& a, LAS unsigned char* lds, int vcu, int G) {
    unsigned char* ws = a.ws();
    int tid_ = threadIdx.x; asm volatile("" : "+v"(tid_)); const int tid = tid_, lane = tid & 63, wave = __builtin_amdgcn_readfirstlane(tid >> 6);
    const int gw = vcu * NWAVES + wave, NGW = G * NWAVES;
    const size_t gt = (size_t)vcu * NTHR + tid, NGT = (size_t)G * NTHR;
    LAS float* scr = (LAS float*)(lds + wave * 16384);
    convert_layer_weights(a, lds, 0, vcu, G, 3);
#pragma unroll 1
    for (int l = 1; l < DEPTH; ++l) convert_layer_weights(a, lds, l, vcu, G, 1);
    for (size_t i = gt; i < (size_t)NTOK * DM / 8; i += NGT) { const f32x4 v0 = *(const GAS f32x4*)(a.in(I_X) + i * 8), v1 = *(const GAS f32x4*)(a.in(I_X) + i * 8 + 4);
        u32x4 o; o.x = cvtpk(v0[0], v0[1]); o.y = cvtpk(v0[2], v0[3]); o.z = cvtpk(v1[0], v1[1]); o.w = cvtpk(v1[2], v1[3]);
        *(GAS u32x4*)((bf16_t*)(ws + WS_XN) + i * 8) = o; }
    unsigned char* sm = ws + WS_SMALL;
    for (size_t i = gt; i < 64 * 16; i += NGT) { const int pos = (int)(i >> 4), f = (int)(i & 15); double inv = 1.0; for (int k = 0; k < f; ++k) inv *= 0.56234132519034908;
        double s, c; sincos_d((double)pos * inv, s, c); float* R = (float*)(sm + SM_ROPE) + pos * 32; R[f] = (float)c; R[16 + f] = (float)s; }
    for (size_t i = gt; i < (size_t)DEPTH * 4 * 64 * 64; i += NGT) { const int k = (int)(i & 63), n = (int)((i >> 6) & 63); const size_t lg = i >> 12;
        ((bf16_t*)(sm + SM_PWT))[i] = (bf16_t)(cvtpk(a.in(I_POOLW)[(lg * 64 + k) * 64 + n], 0.f) & 0xffffu); }
    for (size_t i = gt; i < (size_t)DEPTH * 2 * 256 * 32; i += NGT) { const int k = (int)(i & 31), n = (int)((i >> 5) & 255); const size_t ld = i >> 13;
        ((bf16_t*)(sm + SM_WUPT))[i] = (bf16_t)(cvtpk(a.in(I_WUP)[(ld * 32 + k) * 256 + n], 0.f) & 0xffffu);
        ((bf16_t*)(sm + SM_AUPT))[i] = (bf16_t)(cvtpk(a.in(I_AUP)[(ld * 32 + k) * 256 + n], 0.f) & 0xffffu); }
    for (size_t i = gt; i < (size_t)DEPTH * 256 * 64; i += NGT) { const int k = (int)(i & 63), n = (int)((i >> 6) & 255); const size_t l = i >> 14;
        ((bf16_t*)(sm + SM_GUPT))[i] = (bf16_t)(cvtpk(a.in(I_GUP)[(l * 64 + k) * 256 + n], 0.f) & 0xffffu); }
    for (size_t i = gt; i < (size_t)DEPTH * 48 * 1024; i += NGT) { const int k = (int)(i & 1023); const int c = (int)((i >> 10) % 48); const size_t l = i / (48 * 1024);
        const float w = (c < 32 ? ((const GAS float*)a.in(I_RE))[(l * DM + k) * 32 + c] : (c < 36 ? ((const GAS float*)a.in(I_RG))[(l * DM + k) * 4 + (c - 32)] : 0.f)) * ((const GAS float*)a.in(I_LN1G))[l * DM + k];
        const unsigned hi_ = cvtpk(w, 0.f) & 0xffffu; const float lo_ = w - __uint_as_float(hi_ << 16);
        bf16_t* RWB = (bf16_t*)(ws + WS_RWB) + l * 2 * 48 * 1024; RWB[c * 1024 + k] = (bf16_t)hi_; RWB[48 * 1024 + c * 1024 + k] = (bf16_t)(cvtpk(lo_, 0.f) & 0xffffu); }
    for (int it = gw; it < DEPTH * 48; it += NGW) { const int l = it / 48, c = it % 48; float sb_ = 0.f;
        if (c < 36) for (int k = lane; k < DM; k += 64) sb_ += ((const GAS float*)a.in(I_LN1B))[l * DM + k] * (c < 32 ? ((const GAS float*)a.in(I_RE))[((size_t)l * DM + k) * 32 + c] : ((const GAS float*)a.in(I_RG))[((size_t)l * DM + k) * 4 + (c - 32)]);
        sb_ = wave_sum(sb_); if (lane == 0) ((GAS float*)(ws + WS_RB))[it] = sb_; }
}

constexpr size_t REC_BYTES = 13568, REC_AOP = 0  , REC_AY = 5120  , REC_AS = 7168  , REC_GC = 11264  , REC_VT = 11520  ;
__device__ __forceinline__ int permp(int x) { return (x & 3) | ((x & 4) << 1) | ((x & 8) >> 1); }
__device__ __forceinline__ bf16x8 pack_frag(const float (&x)[8]) { u32x4 o; o.x = cvtpk(x[0], x[1]); o.y = cvtpk(x[2], x[3]); o.z = cvtpk(x[4], x[5]); o.w = cvtpk(x[6], x[7]); return __builtin_bit_cast(bf16x8, o); }
__device__ __forceinline__ void swap32(float a, float b, float& lo, float& hi) {
    auto rr = __builtin_amdgcn_permlane32_swap(__float_as_uint(a), __float_as_uint(b), false, false); lo = __uint_as_float(rr[0]); hi = __uint_as_float(rr[1]); }

__device__ __forceinline__ void scan_pre_item(const PArgs& a, LAS bf16_t* X, int bh, int dir, int c, int lane, int var = 0) {
    unsigned char* ws0 = a.ws_; asm volatile("" : "+s"(ws0)); unsigned char* ws = (unsigned char*)(GAS unsigned char*)ws0;
    asm volatile("" : "+v"(lane));
    const int l31 = lane & 31, hi = lane >> 5;
    {
        const int item = (bh * 2 + dir) * 128 + c;
        const size_t hb = (size_t)bh * SEQ * 64 + lane;
        const GAS unsigned short* gW = (const GAS unsigned short*)(ws + (dir ? WS_WH1 : WS_WH0)) + hb; const GAS bf16_t* gV = (const GAS bf16_t*)(ws + WS_V) + hb;
        const GAS unsigned char* gFC = (const GAS unsigned char*)(ws + (dir ? WS_FC1 : WS_FC0)) + ((size_t)bh * SEQ * 32 + (lane >> 1)) * 16;
        unsigned char* rec = ws + WS_REC + (size_t)item * REC_BYTES;
        float ah[16], bhh[16], khh[16], rh[16]; unsigned vv2[8] = {0u, 0u, 0u, 0u, 0u, 0u, 0u, 0u};
        float g = 1.f;
        {
            u32x4 ck[16]; unsigned short wr_[16], vr[16];
#pragma unroll
            for (int t = 0; t < 16; ++t) { const int tt = dir ? SEQ - 1 - (16 * c + t) : 16 * c + t; const size_t o = (size_t)tt * 64;
                ck[t] = *(const GAS u32x4*)(gFC + (size_t)tt * 512); wr_[t] = gW[o]; vr[t] = gV[o]; }
            asm volatile("" ::: "memory");
            const int sh = (lane & 1) * 16;
#pragma unroll
            for (int t = 0; t < 16; ++t) {
                const float w = (float)__builtin_bit_cast(_Float16, wr_[t]), b = __uint_as_float((ck[t].x >> sh) << 16), kh = __uint_as_float((ck[t].y >> sh) << 16), kk = __uint_as_float((ck[t].z >> sh) << 16), r = __uint_as_float((ck[t].w >> sh) << 16);
                vv2[t >> 1] |= (unsigned)vr[t] << (16 * (t & 1));
                ah[t] = g * kk; g *= w; const float ig = __builtin_amdgcn_rcpf(g); bhh[t] = b * ig; khh[t] = kh * ig; rh[t] = g * r; }
        }
        const float gC = g;
#pragma unroll
        for (int t = 0; t < 16; ++t) { X[(0 * 16 + t) * 64 + lane] = (bf16_t)(cvtpk(ah[t], 0.f) & 0xffffu); X[(1 * 16 + t) * 64 + lane] = (bf16_t)(cvtpk(bhh[t], 0.f) & 0xffffu);
            X[(2 * 16 + t) * 64 + lane] = (bf16_t)(cvtpk(khh[t], 0.f) & 0xffffu); X[(3 * 16 + t) * 64 + lane] = (bf16_t)(cvtpk(rh[t], 0.f) & 0xffffu); }
        f32x16 Nacc = f32x16{};
        { const LAS bf16_t* pa = X + ((l31 < 16 ? 1 : 2) * 16 + (l31 & 15)) * 64 + 8 * hi; const LAS bf16_t* pb = X + ((l31 < 16 ? 0 : 3) * 16 + (l31 & 15)) * 64 + 8 * hi;
#pragma unroll
          for (int ks = 0; ks < 4; ++ks) Nacc = __builtin_amdgcn_mfma_f32_32x32x16_bf16(*(const LAS bf16x8*)(pa + 16 * ks), *(const LAS bf16x8*)(pb + 16 * ks), Nacc, 0, 0, 0); }
        float NB[16], NK[16];
        { const int lim = (l31 & 15) + (l31 >> 4);
#pragma unroll
          for (int r = 0; r < 16; ++r) { float lo_, oth; swap32(Nacc[r], Nacc[r], lo_, oth);
              const int r7 = r & 7, s_own = (r7 & 3) + 8 * (r7 >> 2), s_oth = s_own + 4;
              const float vo = (s_own < lim) ? Nacc[r] : 0.f, vt = (s_oth < lim) ? oth : 0.f;
              if (r < 8) { NB[s_own] = vo; NB[s_oth] = vt; } else { NK[s_own] = vo; NK[s_oth] = vt; } } }
        float Tc[16], Mc[16];
#pragma unroll
        for (int s_ = 0; s_ < 16; ++s_) { Tc[s_] = (s_ == lane) ? 1.f : 0.f; Mc[s_] = 0.f; }
        if (var < 2) {
#pragma unroll
        for (int p = 0; p < 15; ++p)
#pragma unroll
            for (int s_ = 0; s_ <= p; ++s_) { const float tb_ = __int_as_float(__builtin_amdgcn_readlane(__float_as_int(Tc[s_]), p)); Tc[s_] -= tb_ * NB[p]; }
#pragma unroll
        for (int p = 1; p < 16; ++p)
#pragma unroll
            for (int s_ = 0; s_ < p; ++s_) { const float nb_ = __int_as_float(__builtin_amdgcn_readlane(__float_as_int(NK[s_]), p)); Mc[s_] += nb_ * Tc[p]; }
        }
        f32x16 Ap0, Ap1;
        { float ta[8], f0[8], f1[8];
#pragma unroll
          for (int jj = 0; jj < 8; ++jj) { float lo_, hi_; swap32(Tc[jj], Tc[8 + jj], lo_, hi_); ta[jj] = lo_; swap32(ah[jj], ah[8 + jj], f0[jj], f1[jj]); }
          const bf16x8 TA = pack_frag(ta);
          Ap0 = __builtin_amdgcn_mfma_f32_32x32x16_bf16(TA, pack_frag(f0), f32x16{}, 0, 0, 0); Ap1 = __builtin_amdgcn_mfma_f32_32x32x16_bf16(TA, pack_frag(f1), f32x16{}, 0, 0, 0); }
        if (var == 0) {
#define FRAG_OFF(m, ks, p) ((ks) * 1024 + ((m) + 32 * ((p) >> 3)) * 16 + ((p) & 7) * 2)
        { LAS unsigned char* AL = (LAS unsigned char*)X;
          { const int ksl = l31 >> 4, pj = permp(l31 & 15);
#pragma unroll
            for (int r = 0; r < 8; ++r) { const int t = (r & 3) + 8 * (r >> 2) + 4 * hi;
                *(LAS bf16_t*)(AL + FRAG_OFF(t, ksl, pj)) = (bf16_t)(cvtpk(Ap0[r], 0.f) & 0xffffu); *(LAS bf16_t*)(AL + FRAG_OFF(t, 2 + ksl, pj)) = (bf16_t)(cvtpk(Ap1[r], 0.f) & 0xffffu); } }
          { const int ksj = lane >> 4, pj = permp(lane & 15);
#pragma unroll
            for (int t = 0; t < 16; ++t) *(LAS bf16_t*)(AL + FRAG_OFF(16 + t, ksj, pj)) = (bf16_t)(cvtpk(rh[t], 0.f) & 0xffffu); }
          if (lane < 16) { float m0[8], m1[8];
#pragma unroll
              for (int jj = 0; jj < 8; ++jj) { m0[jj] = Mc[jj]; m1[jj] = Mc[8 + jj]; }
              *(LAS bf16x8*)(AL + 4096 + lane * 16) = pack_frag(m0); *(LAS bf16x8*)(AL + 4096 + (lane + 32) * 16) = pack_frag(m1);
              *(LAS u32x4*)(AL + 4096 + (16 + lane) * 16) = (u32x4){0u, 0u, 0u, 0u}; *(LAS u32x4*)(AL + 4096 + (48 + lane) * 16) = (u32x4){0u, 0u, 0u, 0u}; }
          asm volatile("s_waitcnt lgkmcnt(0)" ::: "memory");
#pragma unroll
          for (int k = 0; k < 5; ++k) { const u32x4 v = *(const LAS u32x4*)(AL + k * 1024 + lane * 16); *(GAS u32x4*)(rec + REC_AOP + k * 1024 + lane * 16) = v; }
          asm volatile("s_waitcnt lgkmcnt(0)" ::: "memory"); }
        if (lane >= 16 && lane < 32) { unsigned char* AY = rec + REC_AY; const int t = lane - 16;
            float y0[8], y1[8], y2[8], y3[8];
#pragma unroll
            for (int jj = 0; jj < 8; ++jj) { y0[jj] = -NB[permp(jj)]; y1[jj] = -NB[permp(8 + jj)]; y2[jj] = NK[jj]; y3[jj] = NK[8 + jj]; }
            *(GAS bf16x8*)(AY + t * 16) = pack_frag(y0); *(GAS bf16x8*)(AY + (t + 32) * 16) = pack_frag(y1); *(GAS bf16x8*)(AY + 1024 + t * 16) = pack_frag(y2); *(GAS bf16x8*)(AY + 1024 + (t + 32) * 16) = pack_frag(y3);
            const u32x4 z = {0u, 0u, 0u, 0u};
            *(GAS u32x4*)(AY + (16 + t) * 16) = z; *(GAS u32x4*)(AY + (48 + t) * 16) = z; *(GAS u32x4*)(AY + 1024 + (16 + t) * 16) = z; *(GAS u32x4*)(AY + 1024 + (48 + t) * 16) = z; }
        { unsigned char* AS = rec + REC_AS + (lane >> 5) * 2048; const int jl = lane & 31;
            float s0[8], s1[8], s2[8], s3[8];
#pragma unroll
            for (int jj = 0; jj < 8; ++jj) { s0[jj] = -bhh[permp(jj)] * gC; s1[jj] = -bhh[permp(8 + jj)] * gC; s2[jj] = khh[jj] * gC; s3[jj] = khh[8 + jj] * gC; }
            *(GAS bf16x8*)(AS + jl * 16) = pack_frag(s0); *(GAS bf16x8*)(AS + (jl + 32) * 16) = pack_frag(s1); *(GAS bf16x8*)(AS + 1024 + jl * 16) = pack_frag(s2); *(GAS bf16x8*)(AS + 1024 + (jl + 32) * 16) = pack_frag(s3); }
        { const int jl = lane & 31; ((GAS float*)(rec + REC_GC))[(lane >> 5) * 32 + ((jl >> 2) & 1) * 16 + (jl & 3) + 4 * (jl >> 3)] = gC; }
        { unsigned char* VT = rec + REC_VT + (lane >> 5) * 1024; const int il = lane & 31;
            *(GAS u32x4*)(VT + il * 16) = (u32x4){vv2[0], vv2[1], vv2[2], vv2[3]};
            *(GAS u32x4*)(VT + (il + 32) * 16) = (u32x4){vv2[4], vv2[5], vv2[6], vv2[7]}; }
        } else { asm volatile("" :: "v"(Ap0[0]), "v"(Ap1[0]), "v"(Mc[0]), "v"(NB[1]), "v"(NK[1]), "v"(gC), "v"(vv2[0])); }
#undef FRAG_OFF
    }
}

constexpr int FT_STRIDE = 968, DT_STRIDE = 264, DT_OFF = 64 * FT_STRIDE * 2;
static_assert(DT_OFF + 64 * DT_STRIDE * 2 <= LDSCTL_OFF, "prep LDS");
__device__ __forceinline__ void unpack8(const u32x4 w, float (&x)[8]) { x[0] = bflo(w.x); x[1] = bfhi(w.x); x[2] = bflo(w.y); x[3] = bfhi(w.y); x[4] = bflo(w.z); x[5] = bfhi(w.z); x[6] = bflo(w.w); x[7] = bfhi(w.w); }
__device__ __forceinline__ u32x4 pack8(const float (&x)[8]) { u32x4 o; o.x = cvtpk(x[0], x[1]); o.y = cvtpk(x[2], x[3]); o.z = cvtpk(x[4], x[5]); o.w = cvtpk(x[6], x[7]); return o; }
__device__ __forceinline__ void unpack4(const u32x2 w, float (&x)[4]) { x[0] = bflo(w.x); x[1] = bfhi(w.x); x[2] = bflo(w.y); x[3] = bfhi(w.y); }

__device__ __forceinline__ void phase_prep(const PArgs& a_in, LAS unsigned char* lds, int l, int dry, int i0, int ihi, int istep, const unsigned* pcnt) {
    int tid_ = threadIdx.x; asm volatile("" : "+v"(tid_)); const int tid = tid_, lane = tid & 63, wave = __builtin_amdgcn_readfirstlane(tid >> 6), l31 = lane & 31, hi = lane >> 5;
    LAS bf16_t* Ft = (LAS bf16_t*)lds; LAS bf16_t* Dt = (LAS bf16_t*)(lds + DT_OFF);
    for (int item = i0; item < (dry >= 5 ? 0 : ihi); item += istep) {
        const int tb = item * 64, t0 = tb & (SEQ - 1), bidx = tb / SEQ;
        if (pcnt) { const int pm = item >> 2, q = item & 3; unsigned* tmo = (unsigned*)(a_in.ws() + WS_CTL) + 8;
            wait_count(pcnt + 16 * pm, 64u, tmo);
            if (q == 0 && t0 > 0) wait_count(pcnt + 16 * (pm - 1), 64u, tmo);
            if (q == 3 && t0 + 64 < SEQ) wait_count(pcnt + 16 * (pm + 1), 64u, tmo); }
        PArgs a = a_in; asm volatile("" : "+s"(a.kp), "+s"(a.ws_));
        unsigned char* ws = a.ws(); unsigned char* sm = ws + WS_SMALL; bf16_t* PROJ = (bf16_t*)(ws + WS_PROJ); bf16_t* MIX = (bf16_t*)(ws + WS_MIX); const float* ROPE = (const float*)(sm + SM_ROPE);
        int tv = tid; asm volatile("" : "+v"(tv));
        {
            u32x4 raw[10];
#pragma unroll
            for (int it = 0; it < 10; ++it) { const int idx = tv + NTHR * it, chunk = idx & 7, hv = idx >> 3, tok = hv / 10, head = hv - tok * 10;
                const int col = head < 8 ? C_Q + head * 64 : C_K + (head - 8) * 64;
                raw[it] = *(const GAS u32x4*)(PROJ + (size_t)(tb + tok) * INP + col + chunk * 8); }
#pragma unroll
            for (int it = 0; it < 10; ++it) { const int idx = tv + NTHR * it, chunk = idx & 7, hv = idx >> 3, tok = hv / 10, head = hv - tok * 10;
                const int col = head < 8 ? C_Q + head * 64 : C_K + (head - 8) * 64;
                bf16_t* p = PROJ + (size_t)(tb + tok) * INP + col + chunk * 8;
                float x[8]; unpack8(raw[it], x);
                float ss = 0.f;
#pragma unroll
                for (int j = 0; j < 8; ++j) ss += x[j] * x[j];
                ss += __shfl_xor(ss, 1); ss += __shfl_xor(ss, 2); ss += __shfl_xor(ss, 4);
                const float rs = rsqrtf(ss * (1.f / 64.f) + QK_EPS);
                const GAS float* gw = (const GAS float*)(a.in(head < 8 ? I_QN : I_KN) + l * 64 + chunk * 8);
                const int t = t0 + tok, pos = chunk < 4 ? (t >> 6) : (t & 63);
                const GAS float* ct = (const GAS float*)(ROPE + pos * 32 + (chunk & 1) * 8);
                const float sgn = (chunk & 2) ? 1.f : -1.f, qs = head < 8 ? QSCALE : 1.f;
                float y[8], o[8];
#pragma unroll
                for (int j = 0; j < 8; ++j) y[j] = x[j] * rs * gw[j];
#pragma unroll
                for (int j = 0; j < 8; ++j) { const float yp = __shfl_xor(y[j], 2); o[j] = (y[j] * ct[j] + sgn * yp * ct[16 + j]) * qs; }
                if (!dry) *(GAS u32x4*)p = pack8(o); }
        }
        asm volatile("" ::: "memory");
        if (tv < 480) {
            const int ch8 = tv % 120, tg = tv / 120, c = ch8 * 8;
            float mp[8], mn[8];
#pragma unroll
            for (int j = 0; j < 8; ++j) { mp[j] = ((const GAS float*)a.in(I_MUP))[l * 960 + c + j]; mn[j] = ((const GAS float*)a.in(I_MUN))[l * 960 + c + j]; }
            const int mode = (c >= 768 && c < 832) ? 1 : (c >= 896 ? 2 : 0);
#pragma unroll
            for (int hf = 0; hf < 2; ++hf) {
                asm volatile("" ::: "memory");
                const int tk0 = tg * 16 + hf * 8;
                u32x4 rw[10];
#pragma unroll
                for (int r = 0; r < 10; ++r) { const int t = t0 + tk0 - 1 + r;
                    rw[r] = (t >= 0 && t < SEQ) ? *(const GAS u32x4*)(PROJ + (size_t)(tb + tk0 - 1 + r) * INP + C_RW + c) : (u32x4){0u, 0u, 0u, 0u}; }
#pragma unroll
                for (int k = 0; k < 8; ++k) { float pp[8], p[8], pn[8], f[8]; unpack8(rw[k], pp); unpack8(rw[k + 1], p); unpack8(rw[k + 2], pn);
#pragma unroll
                    for (int j = 0; j < 8; ++j) f[j] = p[j] + mp[j] * (pp[j] - p[j]) + mn[j] * (pn[j] - p[j]);
                    if (mode == 1) {
#pragma unroll
                        for (int j = 0; j < 8; ++j) f[j] = 1.f - 2.f * __builtin_amdgcn_rcpf(__expf(2.f * f[j]) + 1.f);
                    } else if (mode == 2) {
#pragma unroll
                        for (int j = 0; j < 8; ++j) f[j] = sigmoidf_(f[j]);
                    }
                    *(LAS u32x4*)(Ft + (tk0 + k) * FT_STRIDE + c) = pack8(f); }
            }
        }
        asm volatile("" ::: "memory");
#pragma unroll 1
        for (int it = 0; it < 4; ++it) {
            asm volatile("" ::: "memory");
            const int idx = tv + NTHR * it, tok = idx >> 5, ch8 = idx & 31, g = ch8 >> 3, w = 2 << g, t = t0 + tok;
            const bf16_t* base = PROJ + (size_t)(bidx * SEQ) * INP + ch8 * 8;
            u32x4 rw[16];
#pragma unroll
            for (int i = 0; i < 16; ++i) { const int r = t - (w >> 1) + i; rw[i] = (i < w && r >= 0 && r < SEQ) ? *(const GAS u32x4*)(base + (size_t)r * INP) : (u32x4){0u, 0u, 0u, 0u}; }
            const u32x4 ur = *(const GAS u32x4*)(base + (size_t)t * INP);
            float acc[8] = {0.f, 0.f, 0.f, 0.f, 0.f, 0.f, 0.f, 0.f};
#pragma unroll
            for (int i = 0; i < 16; ++i) { float v[8]; unpack8(rw[i], v);
#pragma unroll
                for (int j = 0; j < 8; ++j) acc[j] += v[j]; }
            const int lo = max(t - (w >> 1), 0), hiw = min(t + (w >> 1), SEQ);
            float u[8]; unpack8(ur, u);
            const float inv = 1.f / (float)(hiw - lo);
            float d[8];
#pragma unroll
            for (int j = 0; j < 8; ++j) d[j] = acc[j] * inv - u[j];
            *(LAS u32x4*)(Dt + tok * DT_STRIDE + ch8 * 8) = pack8(d);
        }
        __syncthreads();
        if (dry != 2) {
        const int th = wave & 1, hd = wave >> 1, tokl = 32 * th + l31;
        const int ce = 64 * hd + 2 * l31;
#define TOKR(r) (32 * th + ((r) & 3) + 8 * ((r) >> 2) + 4 * hi)
        {
            const bf16_t* PWT = (const bf16_t*)(sm + SM_PWT) + (size_t)(l * 4 + hd) * 4096;
            f32x16 pe = f32x16{}, po = f32x16{};
#pragma unroll
            for (int s = 0; s < 4; ++s) { const bf16x8 A = *(const LAS bf16x8*)(Dt + tokl * DT_STRIDE + 64 * hd + 16 * s + 8 * hi);
                pe = __builtin_amdgcn_mfma_f32_32x32x16_bf16(A, *(const GAS bf16x8*)(PWT + (2 * l31) * 64 + 16 * s + 8 * hi), pe, 0, 0, 0);
                po = __builtin_amdgcn_mfma_f32_32x32x16_bf16(A, *(const GAS bf16x8*)(PWT + (2 * l31 + 1) * 64 + 16 * s + 8 * hi), po, 0, 0, 0); }
            const f32x2 sc = *(const GAS f32x2*)(a.in(I_POOLS) + l * 256 + ce);
#pragma unroll
            for (int r = 0; r < 16; ++r) *(GAS unsigned*)(MIX + (size_t)(tb + TOKR(r)) * DM + ce) = cvtpk(pe[r] * sc[0], po[r] * sc[1]);
        }
        {
            const LAS bf16_t* Frow = Ft + tokl * FT_STRIDE;
            const int bh = bidx * 4 + hd; const size_t hbase = ((size_t)bh * SEQ + t0) * 64 + 2 * l31;
            const f32x2 kkw = *(const GAS f32x2*)(a.in(I_KK) + l * 256 + ce), kaw = *(const GAS f32x2*)(a.in(I_KA) + l * 256 + ce), rkw = *(const GAS f32x2*)(a.in(I_RK) + l * 256 + ce);
            const bf16_t* WUPT = (const bf16_t*)(sm + SM_WUPT) + (size_t)l * 2 * 256 * 32; const bf16_t* AUPT = (const bf16_t*)(sm + SM_AUPT) + (size_t)l * 2 * 256 * 32;
            const bf16_t* GUPT = (const bf16_t*)(sm + SM_GUPT) + (size_t)l * 256 * 64;
            const int ne = ce, no = ce + 1;
            unsigned kp[16];
            float invn[16];
#pragma unroll
            for (int r = 0; r < 16; ++r) { kp[r] = *(const LAS unsigned*)(Ft + TOKR(r) * FT_STRIDE + 256 + ce);
                const float ve = bflo(kp[r]) * kkw[0], vo = bfhi(kp[r]) * kkw[1]; float q = ve * ve + vo * vo;
                q = red16(q); q += __shfl_xor(q, 16); invn[r] = 1.f / fmaxf(sqrtf(q), 1e-12f); }
            asm volatile("" ::: "memory"); __builtin_amdgcn_sched_barrier(0);
            {
                f32x16 d0e = f32x16{}, d0o = f32x16{}, d1e = f32x16{}, d1o = f32x16{};
#pragma unroll
                for (int s = 0; s < 2; ++s) { const int ko = 16 * s + 8 * hi; const bf16x8 A0 = *(const LAS bf16x8*)(Frow + 768 + ko), A1 = *(const LAS bf16x8*)(Frow + 800 + ko);
                    d0e = __builtin_amdgcn_mfma_f32_32x32x16_bf16(A0, *(const GAS bf16x8*)(WUPT + (0 * 256 + ne) * 32 + ko), d0e, 0, 0, 0);
                    d0o = __builtin_amdgcn_mfma_f32_32x32x16_bf16(A0, *(const GAS bf16x8*)(WUPT + (0 * 256 + no) * 32 + ko), d0o, 0, 0, 0);
                    d1e = __builtin_amdgcn_mfma_f32_32x32x16_bf16(A1, *(const GAS bf16x8*)(WUPT + (1 * 256 + ne) * 32 + ko), d1e, 0, 0, 0);
                    d1o = __builtin_amdgcn_mfma_f32_32x32x16_bf16(A1, *(const GAS bf16x8*)(WUPT + (1 * 256 + no) * 32 + ko), d1o, 0, 0, 0); }
                const f32x2 w00 = *(const GAS f32x2*)(a.in(I_W0) + (l * 2 + 0) * 256 + ce), w01 = *(const GAS f32x2*)(a.in(I_W0) + (l * 2 + 1) * 256 + ce);
#pragma unroll
                for (int r = 0; r < 16; ++r) { const size_t o = hbase + (size_t)TOKR(r) * 64;
                    const f32x2 x0 = {__expf(-0.6065306597126334f * sigmoidf_(w00[0] + d0e[r])), __expf(-0.6065306597126334f * sigmoidf_(w00[1] + d0o[r]))};
                    const f32x2 x1 = {__expf(-0.6065306597126334f * sigmoidf_(w01[0] + d1e[r])), __expf(-0.6065306597126334f * sigmoidf_(w01[1] + d1o[r]))};
                    typedef _Float16 h2_t __attribute__((ext_vector_type(2)));
                    const unsigned p0 = __builtin_bit_cast(unsigned, (h2_t){(_Float16)x0[0], (_Float16)x0[1]}), p1 = __builtin_bit_cast(unsigned, (h2_t){(_Float16)x1[0], (_Float16)x1[1]});
                    if (dry != 3) { *(GAS unsigned*)((unsigned short*)(ws + WS_WH0) + o) = p0; *(GAS unsigned*)((unsigned short*)(ws + WS_WH1) + o) = p1; } else asm volatile("" :: "v"(p0), "v"(p1)); }
            }
            asm volatile("" ::: "memory"); __builtin_amdgcn_sched_barrier(0);
            {
                f32x16 a0e = f32x16{}, a0o = f32x16{}, a1e = f32x16{}, a1o = f32x16{};
#pragma unroll
                for (int s = 0; s < 2; ++s) { const int ko = 16 * s + 8 * hi; const bf16x8 A0 = *(const LAS bf16x8*)(Frow + 832 + ko), A1 = *(const LAS bf16x8*)(Frow + 864 + ko);
                    a0e = __builtin_amdgcn_mfma_f32_32x32x16_bf16(A0, *(const GAS bf16x8*)(AUPT + (0 * 256 + ne) * 32 + ko), a0e, 0, 0, 0);
                    a0o = __builtin_amdgcn_mfma_f32_32x32x16_bf16(A0, *(const GAS bf16x8*)(AUPT + (0 * 256 + no) * 32 + ko), a0o, 0, 0, 0);
                    a1e = __builtin_amdgcn_mfma_f32_32x32x16_bf16(A1, *(const GAS bf16x8*)(AUPT + (1 * 256 + ne) * 32 + ko), a1e, 0, 0, 0);
                    a1o = __builtin_amdgcn_mfma_f32_32x32x16_bf16(A1, *(const GAS bf16x8*)(AUPT + (1 * 256 + no) * 32 + ko), a1o, 0, 0, 0); }
                const f32x2 b00 = *(const GAS f32x2*)(a.in(I_A0) + (l * 2 + 0) * 256 + ce), b01 = *(const GAS f32x2*)(a.in(I_A0) + (l * 2 + 1) * 256 + ce);
                GAS float* bsp = (GAS float*)(ws + WS_BON) + (size_t)bh * SEQ + t0 + 32 * th + 4 * hi; float bsacc = 0.f;
#define ST2(base, lo_, hi_) do { const unsigned _o = cvtpk(lo_, hi_); if (dry != 3) *(GAS unsigned*)((bf16_t*)(ws + (base)) + o) = _o; else asm volatile("" :: "v"(_o)); } while (0)
#pragma unroll
                for (int r = 0; r < 16; ++r) { const size_t o = hbase + (size_t)TOKR(r) * 64;
                    const unsigned rp = *(const LAS unsigned*)(Ft + TOKR(r) * FT_STRIDE + ce);
                    const float ke = bflo(kp[r]), ko_ = bfhi(kp[r]), re = bflo(rp), ro = bfhi(rp);
                    const float s0e = sigmoidf_(b00[0] + a0e[r]), s0o = sigmoidf_(b00[1] + a0o[r]), s1e = sigmoidf_(b01[0] + a1e[r]), s1o = sigmoidf_(b01[1] + a1o[r]);
                    const float kke = ke * kkw[0] * invn[r], kko = ko_ * kkw[1] * invn[r];
                    const float h0e = ke * (1.f + (s0e - 1.f) * kaw[0]), h0o = ko_ * (1.f + (s0o - 1.f) * kaw[1]), h1e = ke * (1.f + (s1e - 1.f) * kaw[0]), h1o = ko_ * (1.f + (s1o - 1.f) * kaw[1]);
                    float bs = re * (h0e + h1e) * rkw[0] + ro * (h0o + h1o) * rkw[1];
                    bs = red16(bs); bs += __shfl_xor(bs, 16);
                    const unsigned vp = *(const LAS unsigned*)(Ft + TOKR(r) * FT_STRIDE + 512 + ce);
                    if (dry != 3) *(GAS unsigned*)((bf16_t*)(ws + WS_V) + o) = vp; else asm volatile("" :: "v"(vp));
                    bsacc = (l31 == r) ? bs : bsacc;
                    { const unsigned kkp = cvtpk(kke, kko);
                      const u32x4 c0 = {cvtpk(kke * s0e, kko * s0o), cvtpk(h0e, h0o), kkp, rp}, c1 = {cvtpk(kke * s1e, kko * s1o), cvtpk(h1e, h1o), kkp, rp};
                      if (dry != 3) { *(GAS u32x4*)((unsigned char*)(ws + WS_FC0) + 8 * o) = c0; *(GAS u32x4*)((unsigned char*)(ws + WS_FC1) + 8 * o) = c1; } else asm volatile("" :: "v"(c0), "v"(c1)); } }
                if (l31 < 16) bsp[(l31 & 3) + 8 * (l31 >> 2)] = bsacc;
            }
            asm volatile("" ::: "memory"); __builtin_amdgcn_sched_barrier(0);
            {
                f32x16 ge = f32x16{}, go = f32x16{};
#pragma unroll
                for (int s = 0; s < 4; ++s) { const int ko = 16 * s + 8 * hi; const bf16x8 A0 = *(const LAS bf16x8*)(Frow + 896 + ko);
                    ge = __builtin_amdgcn_mfma_f32_32x32x16_bf16(A0, *(const GAS bf16x8*)(GUPT + ne * 64 + ko), ge, 0, 0, 0);
                    go = __builtin_amdgcn_mfma_f32_32x32x16_bf16(A0, *(const GAS bf16x8*)(GUPT + no * 64 + ko), go, 0, 0, 0); }
#pragma unroll
                for (int r = 0; r < 16; ++r) { const size_t o = hbase + (size_t)TOKR(r) * 64;
                    ST2(WS_G, ge[r], go[r]); }
#undef ST2
            }
        }
#undef TOKR
        }
        __syncthreads();
    }
    asm volatile("s_waitcnt vmcnt(0)" ::: "memory");
    __syncthreads();
    if (dry != 2 && dry != 4) {
#pragma unroll 1
        for (int item = i0; item < ihi; item += istep) {
            const int tb = item * 64, t0 = tb & (SEQ - 1), bidx = tb / SEQ;
#pragma unroll 1
            for (int q4 = 0; q4 < 4; ++q4) { const int itx = wave * 4 + q4, hd2 = itx & 3, qb = (itx >> 2) & 3, dir = itx >> 4;
                const int c0 = (t0 >> 4) + qb;
                int lz = lane; asm volatile("" : "+v"(lz));
                scan_pre_item(a_in, (LAS bf16_t*)(lds + wave * 8192), bidx * 4 + hd2, dir, dir ? 127 - c0 : c0, lz, dry >= 5 ? dry - 5 : 0); }
        }
    }
    __syncthreads();
}

typedef _Float16 h16x8 __attribute__((ext_vector_type(8)));
typedef _Float16 h16x4 __attribute__((ext_vector_type(4)));
constexpr int SC_CHUNK = 16, SC_NCH = SEQ / SC_CHUNK, SC_STEPB = 768  , SC_BUFB = SC_CHUNK * SC_STEPB, SC_YOFF = 2 * SC_BUFB, SC_YB = SC_CHUNK * 512 * 4;
static_assert(SC_YOFF + 2 * SC_YB <= LDSCTL_OFF, "scan LDS");
__device__ __forceinline__ float fmix_lo(float a, unsigned pk, float c) { float d; asm("v_fma_mix_f32 %0, %1, %2, %3 op_sel:[0,0,0] op_sel_hi:[0,1,0]" : "=v"(d) : "v"(a), "v"(pk), "v"(c)); return d; }
__device__ __forceinline__ float fmix_hi(float a, unsigned pk, float c) { float d; asm("v_fma_mix_f32 %0, %1, %2, %3 op_sel:[0,1,0] op_sel_hi:[0,1,0]" : "=v"(d) : "v"(a), "v"(pk), "v"(c)); return d; }
__device__ __forceinline__ float fmixn_lo(float a, unsigned pk, float c) { float d; asm("v_fma_mix_f32 %0, -%1, %2, %3 op_sel:[0,0,0] op_sel_hi:[0,1,0]" : "=v"(d) : "v"(a), "v"(pk), "v"(c)); return d; }
__device__ __forceinline__ float fmixn_hi(float a, unsigned pk, float c) { float d; asm("v_fma_mix_f32 %0, -%1, %2, %3 op_sel:[0,1,0] op_sel_hi:[0,1,0]" : "=v"(d) : "v"(a), "v"(pk), "v"(c)); return d; }
__device__ __forceinline__ unsigned h2pack(float lo, float hi) { typedef _Float16 h2 __attribute__((ext_vector_type(2))); h2 v = {(_Float16)lo, (_Float16)hi}; return __builtin_bit_cast(unsigned, v); }
struct ScOp { u32x4 q0, q1; u32x2 q2; unsigned short v; };
template <int DIR, int VAR>
__device__ __forceinline__ void scan_item(const PArgs& a, LAS unsigned char* lds, int bh, int half, int dummy) {
    unsigned char* ws = a.ws();
    int tid_ = threadIdx.x; asm volatile("" : "+v"(tid_)); const int tid = tid_, lane = tid & 63, wave = __builtin_amdgcn_readfirstlane(tid >> 6), c4 = lane & 15;
    const int irow = 32 * half + 4 * wave + (lane >> 4);
    const size_t hb = (size_t)bh * SEQ * 64;
    const bf16_t* gKK = (const bf16_t*)(ws + WS_KK) + hb; const bf16_t* gB = (const bf16_t*)(ws + WS_B + (size_t)DIR * 16 * MiB) + hb;
    const bf16_t* gKH = (const bf16_t*)(ws + WS_KH + (size_t)DIR * 16 * MiB) + hb; const bf16_t* gR = (const bf16_t*)(ws + WS_R) + hb; const bf16_t* gV = (const bf16_t*)(ws + WS_V) + hb;
    const float* gW = (const float*)(ws + WS_W + (size_t)DIR * 32 * MiB) + hb;
    float* gY = (float*)(ws + (dummy ? 950 * MiB : WS_WKV) + (size_t)DIR * 32 * MiB) + hb;
    const int sst = tid >> 4, sq = tid & 15; const size_t so = (size_t)sst * 64 + sq * 4; const int sd = sst * SC_STEPB + sq * 16;
    const int vt = tid - 256; const size_t vo = (size_t)(vt >> 3) * 64 + (vt & 7) * 8; const int vd = (vt >> 3) * SC_STEPB + 640 + (vt & 7) * 16;
    u32x2 rkk = {}, rb = {}, rkh = {}, rr = {}; f32x4 rw = {}; u32x4 rv = {};
#define SC_T0(cidx) (DIR ? SEQ - SC_CHUNK * ((cidx) + 1) : SC_CHUNK * (cidx))
#define SC_LOAD(cidx) do { const size_t _o = (size_t)SC_T0(cidx) * 64; \
        if (tid < 256) { rkk = *(const GAS u32x2*)(gKK + _o + so); rb = *(const GAS u32x2*)(gB + _o + so); rkh = *(const GAS u32x2*)(gKH + _o + so); rr = *(const GAS u32x2*)(gR + _o + so); rw = *(const GAS f32x4*)(gW + _o + so); } \
        else if (tid < 384) rv = *(const GAS u32x4*)(gV + _o + vo); } while (0)
#define SC_H4(vv) (u32x2){h2pack(bflo((vv)[0]), bfhi((vv)[0])), h2pack(bflo((vv)[1]), bfhi((vv)[1]))}
#define SC_STORE(bufb) do { if (tid < 256) { const u32x2 _a = SC_H4(rkk), _b = SC_H4(rb), _c = SC_H4(rkh), _d = SC_H4(rr); \
            *(LAS u32x4*)(lds + (bufb) + sd) = (u32x4){_a.x, _a.y, _b.x, _b.y}; *(LAS u32x4*)(lds + (bufb) + sd + 256) = (u32x4){_c.x, _c.y, _d.x, _d.y}; \
            *(LAS u32x2*)(lds + (bufb) + sst * SC_STEPB + 512 + sq * 8) = (u32x2){h2pack(rw[0], rw[1]), h2pack(rw[2], rw[3])}; } \
        else if (tid < 384) { *(LAS u32x4*)(lds + (bufb) + vd) = (u32x4){h2pack(bflo(rv.x), bfhi(rv.x)), h2pack(bflo(rv.y), bfhi(rv.y)), h2pack(bflo(rv.z), bfhi(rv.z)), h2pack(bflo(rv.w), bfhi(rv.w))}; } } while (0)
#define SC_RD(op, p) do { (op).q0 = *(const LAS u32x4*)((p) + 16 * c4); (op).q1 = *(const LAS u32x4*)((p) + 256 + 16 * c4); (op).q2 = *(const LAS u32x2*)((p) + 512 + 8 * c4); \
        (op).v = *(const LAS unsigned short*)((p) + 640 + 2 * irow); } while (0)
    const int fl_step = tid >> 5, fl_row = tid & 31;
#define SC_FLUSH(ybufb, t0) do { const LAS float* _q = (const LAS float*)(lds + (ybufb)) + fl_step * 512 + fl_row * 16; f32x4 _s = {0.f, 0.f, 0.f, 0.f}; \
        _Pragma("unroll") for (int _k = 0; _k < 4; ++_k) { const int _c = (_k + (tid >> 2)) & 3; _s += *(const LAS f32x4*)(_q + 4 * _c); } \
        ((GAS float*)gY)[(size_t)((t0) + fl_step) * 64 + 32 * half + fl_row] = (_s[0] + _s[1]) + (_s[2] + _s[3]); } while (0)
    SC_LOAD(0); SC_STORE(0);
    __syncthreads();
    float S0 = 0.f, S1 = 0.f, S2 = 0.f, S3 = 0.f;
#pragma unroll 1
    for (int cidx = 0; cidx < SC_NCH; ++cidx) {
        const int cb = cidx & 1;
        if (cidx + 1 < SC_NCH && VAR != 4) SC_LOAD(cidx + 1);
        if (cidx > 0 && VAR != 4 && VAR != 3) SC_FLUSH(SC_YOFF + (cb ^ 1) * SC_YB, SC_T0(cidx - 1));
        const LAS unsigned char* buf = lds + cb * SC_BUFB;
        LAS float* yb = (LAS float*)(lds + SC_YOFF + cb * SC_YB) + tid;
        ScOp cur, nxt;
        SC_RD(nxt, buf + (DIR ? SC_CHUNK - 1 : 0) * SC_STEPB);
#pragma unroll
        for (int jj = 0; jj < SC_CHUNK; ++jj) {
            const int s = DIR ? SC_CHUNK - 1 - jj : jj;
            cur = nxt;
            if (jj + 1 < SC_CHUNK && VAR != 2) { SC_RD(nxt, buf + (DIR ? s - 1 : s + 1) * SC_STEPB); }
            __builtin_amdgcn_sched_barrier(0);
            const float dot = fmix_hi(S1, cur.q0.x, fmix_lo(S0, cur.q0.x, 0.f)) + fmix_hi(S3, cur.q0.y, fmix_lo(S2, cur.q0.y, 0.f));
            const float vi = (float)__builtin_bit_cast(_Float16, cur.v);
            const float u0 = fmix_lo(S0, cur.q2.x, fmix_lo(vi, cur.q1.x, 0.f)), u1 = fmix_hi(S1, cur.q2.x, fmix_hi(vi, cur.q1.x, 0.f));
            const float u2 = fmix_lo(S2, cur.q2.y, fmix_lo(vi, cur.q1.y, 0.f)), u3 = fmix_hi(S3, cur.q2.y, fmix_hi(vi, cur.q1.y, 0.f));
            const float sk = VAR == 1 ? dot : red16(dot);
            S0 = fmixn_lo(sk, cur.q0.z, u0); S1 = fmixn_hi(sk, cur.q0.z, u1); S2 = fmixn_lo(sk, cur.q0.w, u2); S3 = fmixn_hi(sk, cur.q0.w, u3);
            { const float yv = fmix_hi(S1, cur.q1.z, fmix_lo(S0, cur.q1.z, 0.f)) + fmix_hi(S3, cur.q1.w, fmix_lo(S2, cur.q1.w, 0.f)); if (VAR == 3) { if (jj == SC_CHUNK - 1) yb[s * 512] = yv; else asm volatile("" :: "v"(yv)); } else yb[s * 512] = yv; }
        }
        if (cidx + 1 < SC_NCH && VAR != 4) SC_STORE((cb ^ 1) * SC_BUFB);
        if (VAR != 5) __syncthreads();
    }
    SC_FLUSH(SC_YOFF + ((SC_NCH & 1) ^ 1) * SC_YB, SC_T0(SC_NCH - 1));
    __syncthreads();
#undef SC_T0
#undef SC_LOAD
#undef SC_H4
#undef SC_STORE
#undef SC_RD
#undef SC_FLUSH
}
#ifndef PROBE_SCANVAR
#define PROBE_SCANVAR 0
#endif
__device__ __forceinline__ void phase_scan(const PArgs& a, LAS unsigned char* lds, int dummy) {
    for (int item = blockIdx.x; item < 256; item += gridDim.x) {
        const int half = item & 1, dir = (item >> 1) & 1, bh = item >> 2;
        if (dummy) { if (dir) scan_item<1, PROBE_SCANVAR>(a, lds, bh, half, 1); else scan_item<0, PROBE_SCANVAR>(a, lds, bh, half, 1); }
        else { if (dir) scan_item<1, 0>(a, lds, bh, half, 0); else scan_item<0, 0>(a, lds, bh, half, 0); }
    }
}

constexpr int RING_D = 4, RING_FLAGS = 2 * RING_D * 13568;
__device__ __forceinline__ void scan_serial_wave(const PArgs& a, int bh, int dir, int it, int lane, LAS unsigned char* ring, volatile LAS int* flg) {
    unsigned char* ws = a.ws();
    const int l31 = lane & 31, hi = lane >> 5;
    GAS float* gY = (GAS float*)(ws + WS_WKV + (size_t)dir * 32 * MiB) + (size_t)bh * SEQ * 64 + 32 * it + l31;
    f32x16 ST0 = f32x16{}, ST1 = f32x16{};
#define SS_ISSUE(P, cc) do { { unsigned _sp = 0; while (flg[0] <= (cc) && ++_sp < 2000000u) __builtin_amdgcn_s_sleep(1); } asm volatile("" ::: "memory"); \
        const LAS unsigned char* _r = ring + ((cc) & (RING_D - 1)) * 13568 + lane * 16; \
        _Pragma("unroll") for (int _k = 0; _k < 5; ++_k) P##aop[_k] = *(const LAS bf16x8*)(_r + REC_AOP + _k * 1024); \
        P##vt = *(const LAS bf16x8*)(_r + REC_VT + it * 1024); \
        _Pragma("unroll") for (int _k = 0; _k < 2; ++_k) P##ay[_k] = *(const LAS bf16x8*)(_r + REC_AY + _k * 1024); \
        _Pragma("unroll") for (int _k = 0; _k < 4; ++_k) P##as[_k] = *(const LAS bf16x8*)(_r + REC_AS + _k * 1024); \
        __builtin_amdgcn_sched_barrier(0); } while (0)
#define SS_RELEASE(cc) do { asm volatile("s_waitcnt lgkmcnt(0)" ::: "memory"); __builtin_amdgcn_sched_barrier(0); \
        if (lane == 0) __hip_atomic_fetch_add((LAS int*)&flg[4 + ((cc) & (RING_D - 1))], 1, __ATOMIC_RELAXED, __HIP_MEMORY_SCOPE_WORKGROUP); } while (0)
#define SS_BODY(P, cc) do { \
        f32x4 gc_[8]; { const LAS unsigned char* _g = ring + ((cc) & (RING_D - 1)) * 13568 + REC_GC + hi * 64; \
          _Pragma("unroll") for (int _k = 0; _k < 8; ++_k) gc_[_k] = *(const LAS f32x4*)(_g + ((_k >> 2) * 32 + (_k & 3) * 4) * 4); } \
        f32x16 UQ = f32x16{}; \
        { float f[8]; \
          _Pragma("unroll") for (int s_ = 0; s_ < 2; ++s_) { _Pragma("unroll") for (int jj = 0; jj < 8; ++jj) f[jj] = ST0[8 * s_ + jj]; \
            UQ = __builtin_amdgcn_mfma_f32_32x32x16_bf16(P##aop[s_], pack_frag(f), UQ, 0, 0, 0); } \
          _Pragma("unroll") for (int s_ = 0; s_ < 2; ++s_) { _Pragma("unroll") for (int jj = 0; jj < 8; ++jj) f[jj] = ST1[8 * s_ + jj]; \
            UQ = __builtin_amdgcn_mfma_f32_32x32x16_bf16(P##aop[2 + s_], pack_frag(f), UQ, 0, 0, 0); } } \
        UQ = __builtin_amdgcn_mfma_f32_32x32x16_bf16(P##aop[4], P##vt, UQ, 0, 0, 0); \
        bf16x8 Uf; { float f[8]; _Pragma("unroll") for (int jj = 0; jj < 8; ++jj) f[jj] = UQ[jj]; Uf = pack_frag(f); } \
        f32x16 Y = f32x16{}; \
        _Pragma("unroll") for (int r = 0; r < 8; ++r) Y[r] = UQ[8 + r]; \
        Y = __builtin_amdgcn_mfma_f32_32x32x16_bf16(P##ay[0], Uf, Y, 0, 0, 0); \
        Y = __builtin_amdgcn_mfma_f32_32x32x16_bf16(P##ay[1], P##vt, Y, 0, 0, 0); \
        _Pragma("unroll") for (int q = 0; q < 4; ++q) _Pragma("unroll") for (int e = 0; e < 4; ++e) { ST0[4 * q + e] *= gc_[q][e]; ST1[4 * q + e] *= gc_[4 + q][e]; } \
        ST0 = __builtin_amdgcn_mfma_f32_32x32x16_bf16(P##as[0], Uf, ST0, 0, 0, 0); ST0 = __builtin_amdgcn_mfma_f32_32x32x16_bf16(P##as[1], P##vt, ST0, 0, 0, 0); \
        ST1 = __builtin_amdgcn_mfma_f32_32x32x16_bf16(P##as[2], Uf, ST1, 0, 0, 0); ST1 = __builtin_amdgcn_mfma_f32_32x32x16_bf16(P##as[3], P##vt, ST1, 0, 0, 0); \
        _Pragma("unroll") for (int r = 0; r < 8; ++r) { const int t = 16 * (cc) + (r & 3) + 8 * (r >> 2) + 4 * hi; const int tt = dir ? SEQ - 1 - t : t; gY[(size_t)tt * 64] = Y[r]; } } while (0)
    bf16x8 A_aop[5], A_vt, A_ay[2], A_as[4];
    bf16x8 B_aop[5], B_vt, B_ay[2], B_as[4];
    SS_ISSUE(A_, 0);
#pragma unroll 1
    for (int c = 0; c < 128; c += 2) {
        SS_ISSUE(B_, c + 1);
        SS_BODY(A_, c);
        SS_RELEASE(c);
        if (c + 2 < 128) SS_ISSUE(A_, c + 2);
        SS_BODY(B_, c + 1);
        SS_RELEASE(c + 1);
    }
#undef SS_ISSUE
#undef SS_RELEASE
#undef SS_BODY

}

__device__ __forceinline__ void glds4(const void* gsrc, unsigned lds_dst) { unsigned keep;
    asm volatile("s_mov_b32 %0, m0\n\ts_mov_b32 m0, %2\n\ts_nop 0\n\tglobal_load_lds_dword %1, off\n\ts_mov_b32 m0, %0" : "=&s"(keep) : "v"(gsrc), "s"(lds_dst) : "memory"); }
__device__ __forceinline__ void scan_loader_wave(const PArgs& a, int bh, int dir, int lane, LAS unsigned char* ring, volatile LAS int* flg) {
    unsigned char* ws = a.ws();
    const unsigned char* rec0 = ws + WS_REC + (size_t)((bh * 2 + dir) * 128) * REC_BYTES;
    const unsigned ring0 = (unsigned)(uintptr_t)ring;
#pragma unroll 1
    for (int c = 0; c < 128; ++c) {
        const int slot = c & (RING_D - 1);
        if (c >= RING_D) { unsigned sp = 0; while (flg[4 + slot] < 2 * (c / RING_D) && ++sp < 2000000u) __builtin_amdgcn_s_sleep(1); }
        asm volatile("" ::: "memory");
        const unsigned char* r = rec0 + (size_t)c * REC_BYTES; const unsigned dst = (unsigned)__builtin_amdgcn_readfirstlane(ring0 + slot * 13568);
#pragma unroll
        for (int k = 0; k < 13; ++k) { const int off = k < 5 ? REC_AOP + k * 1024 : k < 7 ? REC_AY + (k - 5) * 1024 : k < 11 ? REC_AS + (k - 7) * 1024 : REC_VT + (k - 11) * 1024;
            attn_body::glds16(r + off + lane * 16, dst + off); }
        glds4(r + REC_GC + lane * 4, dst + REC_GC);
        asm volatile("s_waitcnt vmcnt(14)" ::: "memory");
        if (lane == 0) flg[0] = c;
    }
    asm volatile("s_waitcnt vmcnt(0)" ::: "memory");
    if (lane == 0) flg[0] = 128;
}

constexpr int AQ_LDS = 100000;
__device__ __forceinline__ void rwkv_post(const PArgs& a, int l, int hv0, int nhv, int wave, int lane) {
    unsigned char* ws = a.ws();
    const int sub = lane >> 4, c4 = lane & 15;
    bf16_t* MIX = (bf16_t*)(ws + WS_MIX);
    for (int it = wave; it < nhv / 4; it += NWAVES) {
        const size_t hv = (size_t)hv0 + (size_t)it * 4 + sub; const size_t o = hv * 64 + 4 * c4;
        const f32x4 f = *(const GAS f32x4*)((const float*)(ws + WS_WKV) + o), bk = *(const GAS f32x4*)((const float*)(ws + WS_WKV + 32 * MiB) + o);
        float g4[4], bo[4]; unpack4(*(const GAS u32x2*)((const bf16_t*)(ws + WS_G) + o), g4); unpack4(*(const GAS u32x2*)((const bf16_t*)(ws + WS_V) + o), bo);
        { const float bs = ((const GAS float*)(ws + WS_BON))[hv];
#pragma unroll
          for (int e = 0; e < 4; ++e) bo[e] *= bs; }
        const f32x4 x = f + bk;
        const float mean = red16((x[0] + x[1]) + (x[2] + x[3])) * (1.f / 64.f);
        const f32x4 d = x - mean;
        const float var = red16((d[0] * d[0] + d[1] * d[1]) + (d[2] * d[2] + d[3] * d[3])) * (1.f / 64.f);
        const float rs = rsqrtf(var + GN_EPS);
        const int bh = (int)(hv / SEQ), t = (int)(hv % SEQ), bb = bh >> 2, hh = bh & 3, c = 64 * hh + 4 * c4;
        const f32x4 gg = *(const GAS f32x4*)(a.in(I_GNG) + l * 256 + c), gb = *(const GAS f32x4*)(a.in(I_GNB) + l * 256 + c);
        float y[4];
#pragma unroll
        for (int e = 0; e < 4; ++e) y[e] = (d[e] * rs * gg[e] + gb[e] + bo[e]) * g4[e];
        u32x2 ov; ov.x = cvtpk(y[0], y[1]); ov.y = cvtpk(y[2], y[3]);
        *(GAS u32x2*)(MIX + ((size_t)bb * SEQ + t) * DM + 256 + c) = ov;
    }
}
__device__ __forceinline__ void phase_attn_post(const PArgs& a, unsigned char* lds_generic, int l, int bx) {
    unsigned char* ws = a.ws();
    int tid_ = threadIdx.x; asm volatile("" : "+v"(tid_)); const int tid = tid_, lane = tid & 63, wave = __builtin_amdgcn_readfirstlane(tid >> 6);
    if (bx < 64) {
        LAS unsigned char* L = (LAS unsigned char*)lds_generic; volatile LAS int* flags = (volatile LAS int*)(L + RING_FLAGS);
        if (tid < 16) flags[tid] = 0;
        __syncthreads();
        if (wave < 4) scan_serial_wave(a, bx, wave >> 1, wave & 1, lane, L + (wave >> 1) * RING_D * 13568, flags + (wave >> 1) * 8);
        else if (wave < 6) scan_loader_wave(a, bx, wave - 4, lane, L + (wave - 4) * RING_D * 13568, flags + (wave - 4) * 8);
        asm volatile("s_waitcnt vmcnt(0)" ::: "memory");
        __syncthreads();
        rwkv_post(a, l, bx * SEQ, SEQ, wave, lane);
    }
    const attn_body::bf16* PROJ = (const attn_body::bf16*)(ws + WS_PROJ); attn_body::bf16* MIXO = (attn_body::bf16*)(ws + WS_MIX) + 512;
    unsigned* qhead = (unsigned*)(ws + WS_CTL) + CW_AQ + l * 64;
    volatile LAS unsigned* slot = (volatile LAS unsigned*)((LAS unsigned char*)lds_generic + AQ_LDS);
    for (;;) {
        if (tid == 0) *slot = __hip_atomic_fetch_add(qhead, 1u, __ATOMIC_RELAXED, __HIP_MEMORY_SCOPE_AGENT);
        __syncthreads();
        const int uidx = (int)__builtin_amdgcn_readfirstlane(*slot);
        __syncthreads();
        if (uidx >= 1024) break;
        const int grp = uidx >> 5, u = uidx & 31, b = grp >> 1, kvh = grp & 1, h = kvh * 4 + (u >> 3), qb = u & 7;
        attn_body::attn_unit<8>(b, h, kvh, qb, PROJ + C_Q, PROJ + C_K, PROJ + C_V, MIXO, (char*)lds_generic);
    }
}

constexpr int RT_ZROW = 2064;
constexpr int RT_ZH = 0, RT_ZL = 16 * RT_ZROW, RT_PL = 2 * 16 * RT_ZROW, RT_LOGS = RT_PL + 8 * 16 * 48 * 4, RT_INFO = RT_LOGS + 16 * 48 * 4;
static_assert(RT_INFO + 4096 <= LDSCTL_OFF, "router LDS");
__device__ __forceinline__ void phase_ln1_router(const PArgs& a, LAS unsigned char* lds, int l, int dry, int grank, const unsigned* pcnt) {
    unsigned char* ws = a.ws();
    int tid_ = threadIdx.x; asm volatile("" : "+v"(tid_)); const int tid = tid_, lane = tid & 63, wave = __builtin_amdgcn_readfirstlane(tid >> 6);
    const float* Z = (const float*)(ws + WS_Z); bf16_t* XN = (bf16_t*)(ws + WS_XN);
    LAS unsigned char* ZH = lds + RT_ZH; LAS unsigned char* ZL = lds + RT_ZL; LAS float* PL = (LAS float*)(lds + RT_PL); LAS float* LOG = (LAS float*)(lds + RT_LOGS);
    LAS int* inf_e = (LAS int*)(lds + RT_INFO); LAS int* inf_r = inf_e + 256; LAS float* inf_g = (LAS float*)(inf_r + 256); LAS int* lcnt = (LAS int*)(inf_g + 256); LAS int* lbase = lcnt + 32;
    if (tid < 32) lcnt[tid] = 0;
    __syncthreads();
    const bf16_t* RWH = (const bf16_t*)(ws + WS_RWB) + (size_t)l * 2 * 48 * 1024; const bf16_t* RWL = RWH + 48 * 1024;
    const float* lng = a.in(I_LN1G) + l * DM; const float* lnb = a.in(I_LN1B) + l * DM;
    const int tk = lane & 15, kg = lane >> 4;
    for (int chunk = grank; chunk < NTOK / 128; chunk += gridDim.x) {
        const int tb = chunk * 128;
        bf16x8 Bh[3][4];
#pragma unroll
        for (int nb = 0; nb < 3; ++nb)
#pragma unroll
            for (int s_ = 0; s_ < 4; ++s_) { const size_t wo = (size_t)(16 * nb + tk) * 1024 + 128 * wave + 32 * s_ + 8 * kg; Bh[nb][s_] = *(const GAS bf16x8*)(RWH + wo); }
        if (pcnt) wait_count(pcnt + 16 * (chunk >> 1), 32u, (unsigned*)(ws + WS_CTL) + 8);
        f32x4 xc[2][4], xn[2][4];
#define RT_LOAD(X_, sb_) do { _Pragma("unroll") for (int u = 0; u < 2; ++u) _Pragma("unroll") for (int j = 0; j < 4; ++j) \
            X_[u][j] = *(const GAS f32x4*)(Z + (size_t)(tb + (sb_) * 16 + 2 * wave + u) * DM + 4 * lane + 256 * j); } while (0)
        RT_LOAD(xc, 0);
#pragma unroll 1
        for (int sb = 0; sb < 8; ++sb) {
            if (sb + 1 < 8) RT_LOAD(xn, sb + 1);
            f32x4 lg[4], lb[4];
#pragma unroll
            for (int j = 0; j < 4; ++j) { lg[j] = *(const GAS f32x4*)(lng + 4 * lane + 256 * j); lb[j] = *(const GAS f32x4*)(lnb + 4 * lane + 256 * j); }
            asm volatile("" ::: "memory");
#pragma unroll
            for (int u = 0; u < 2; ++u) { const int tl = 2 * wave + u; float s = 0.f;
#pragma unroll
                for (int j = 0; j < 4; ++j) s += (xc[u][j][0] + xc[u][j][1]) + (xc[u][j][2] + xc[u][j][3]);
                const float mean = wave_sum(s) * (1.f / DM); float s2 = 0.f;
#pragma unroll
                for (int j = 0; j < 4; ++j) { xc[u][j] = xc[u][j] - mean; s2 += (xc[u][j][0] * xc[u][j][0] + xc[u][j][1] * xc[u][j][1]) + (xc[u][j][2] * xc[u][j][2] + xc[u][j][3] * xc[u][j][3]); }
                const float rstd = rsqrtf(wave_sum(s2) * (1.f / DM) + LN_EPS);
                bf16_t* xr = XN + (size_t)(tb + sb * 16 + tl) * DM;
#pragma unroll
                for (int j = 0; j < 4; ++j) { const f32x4 nz = xc[u][j] * rstd; const f32x4 v = nz * lg[j] + lb[j];
                    u32x2 o; o.x = cvtpk(v[0], v[1]); o.y = cvtpk(v[2], v[3]); if (!dry) *(GAS u32x2*)(xr + 4 * lane + 256 * j) = o;
                    u32x2 h; h.x = cvtpk(nz[0], nz[1]); h.y = cvtpk(nz[2], nz[3]);
                    u32x2 lo_; lo_.x = cvtpk(nz[0] - bflo(h.x), nz[1] - bfhi(h.x)); lo_.y = cvtpk(nz[2] - bflo(h.y), nz[3] - bfhi(h.y));
                    *(LAS u32x2*)(ZH + tl * RT_ZROW + (4 * lane + 256 * j) * 2) = h; *(LAS u32x2*)(ZL + tl * RT_ZROW + (4 * lane + 256 * j) * 2) = lo_; } }
            __syncthreads();
            { f32x4 acc[3] = {f32x4{0.f, 0.f, 0.f, 0.f}, f32x4{0.f, 0.f, 0.f, 0.f}, f32x4{0.f, 0.f, 0.f, 0.f}};
#pragma unroll
              for (int s_ = 0; s_ < 4; ++s_) { const int co = tk * RT_ZROW + (128 * wave + 32 * s_ + 8 * kg) * 2;
                  const bf16x8 Ah = *(const LAS bf16x8*)(ZH + co), Al = *(const LAS bf16x8*)(ZL + co);
#pragma unroll
                  for (int nb = 0; nb < 3; ++nb) { const bf16x8 Bl_ = *(const GAS bf16x8*)(RWL + (size_t)(16 * nb + tk) * 1024 + 128 * wave + 32 * s_ + 8 * kg);
                      acc[nb] = __builtin_amdgcn_mfma_f32_16x16x32_bf16(Ah, Bh[nb][s_], acc[nb], 0, 0, 0);
                      acc[nb] = __builtin_amdgcn_mfma_f32_16x16x32_bf16(Ah, Bl_, acc[nb], 0, 0, 0);
                      acc[nb] = __builtin_amdgcn_mfma_f32_16x16x32_bf16(Al, Bh[nb][s_], acc[nb], 0, 0, 0); } }
#pragma unroll
              for (int nb = 0; nb < 3; ++nb)
#pragma unroll
                  for (int r = 0; r < 4; ++r) PL[wave * 768 + (4 * kg + r) * 48 + 16 * nb + tk] = acc[nb][r]; }
            __syncthreads();
            for (int i = tid; i < 768; i += NTHR) { float v = 0.f;
#pragma unroll
                for (int w = 0; w < 8; ++w) v += PL[w * 768 + i];
                LOG[i] = v; }
            __syncthreads();
            if (tid < 16) {
            const LAS float* lt = LOG + lane * 48;
            float gl[4];
#pragma unroll
            for (int g = 0; g < 4; ++g) gl[g] = lt[32 + g] + ((const GAS float*)a.in(I_RGB))[l * 4 + g] + ((const GAS float*)(ws + WS_RB))[l * 48 + 32 + g];
            int grp = 0; float gm = gl[0];
#pragma unroll
            for (int g = 1; g < 4; ++g) if (gl[g] > gm) { gm = gl[g]; grp = g; }
            float den = 0.f;
#pragma unroll
            for (int g = 0; g < 4; ++g) den += __expf(gl[g] - gm);
            const float gwt = 1.f / den;
            float el[8];
#pragma unroll
            for (int j = 0; j < 8; ++j) el[j] = lt[grp * 8 + j] + ((const GAS float*)a.in(I_REB))[l * 32 + grp * 8 + j] + ((const GAS float*)(ws + WS_RB))[l * 48 + grp * 8 + j];
            int i1 = 0; float v1 = el[0];
#pragma unroll
            for (int j = 1; j < 8; ++j) if (el[j] > v1) { v1 = el[j]; i1 = j; }
            int i2 = -1; float v2 = -INFINITY;
#pragma unroll
            for (int j = 0; j < 8; ++j) if (j != i1 && el[j] > v2) { v2 = el[j]; i2 = j; }
            const float e2 = __expf(v2 - v1), g1 = gwt / (1.f + e2), g2 = gwt * e2 / (1.f + e2);
            const int p = (sb * 16 + lane) * 2, ea = grp * 8 + i1, eb = grp * 8 + i2;
            inf_e[p] = ea; inf_g[p] = g1; inf_r[p] = atomicAdd((int*)&lcnt[ea], 1);
            inf_e[p + 1] = eb; inf_g[p + 1] = g2; inf_r[p + 1] = atomicAdd((int*)&lcnt[eb], 1);
        }
#pragma unroll
            for (int u = 0; u < 2; ++u)
#pragma unroll
                for (int j = 0; j < 4; ++j) xc[u][j] = xn[u][j];
        }
#undef RT_LOAD
        __syncthreads();
        unsigned char* ws2 = a.ws_; asm volatile("" : "+s"(ws2)); ws2 = (unsigned char*)(GAS unsigned char*)ws2;
        unsigned* gcnt = (unsigned*)(ws2 + WS_CTL) + CW_CNT + l * 64;
        GAS int* list = (GAS int*)(ws2 + WS_LIST); GAS float* gate = (GAS float*)(ws2 + WS_GLIST);
        if (tid < 32) { const int n = lcnt[tid]; lbase[tid] = (n && !dry) ? (int)atomicAdd(gcnt + tid, (unsigned)n) : 0; lcnt[tid] = 0; }
        __syncthreads();
        if (tid < 256 && !dry) { const int e = inf_e[tid], pos = lbase[e] + inf_r[tid], pair = tb * 2 + tid;
            list[e * LISTCAP + pos] = pair; gate[e * LISTCAP + pos] = inf_g[tid]; }
        __syncthreads();
    }
}

__device__ __forceinline__ int moe_build_tab(const PArgs& a, LAS unsigned char* lds, int l) {
    LAS int* tab = (LAS int*)(lds + MOE_TAB_OFF);
    const unsigned* gcnt = (const unsigned*)(a.ws() + WS_CTL) + CW_CNT + l * 64;
    int tid_ = threadIdx.x; asm volatile("" : "+v"(tid_)); const int tid = tid_;
    if (tid < 64) {
        const int cnt = tid < 32 ? (int)__hip_atomic_load(gcnt + (tid & 31), __ATOMIC_RELAXED, __HIP_MEMORY_SCOPE_AGENT) : 0;
        const int nt = (cnt + 255) >> 8; int inc = nt;
#pragma unroll
        for (int d = 1; d < 32; d <<= 1) { const int o = __shfl_up(inc, d); if (tid >= d) inc += o; }
        const int ts = inc - nt;
        if (tid < 32) { tab[64 + tid] = cnt; tab[tid] = ts; for (int k = 0; k < nt; ++k) tab[128 + ts + k] = tid; if (tid == 31) tab[32] = inc; } }
    __syncthreads();
    return tab[32];
}

__device__ __forceinline__ void phase_ln2(const PArgs& a, int l, int grank, int G, int dry, unsigned* pcnt) {
    unsigned char* ws = a.ws();
    int tid_ = threadIdx.x; asm volatile("" : "+v"(tid_)); const int tid = tid_, lane = tid & 63, wave = __builtin_amdgcn_readfirstlane(tid >> 6);
    float* X = a.out(); bf16_t* XN = (bf16_t*)(ws + WS_XN); const bf16_t* Y = (const bf16_t*)(ws + WS_Y);
    const bool last = (l + 1 == DEPTH);
    f32x4 lg[4], lb[4];
#pragma unroll
    for (int j = 0; j < 4; ++j) { lg[j] = *(const GAS f32x4*)(a.in(I_LN2G) + l * DM + 4 * lane + 256 * j); lb[j] = *(const GAS f32x4*)(a.in(I_LN2B) + l * DM + 4 * lane + 256 * j); }
    for (int chunk = grank; chunk < NTOK / 128; chunk += G) {
    for (int ti = 0; ti < 16; ti += 2) {
        f32x4 x[2][4]; float s[2] = {0.f, 0.f};
#pragma unroll
        for (int u = 0; u < 2; ++u) { const int tok = chunk * 128 + wave + 8 * (ti + u);
            const bf16_t* xr = XN + (size_t)tok * DM; const bf16_t* y0 = Y + (size_t)(2 * tok) * DM; const bf16_t* y1 = y0 + DM;
#pragma unroll
            for (int j = 0; j < 4; ++j) { float xv[4], ya[4], yb[4]; unpack4(*(const GAS u32x2*)(xr + 4 * lane + 256 * j), xv);
                unpack4(*(const GAS u32x2*)(y0 + 4 * lane + 256 * j), ya); unpack4(*(const GAS u32x2*)(y1 + 4 * lane + 256 * j), yb);
#pragma unroll
                for (int e = 0; e < 4; ++e) x[u][j][e] = ALPHA * xv[e] + (ya[e] + yb[e]);
                s[u] += (x[u][j][0] + x[u][j][1]) + (x[u][j][2] + x[u][j][3]); } }
#pragma unroll
        for (int u = 0; u < 2; ++u) { const int tok = chunk * 128 + wave + 8 * (ti + u);
            float* row = X + (size_t)tok * DM; bf16_t* xr = XN + (size_t)tok * DM;
            const float mean = wave_sum(s[u]) * (1.f / DM); float s2 = 0.f;
#pragma unroll
            for (int j = 0; j < 4; ++j) { x[u][j] = x[u][j] - mean; s2 += (x[u][j][0] * x[u][j][0] + x[u][j][1] * x[u][j][1]) + (x[u][j][2] * x[u][j][2] + x[u][j][3] * x[u][j][3]); }
            const float rstd = rsqrtf(wave_sum(s2) * (1.f / DM) + LN_EPS);
#pragma unroll
            for (int j = 0; j < 4; ++j) { x[u][j] = x[u][j] * rstd * lg[j] + lb[j]; if (!dry) { if (last) *(GAS f32x4*)(row + 4 * lane + 256 * j) = x[u][j];
                else { u32x2 o; o.x = cvtpk(x[u][j][0], x[u][j][1]); o.y = cvtpk(x[u][j][2], x[u][j][3]); *(GAS u32x2*)(xr + 4 * lane + 256 * j) = o; } } } }
    }
        if (pcnt) { asm volatile("s_waitcnt vmcnt(0)" ::: "memory");
            if (lane == 0) __hip_atomic_fetch_add(pcnt + 16 * (chunk >> 1), 1u, __ATOMIC_RELAXED, __HIP_MEMORY_SCOPE_AGENT); }
    }
}

constexpr int NPH_L = 8, NPHASE = 1 + DEPTH * NPH_L;
__global__ void __launch_bounds__(NTHR, 2) hyb_fwd(Args args) {
    extern __shared__ __attribute__((aligned(16))) unsigned char lds_raw[];
    LAS unsigned char* lds = (LAS unsigned char*)lds_raw;
    const int tid = threadIdx.x;
    const int G = gridDim.x; const int bx = blockIdx.x; const int vcu = (G % 8 == 0) ? (bx % 8) * (G / 8) + bx / 8 : bx;
    unsigned char* ws = (unsigned char*)(GAS unsigned char*)args.ws;
    volatile LAS unsigned* st = (volatile LAS unsigned*)(lds + LDSCTL_OFF);
    if (tid < 64) st[tid] = 0u;
    __syncthreads();
    XcdBarrier bar; bar.bar = (unsigned*)(ws + WS_CTL) + CW_BAR; bar.x = 0; bar.st = st;
    if (!args.multi) bar = xcd_barrier_post((unsigned*)(ws + WS_CTL) + CW_BAR, st);
    int ph0 = args.ph_lo;
    if (ph0 == 0) {
        PArgs pa; pa.kp = (kptr_t)__builtin_amdgcn_kernarg_segment_ptr(); pa.ws_ = args.ws; pa.out_ = args.out;
        if (PHMASK & 1) phase_prologue(pa, lds, vcu, G);
        if (PROBE_DUP & 512) { cg::this_grid().sync(); phase_prologue(pa, lds, vcu, G); }
        ph0 = 1;
        if (ph0 < args.ph_hi) cg::this_grid().sync();
    }
    if (tid == 0) {
        if (args.multi) { st[2] = (unsigned)bx; st[3] = 0u; st[4] = (unsigned)G; }
        else { unsigned P = 0, n = 1;
            unsigned std_ = 1u;
            for (unsigned j = 0; j < 16; ++j) { const unsigned cj = xb_ld(bar.bar + XB_XCNT(j)); P += (j < bar.x) ? cj : 0u; n = (j == bar.x) ? cj : n; std_ &= (cj == (j < 8u ? 32u : 0u)) ? 1u : 0u; }
            st[3] = P; st[4] = n;
            st[5] = (G == 256) ? std_ : 0u; } }
    __syncthreads();
    for (int ph = ph0; ph < args.ph_hi; ++ph) {
        const int kq = (ph - 1) % NPH_L; const bool xl = !args.multi && st[5] != 0u;
        if (ph > ph0 && !(kq == 6 && !args.multi && !PROBE_KEEPBAR) && !(xl && (HANDOFF_SEAMS >> kq & 1))) {
            if (MK_ALLCG) cg::this_grid().sync(); else xcd_barrier(bar);
        }
#if PROBE_X == 5
        _Pragma("unroll 1") for (int q_ = 0; q_ < 4; ++q_) xcd_barrier(bar);
#endif
        PArgs pa; pa.kp = (kptr_t)__builtin_amdgcn_kernarg_segment_ptr(); asm volatile("" : "+s"(pa.kp)); pa.ws_ = args.ws; pa.out_ = args.out; asm volatile("" : "+s"(pa.ws_), "+s"(pa.out_));
        const int l = (ph - 1) / NPH_L, k = (ph - 1) % NPH_L;
        unsigned char* pws = pa.ws();
        const int nrep = ((PROBE_DUP >> k) & 1) ? 2 : 1;
        for (int rep = 0; rep < nrep; ++rep) {
        if (rep) xcd_barrier(bar);
        if (k == 0 && (PHMASK & 2)) {
            __syncthreads();
            pg8::XDenseOrder S; S.init_xcd(NTOK / 256, INP / 256, G, st); S.Bt = (const char*)(pws + WS_WIN + (size_t)l * 4 * MiB); S.Kb = DM * 2;
            if (l > 0 && !args.multi) { S.pcnt = (const unsigned*)(pws + WS_CTL) + CW_PAN + ((l - 1) * 4 + 1) * 2048; S.need = 16u; S.tmo = (unsigned*)(pws + WS_CTL) + 8; }
            pg8::EpiProj E{(bf16_t*)(pws + WS_PROJ), INP, (unsigned*)(pws + WS_CTL) + CW_PAN + (l * 4 + 2) * 2048};
            pg8::gemm_phase(lds, (const char*)(pws + WS_XN), DM, S, E);
        } else if (k == 1 && (PHMASK & 4)) {
#if PROBE_X == 6
            phase_prep(pa, lds, l, 4, PT_I0, PT_IHI, PT_STEP, nullptr); xcd_barrier(bar);
#endif
#if PROBE_P2
            phase_prep(pa, lds, l, PROBE_P2, PT_I0, PT_IHI, PT_STEP, nullptr); xcd_barrier(bar);
#endif
#if PROBE_X >= 8
            phase_prep(pa, lds, l, PROBE_X - 2, PT_I0, PT_IHI, PT_STEP, nullptr); xcd_barrier(bar);
#endif
            phase_prep(pa, lds, l, 0, PT_I0, PT_IHI, PT_STEP, args.multi ? nullptr : (const unsigned*)(pws + WS_CTL) + CW_PAN + (l * 4 + 2) * 2048);
#if PROBE_X == 7
            xcd_barrier(bar); phase_prep(pa, lds, l, 5, PT_I0, PT_IHI, PT_STEP, nullptr);
#endif
        } else if (k == 2 && (PHMASK & 16)) { phase_attn_post(pa, lds_raw, l, bx);
#if PROBE_X == 2
            xcd_barrier(bar); phase_attn_post(pa, lds_raw, l, bx);
#endif
        } else if (k == 3 && (PHMASK & 32)) {
            pg8::XDenseOrder S; S.init_xcd(NTOK / 256, DM / 256, G, st); S.Bt = (const char*)(pws + WS_WO + (size_t)l * 2 * MiB); S.Kb = DM * 2;
            pg8::EpiRes E{(const bf16_t*)(pws + WS_XN), (float*)(pws + WS_Z), nrep == 2 && rep == 0, (unsigned*)(pws + WS_CTL) + CW_PAN + (l * 4 + 0) * 2048};
            pg8::gemm_phase(lds, (const char*)(pws + WS_MIX), DM, S, E);
        } else if (k == 4 && (PHMASK & 64)) {
#if PROBE_X == 3
            phase_ln1_router(pa, lds, l, 1, (int)(st[2] + st[3]), nullptr); xcd_barrier(bar);
#endif
#if PROBE_X == 4
            phase_ln2(pa, l, vcu, G, 1, nullptr); xcd_barrier(bar);
#endif
            phase_ln1_router(pa, lds, l, 0, (int)(st[2] + st[3]), args.multi ? nullptr : (const unsigned*)(pws + WS_CTL) + CW_PAN + (l * 4 + 0) * 2048);
        } else if (k == 5 && (PHMASK & 128)) {
            const int T = moe_build_tab(pa, lds, l);
            pg8::MoeOrder S; S.tab = (const LAS int*)(lds + MOE_TAB_OFF); S.list = (const GAS int*)(pws + WS_LIST);
            S.wbase = (const char*)(pws + WS_WGU); S.wstride = (size_t)1024 * DM * 2; S.Kb = DM * 2; S.gather = 1;
            const bool ho = !args.multi && !PROBE_KEEPBAR;
            S.init_xcd(T, G, st);
            pg8::EpiMoe1 E{(bf16_t*)(pws + WS_H), ho ? (unsigned*)(pws + WS_CTL) + CW_MH + l * 18432 : nullptr};
            pg8::gemm_phase(lds, (const char*)(pws + WS_XN), DM, S, E);
        } else if (k == 6 && (PHMASK & 256)) {
            const int T = (!args.multi && !PROBE_KEEPBAR) ? ((const LAS int*)(lds + MOE_TAB_OFF))[32] : moe_build_tab(pa, lds, l);
            pg8::MoeOrder S; S.tab = (const LAS int*)(lds + MOE_TAB_OFF); S.list = (const GAS int*)(pws + WS_LIST);
            S.wbase = (const char*)(pws + WS_WD); S.wstride = (size_t)DM * EH * 2; S.Kb = EH * 2; S.gather = 0;
            S.init_xcd(T, G, st);
            if (!args.multi && !PROBE_KEEPBAR) { S.rank = S.nloc - 1 - S.rank;
                S.hcnt = (const unsigned*)(pws + WS_CTL) + CW_MH + l * 18432; S.tmo = (unsigned*)(pws + WS_CTL) + 8; }
            pg8::EpiMoe2 E{(bf16_t*)(pws + WS_Y), (const LAS int*)(lds + MOE_TAB_OFF), (const GAS int*)(pws + WS_LIST), (const GAS float*)(pws + WS_GLIST)};
            pg8::gemm_phase(lds, (const char*)(pws + WS_H), EH, S, E);
        } else if (k == 7 && (PHMASK & 512)) { phase_ln2(pa, l, (int)(st[2] + st[3]), G, nrep == 2 && rep == 0, (args.multi || l + 1 >= DEPTH) ? nullptr : (unsigned*)(pws + WS_CTL) + CW_PAN + (l * 4 + 1) * 2048); if (l + 1 < DEPTH) convert_layer_weights(pa, lds, l + 1, vcu, G, 2); }
        }
    }
}

extern "C" void kernel_launch(void* const* d_in, const int* in_sizes, int n_in, void* d_out, int out_size, void* d_ws, size_t ws_size, hipStream_t stream) {
    static int grid = 0;
    if (grid == 0) {
        if (n_in != 30 || out_size != NTOK * DM || ws_size < WS_END) { fprintf(stderr, "kernel_launch: unexpected shapes (n_in %d, out %d, ws %zu)\n", n_in, out_size, ws_size); grid = -1; return; }
        int dev = 0, cus = 0, per_cu = 0;
        hipGetDevice(&dev); hipDeviceGetAttribute(&cus, hipDeviceAttributeMultiprocessorCount, dev);
        if (hipFuncSetAttribute((const void*)hyb_fwd, hipFuncAttributeMaxDynamicSharedMemorySize, LDS_BYTES) != hipSuccess) { fprintf(stderr, "kernel_launch: hipFuncSetAttribute failed\n"); grid = -1; return; }
        if (hipOccupancyMaxActiveBlocksPerMultiprocessor(&per_cu, (const void*)hyb_fwd, NTHR, LDS_BYTES) != hipSuccess || per_cu < 1) { fprintf(stderr, "kernel_launch: occupancy query says %d\n", per_cu); per_cu = 1; }
        (void)hipGetLastError();
        grid = cus * 1;
        fprintf(stderr, "kernel_launch: %d CUs, occupancy %d, grid %d\n", cus, per_cu, grid);
    }
    if (grid < 0) return;
    hipMemsetAsync((char*)d_ws + WS_CTL, 0, CTL_ZERO_BYTES, stream);
    Args a{};
    for (int i = 0; i < 30; ++i) a.in[i] = (const float*)d_in[i];
    a.out = (float*)d_out; a.ws = (unsigned char*)d_ws;
#if MK_MULTI
    a.multi = 1;
    for (int ph = 0; ph < NPHASE; ++ph) { a.ph_lo = ph; a.ph_hi = ph + 1; hipLaunchKernelGGL(hyb_fwd, dim3(grid), dim3(NTHR), LDS_BYTES, stream, a); }
#else
    a.multi = 0; a.ph_lo = 0; a.ph_hi = NPHASE;
    void* kargs[] = {&a};
    hipError_t e = hipLaunchCooperativeKernel((const void*)hyb_fwd, dim3(grid), dim3(NTHR), kargs, LDS_BYTES, stream);
    if (e != hipSuccess) fprintf(stderr, "cooperative launch failed: %s (grid %d)\n", hipGetErrorString(e), grid);
#endif
}
```
